# Optimizing an MI355X kernel written in HIP

```python
import math
import jax, jax.numpy as jnp
from jax import lax
import numpy as np

D_MODEL = 1024
BATCH = 32
SEQ = 256
DEPTH = 2
DEC_BATCH = 2
DEC_SEQ = 1024
PAST_LEN = 256

GRID_W = 64
MLA_HEADS = 4
MLA_NOPE = 64
MLA_ROPE = 32
MLA_V = 64
MLA_Q_LORA = 256
MLA_KV_LORA = 128
W_MLA = MLA_HEADS * MLA_V
W_CONV = 256
CONV_K = 3
DIFF_HEADS = 4
DIFF_QK = 64
DIFF_V = 2 * DIFF_QK
W_DIFF = DIFF_HEADS * DIFF_V
D_MIX = W_MLA + W_CONV + W_DIFF
IN_SIZES = (MLA_Q_LORA, MLA_KV_LORA, MLA_ROPE,
            W_CONV, W_CONV, W_CONV,
            DIFF_HEADS * 2 * DIFF_QK, DIFF_HEADS * 2 * DIFF_QK, W_DIFF,
            D_MIX)
D_IN = sum(IN_SIZES)
ROPE_THETA = 10000.0
Q_BLOCK = 128
EPS = 1e-6

kernel_name = "hybrid_mla_shortconv_diffattn_prefix_dit"


def _split_offsets():
    acc, offs = 0, []
    for s in IN_SIZES[:-1]:
        acc += s
        offs.append(acc)
    return offs


def rmsnorm(x, g):
    xf = x.astype(jnp.float32)
    y = xf * lax.rsqrt(jnp.mean(xf * xf, axis=-1, keepdims=True) + EPS)
    return (y * g.astype(jnp.float32)).astype(x.dtype)


def grid_positions(n):
    rows = n // GRID_W
    row = jnp.broadcast_to(jnp.arange(rows)[:, None], (rows, GRID_W)).reshape(n)
    col = jnp.broadcast_to(jnp.arange(GRID_W)[None, :], (rows, GRID_W)).reshape(n)
    return row, col


def axial_tables(n, rot_dim):
    half = rot_dim // 2
    inv = ROPE_THETA ** (-(jnp.arange(0, half, 2, dtype=jnp.float32) / half))
    row, col = grid_positions(n)
    ang_r = row.astype(jnp.float32)[:, None] * inv
    ang_c = col.astype(jnp.float32)[:, None] * inv
    ang = jnp.concatenate([ang_r, ang_r, ang_c, ang_c], axis=-1)
    return jnp.cos(ang), jnp.sin(ang)


def _rot_half_axial(x):
    half = x.shape[-1] // 2
    q = half // 2
    xr, xc = x[..., :half], x[..., half:]
    rh = lambda t: jnp.concatenate([-t[..., q:], t[..., :q]], axis=-1)
    return jnp.concatenate([rh(xr), rh(xc)], axis=-1)


def apply_rope(x, cos, sin):
    xf = x.astype(jnp.float32)
    return (xf * cos + _rot_half_axial(xf) * sin).astype(x.dtype)


def map_query_blocks(f, q):
    b, n = q.shape[:2]
    nb = n // Q_BLOCK
    qb = q.reshape((b, nb, Q_BLOCK) + q.shape[2:]).swapaxes(0, 1)
    out = lax.map(f, qb)
    return out.swapaxes(0, 1).reshape((b, n) + out.shape[3:])


def mla_branch(c_q, c_kv, k_rope, q_norm, w_uq, kv_norm, w_ukv, rope, ctx):
    b, n = c_q.shape[:2]
    q = (rmsnorm(c_q, q_norm) @ w_uq).reshape(b, n, MLA_HEADS, MLA_NOPE + MLA_ROPE)
    ckv = rmsnorm(c_kv, kv_norm)
    if rope is not None:
        cos, sin = rope
        q = jnp.concatenate([q[..., :MLA_NOPE],
                             apply_rope(q[..., MLA_NOPE:], cos[:, None, :], sin[:, None, :])], axis=-1)
        k_rope_pos = apply_rope(k_rope, cos, sin)
    else:
        k_rope_pos = k_rope
    ckv_all, krope_all = ckv, k_rope_pos
    if ctx is not None:
        ckv_ctx, krope_ctx = ctx
        ckv_all = jnp.concatenate([ckv_ctx.astype(ckv.dtype), ckv], axis=1)
        krope_all = jnp.concatenate([krope_ctx.astype(k_rope_pos.dtype), k_rope_pos], axis=1)
    m = ckv_all.shape[1]
    kv = (ckv_all @ w_ukv).reshape(b, m, MLA_HEADS, MLA_NOPE + MLA_V)
    k_nope, v = kv[..., :MLA_NOPE], kv[..., MLA_NOPE:]
    scale = (MLA_NOPE + MLA_ROPE) ** -0.5
    k_nope_f = k_nope.astype(jnp.float32)
    krope_f = krope_all.astype(jnp.float32)

    def blk(qb):
        qf = qb.astype(jnp.float32)
        s = (jnp.einsum('bqhd,bkhd->bhqk', qf[..., :MLA_NOPE], k_nope_f)
             + jnp.einsum('bqhr,bkr->bhqk', qf[..., MLA_NOPE:], krope_f))
        p = jax.nn.softmax(s * scale, axis=-1)
        return jnp.einsum('bhqk,bkhd->bqhd', p.astype(v.dtype), v)

    o = map_query_blocks(blk, q).reshape(b, n, W_MLA)
    return o, ckv, k_rope


def conv_branch(bg, cg, xc, conv_w):
    u = cg * xc
    n = u.shape[1]
    pad = CONV_K // 2
    up = jnp.pad(u, ((0, 0), (pad, pad), (0, 0)))
    y = sum(up[:, j:j + n] * conv_w[j] for j in range(CONV_K))
    return bg * y


def diff_branch(q, k, v, lam, subln, lambda_init, rope, ctx):
    b, n = q.shape[:2]
    q = q.reshape(b, n, DIFF_HEADS, 2, DIFF_QK)
    k = k.reshape(b, n, DIFF_HEADS, 2, DIFF_QK)
    v = v.reshape(b, n, DIFF_HEADS, DIFF_V)
    k_ctx_out = k
    if rope is not None:
        cos, sin = rope
        cq, sq = cos[:, None, None, :], sin[:, None, None, :]
        q = apply_rope(q, cq, sq)
        k = apply_rope(k, cq, sq)
    k_all, v_all = k, v
    if ctx is not None:
        k_ctx, v_ctx = ctx
        k_all = jnp.concatenate([k_ctx.astype(k.dtype), k], axis=1)
        v_all = jnp.concatenate([v_ctx.astype(v.dtype), v], axis=1)
    lf = lam.astype(jnp.float32)
    lam_full = jnp.exp(jnp.sum(lf[0] * lf[1])) - jnp.exp(jnp.sum(lf[2] * lf[3])) + lambda_init
    k_f = k_all.astype(jnp.float32)
    scale = DIFF_QK ** -0.5

    def blk(qb):
        s = jnp.einsum('bqhad,bkhad->bhaqk', qb.astype(jnp.float32), k_f) * scale
        p = jax.nn.softmax(s, axis=-1)
        a = p[:, :, 0] - lam_full * p[:, :, 1]
        return jnp.einsum('bhqk,bkhe->bqhe', a.astype(v_all.dtype), v_all)

    o = map_query_blocks(blk, q)
    o = rmsnorm(o, subln) * (1.0 - lambda_init)
    return o.reshape(b, n, W_DIFF), k_ctx_out, v


def trunk_layer(x, cond, layer_idx, p, rope_mla, rope_diff, ctx):
    mod = jax.nn.silu(cond) @ p['ada_w'] + p['ada_b']
    shift, scale, gate = jnp.split(mod, 3, axis=-1)
    h = rmsnorm(x, p['norm_g']) * (1.0 + scale) + shift
    parts = jnp.split(h @ p['w_in'], _split_offsets(), axis=-1)
    c_q, c_kv, k_rope, cb, cc, cx, dq, dk, dv, z = parts
    if ctx is None:
        ctx_mla, ctx_diff = None, None
    else:
        ctx_mla, ctx_diff = (ctx[0], ctx[1]), (ctx[2], ctx[3])
    o_mla, ckv, kr = mla_branch(c_q, c_kv, k_rope, p['q_norm'], p['w_uq'], p['kv_norm'], p['w_ukv'],
                                rope_mla, ctx_mla)
    o_conv = conv_branch(cb, cc, cx, p['conv_w'])
    lambda_init = 0.8 - 0.6 * math.exp(-0.3 * layer_idx)
    o_diff, k_d, v_d = diff_branch(dq, dk, dv, p['lam'], p['subln'], lambda_init, rope_diff, ctx_diff)
    mix = jnp.concatenate([o_mla, o_conv, o_diff], axis=-1) * jax.nn.silu(z)
    x = x + gate * (mix @ p['w_out'])
    return x, (ckv, kr, k_d, v_d)


def setup_inputs(seed: int = 0) -> dict:
    key = jax.random.key(seed)
    ks = jax.random.split(key, 24)
    f32 = jnp.float32
    nrm = lambda k, shape, s: jax.random.normal(k, shape, f32) * s
    gain = lambda k, shape: 1.0 + 0.1 * jax.random.normal(k, shape, f32)
    return {
        "x_prompt": nrm(ks[0], (BATCH, SEQ, D_MODEL), 1.0),
        "x_sample": nrm(ks[1], (DEC_BATCH, DEC_SEQ, D_MODEL), 1.0),
        "c": nrm(ks[2], (DEC_BATCH, D_MODEL), 1.0),
        "cache_mla_ckv": nrm(ks[3], (DEC_BATCH, DEPTH, PAST_LEN, MLA_KV_LORA), 1.0),
        "cache_mla_krope": nrm(ks[4], (DEC_BATCH, DEPTH, PAST_LEN, MLA_ROPE), 1.0),
        "cache_diff_k": nrm(ks[5], (DEC_BATCH, DEPTH, PAST_LEN, DIFF_HEADS, 2, DIFF_QK), 1.0),
        "cache_diff_v": nrm(ks[6], (DEC_BATCH, DEPTH, PAST_LEN, DIFF_HEADS, DIFF_V), 1.0),
        "c_ctx": nrm(ks[7], (D_MODEL,), 1.0),
        "norm_g": gain(ks[8], (DEPTH, D_MODEL)),
        "ada_w": nrm(ks[9], (DEPTH, D_MODEL, 3 * D_MODEL), D_MODEL ** -0.5),
        "ada_b": nrm(ks[10], (DEPTH, 3 * D_MODEL), 0.02),
        "w_in": nrm(ks[11], (DEPTH, D_MODEL, D_IN), D_MODEL ** -0.5),
        "mla_q_norm": gain(ks[12], (DEPTH, MLA_Q_LORA)),
        "w_uq": nrm(ks[13], (DEPTH, MLA_Q_LORA, MLA_HEADS * (MLA_NOPE + MLA_ROPE)), MLA_Q_LORA ** -0.5),
        "mla_kv_norm": gain(ks[14], (DEPTH, MLA_KV_LORA)),
        "w_ukv": nrm(ks[15], (DEPTH, MLA_KV_LORA, MLA_HEADS * (MLA_NOPE + MLA_V)), MLA_KV_LORA ** -0.5),
        "conv_w": nrm(ks[16], (DEPTH, CONV_K, W_CONV), CONV_K ** -0.5),
        "diff_lambda": nrm(ks[17], (DEPTH, 4, DIFF_QK), 0.1),
        "diff_subln": gain(ks[18], (DEPTH, DIFF_V)),
        "w_out": nrm(ks[19], (DEPTH, D_MIX, D_MODEL), D_MIX ** -0.5),
        "final_norm": gain(ks[20], (D_MODEL,)),
    }


def reference(x_prompt, x_sample, c, cache_mla_ckv, cache_mla_krope, cache_diff_k, cache_diff_v,
              c_ctx, norm_g, ada_w, ada_b, w_in, mla_q_norm, w_uq, mla_kv_norm, w_ukv,
              conv_w, diff_lambda, diff_subln, w_out, final_norm):
    n_lat = x_sample.shape[1]
    rope_mla = axial_tables(n_lat, MLA_ROPE)
    rope_diff = axial_tables(n_lat, DIFF_QK)
    cond_ctx = c_ctx[None, None, :]
    cond_lat = c[:, None, :]
    h_ctx, h_lat = x_prompt, x_sample
    ckvs, krs, dks, dvs = [], [], [], []
    for l in range(DEPTH):
        p = dict(norm_g=norm_g[l], ada_w=ada_w[l], ada_b=ada_b[l], w_in=w_in[l],
                 q_norm=mla_q_norm[l], w_uq=w_uq[l], kv_norm=mla_kv_norm[l], w_ukv=w_ukv[l],
                 conv_w=conv_w[l], lam=diff_lambda[l], subln=diff_subln[l], w_out=w_out[l])
        h_ctx, (ckv, kr, dk, dv) = trunk_layer(h_ctx, cond_ctx, l, p, None, None, None)
        ckvs.append(ckv)
        krs.append(kr)
        dks.append(dk)
        dvs.append(dv)
        ctx = (cache_mla_ckv[:, l], cache_mla_krope[:, l], cache_diff_k[:, l], cache_diff_v[:, l])
        h_lat, _ = trunk_layer(h_lat, cond_lat, l, p, rope_mla, rope_diff, ctx)
    y_prompt = rmsnorm(h_ctx, final_norm)
    y_sample = rmsnorm(h_lat, final_norm)
    return (y_prompt, y_sample, jnp.stack(ckvs, axis=1), jnp.stack(krs, axis=1),
            jnp.stack(dks, axis=1), jnp.stack(dvs, axis=1))
```

```cpp
#include <hip/hip_runtime.h>
#include <hip/hip_cooperative_groups.h>
#include <cstdio>
namespace cg = cooperative_groups;

typedef unsigned short bf16_t;
typedef short bf16x8 __attribute__((ext_vector_type(8)));
typedef float f32x2 __attribute__((ext_vector_type(2)));
typedef float f32x4 __attribute__((ext_vector_type(4)));
typedef float f32x16 __attribute__((ext_vector_type(16)));
typedef unsigned u32x2 __attribute__((ext_vector_type(2)));
typedef unsigned u32x4 __attribute__((ext_vector_type(4)));
typedef __bf16 bf16x2_t __attribute__((ext_vector_type(2)));

#ifndef REP
#define REP -1
#endif
#define DI __device__ __forceinline__
#define MFMA16(a, b, c) __builtin_amdgcn_mfma_f32_16x16x32_bf16((a), (b), (c), 0, 0, 0)
#define MFMA32(a, b, c) __builtin_amdgcn_mfma_f32_32x32x16_bf16((a), (b), (c), 0, 0, 0)

#define XCD_BAR_WORDS 3456
constexpr int NCTX = 8192, NTOK = 10240, NP = 3840;
constexpr float EPS = 1e-6f;
constexpr float QSCALE_M = 0.14724444602590306f;
constexpr float QSCALE_D = 0.18033688011112042f;
constexpr size_t OUT_CKV = 10485760, OUT_KR = 12582912, OUT_DK = 13107200, OUT_DV = 21495808;

__constant__ float INV16[16] = {1.000000000e+00f, 5.623413324e-01f, 3.162277639e-01f, 1.778279394e-01f, 1.000000015e-01f, 5.623413250e-02f, 3.162277490e-02f, 1.778279431e-02f,
                                9.999999776e-03f, 5.623413250e-03f, 3.162277630e-03f, 1.778279431e-03f, 1.000000047e-03f, 5.623413017e-04f, 3.162277571e-04f, 1.778279402e-04f};
__constant__ float INV8[8] = {1.000000000e+00f, 3.162277639e-01f, 1.000000015e-01f, 3.162277490e-02f, 9.999999776e-03f, 3.162277630e-03f, 1.000000047e-03f, 3.162277571e-04f};

constexpr size_t al256(size_t x) { return (x + 255) & ~(size_t)255; }
constexpr size_t OFF_bar = 0;
constexpr size_t OFF_WinT = OFF_bar + al256(XCD_BAR_WORDS * 4);
constexpr size_t OFF_WoutT = OFF_WinT + al256((size_t)2 * NP * 1024 * 2);
constexpr size_t OFF_WuqT = OFF_WoutT + al256((size_t)2 * 1024 * 1024 * 2);
constexpr size_t OFF_WukvTf = OFF_WuqT + al256((size_t)2 * 384 * 256 * 2);
constexpr size_t OFF_WukvT = OFF_WukvTf + al256((size_t)2 * 512 * 128 * 2);
constexpr size_t OFF_mod = OFF_WukvT + al256((size_t)2 * 512 * 128 * 2);
constexpr size_t OFF_ssq_q = OFF_mod + al256((size_t)2 * 3 * 3072 * 4);
constexpr size_t OFF_ssq_kv = OFF_ssq_q + al256((size_t)2 * NTOK * 4);
constexpr size_t OFF_ssq_x = OFF_ssq_kv + al256((size_t)2 * NTOK * 4);
constexpr size_t OFF_bw = OFF_ssq_x + al256((size_t)3 * NTOK * 4);
constexpr size_t OFF_ropeD = OFF_bw + al256((size_t)2 * 3 * NP * 4);
constexpr size_t OFF_ropeM = OFF_ropeD + al256(2048 * 4);
constexpr size_t OFF_wq = OFF_ropeM + al256(1024 * 4);
constexpr size_t OFF_hbuf = OFF_wq + al256(256);
constexpr size_t OFF_cq = OFF_hbuf + al256((size_t)NTOK * 1024 * 2);
constexpr size_t OFF_ckvraw = OFF_cq + al256((size_t)NTOK * 256 * 2);
constexpr size_t OFF_cckv = OFF_ckvraw + al256((size_t)NTOK * 128 * 2);
constexpr size_t OFF_convb = OFF_cckv + al256((size_t)2 * 512 * 128 * 2);
constexpr size_t OFF_dq = OFF_convb + al256((size_t)NTOK * 768 * 2);
constexpr size_t OFF_zs = OFF_dq + al256((size_t)NTOK * 512 * 2);
constexpr size_t OFF_qm = OFF_zs + al256((size_t)NTOK * 1024 * 2);
constexpr size_t OFF_KmC = OFF_qm + al256((size_t)NTOK * 384 * 2);
constexpr size_t OFF_KmL = OFF_KmC + al256((size_t)32 * 4 * 256 * 96 * 2);
constexpr size_t OFF_VmC = OFF_KmL + al256((size_t)2 * 983040 * 2);
constexpr size_t OFF_VmL = OFF_VmC + al256((size_t)32 * 4 * 64 * 256 * 2);
constexpr size_t OFF_KdC = OFF_VmL + al256((size_t)2 * 655360 * 2);
constexpr size_t OFF_KdL = OFF_KdC + al256((size_t)32 * 4 * 2 * 256 * 64 * 2);
constexpr size_t OFF_VdC = OFF_KdL + al256((size_t)2 * 1310720 * 2);
constexpr size_t OFF_VdL = OFF_VdC + al256((size_t)32 * 4 * 128 * 256 * 2);
constexpr size_t OFF_mix = OFF_VdL + al256((size_t)2 * 1310720 * 2);
constexpr size_t OFF_xbuf = OFF_mix + al256((size_t)NTOK * 1024 * 2);
constexpr size_t WS_TOTAL = OFF_xbuf + al256((size_t)NTOK * 1024 * 4);

struct Params {
  const float *x_prompt, *x_sample, *c, *cache_ckv, *cache_krope, *cache_dk, *cache_dv, *c_ctx;
  const float *norm_g, *ada_w, *ada_b, *w_in, *q_norm, *w_uq, *kv_norm, *w_ukv, *conv_w, *lam, *subln, *w_out, *final_norm;
  float* out;
  char* ws;
  DI unsigned* bar() const { return (unsigned*)(ws + OFF_bar); }
  DI bf16_t* WinT() const { return (bf16_t*)(ws + OFF_WinT); }
  DI bf16_t* WoutT() const { return (bf16_t*)(ws + OFF_WoutT); }
  DI bf16_t* WuqT() const { return (bf16_t*)(ws + OFF_WuqT); }
  DI bf16_t* WukvTf() const { return (bf16_t*)(ws + OFF_WukvTf); }
  DI bf16_t* WukvT() const { return (bf16_t*)(ws + OFF_WukvT); }
  DI float* mod() const { return (float*)(ws + OFF_mod); }
  DI float* ssq_q() const { return (float*)(ws + OFF_ssq_q); }
  DI float* ssq_kv() const { return (float*)(ws + OFF_ssq_kv); }
  DI float* ssq_x() const { return (float*)(ws + OFF_ssq_x); }
  DI float* bw() const { return (float*)(ws + OFF_bw); }
  DI float* ropeD() const { return (float*)(ws + OFF_ropeD); }
  DI float* ropeM() const { return (float*)(ws + OFF_ropeM); }
  DI int* wq() const { return (int*)(ws + OFF_wq); }
  DI bf16_t* hbuf() const { return (bf16_t*)(ws + OFF_hbuf); }
  DI bf16_t* cq() const { return (bf16_t*)(ws + OFF_cq); }
  DI bf16_t* ckvraw() const { return (bf16_t*)(ws + OFF_ckvraw); }
  DI bf16_t* cckv() const { return (bf16_t*)(ws + OFF_cckv); }
  DI bf16_t* convb() const { return (bf16_t*)(ws + OFF_convb); }
  DI bf16_t* dq() const { return (bf16_t*)(ws + OFF_dq); }
  DI bf16_t* zs() const { return (bf16_t*)(ws + OFF_zs); }
  DI bf16_t* qm() const { return (bf16_t*)(ws + OFF_qm); }
  DI bf16_t* KmC() const { return (bf16_t*)(ws + OFF_KmC); }
  DI bf16_t* KmL() const { return (bf16_t*)(ws + OFF_KmL); }
  DI bf16_t* VmC() const { return (bf16_t*)(ws + OFF_VmC); }
  DI bf16_t* VmL() const { return (bf16_t*)(ws + OFF_VmL); }
  DI bf16_t* KdC() const { return (bf16_t*)(ws + OFF_KdC); }
  DI bf16_t* KdL() const { return (bf16_t*)(ws + OFF_KdL); }
  DI bf16_t* VdC() const { return (bf16_t*)(ws + OFF_VdC); }
  DI bf16_t* VdL() const { return (bf16_t*)(ws + OFF_VdL); }
  DI bf16_t* mix() const { return (bf16_t*)(ws + OFF_mix); }
  DI float* xbuf() const { return (float*)(ws + OFF_xbuf); }
};

DI unsigned pk2(float a, float b) {
  f32x2 v = {a, b};
  bf16x2_t r = __builtin_convertvector(v, bf16x2_t);
  return __builtin_bit_cast(unsigned, r);
}
DI float bflo(unsigned u) { return __uint_as_float(u << 16); }
DI float bfhi(unsigned u) { return __uint_as_float(u & 0xffff0000u); }
DI bf16_t f2bf(float a) { return (bf16_t)(pk2(a, 0.f) & 0xffffu); }
DI float shx(float v, int o, int lane) { return __int_as_float(__builtin_amdgcn_ds_bpermute((lane ^ o) << 2, __float_as_int(v))); }
DI float wave_sum(float v, int lane) {
#pragma unroll
  for (int o = 32; o >= 1; o >>= 1) v += shx(v, o, lane);
  return v;
}
DI int opaque_tid() { int t = threadIdx.x; asm volatile("" : "+v"(t)); return t; }
DI int opaque_bid() { int b = blockIdx.x; asm volatile("" : "+s"(b)); return b; }
DI int rope_perm(int P) { return (P & 7) | ((P & 8) << 1) | ((P & 16) >> 1); }


#define XB_TMO      128
#define XB_XCNT(j)  (256  + 64 * (j))
#define XB_XSUB(j)  (1280 + 64 * (j))
#define XB_XGEN(j)  (2304 + 64 * (j))
#define XB_TOP      3328
#define XB_TOPGEN   3392
#define XB_SPIN_CAP (1u << 18)
DI unsigned xb_ld(unsigned* p)              { return __hip_atomic_load(p, __ATOMIC_RELAXED, __HIP_MEMORY_SCOPE_AGENT); }
DI unsigned xb_add(unsigned* p, unsigned v) { return __hip_atomic_fetch_add(p, v, __ATOMIC_RELAXED, __HIP_MEMORY_SCOPE_AGENT); }
DI unsigned xb_xcc_id() { return (unsigned)__builtin_amdgcn_s_getreg((3 << 11) | 20) & 0xFu; }
#define XB_SPIN(cond, bar) do { unsigned _sp = 0; while (cond) { __builtin_amdgcn_s_sleep(1); \
    if ((++_sp & 255u) == 0u) { if (xb_ld(&(bar)[XB_TMO])) break; if (_sp > XB_SPIN_CAP) { atomicAdd(&(bar)[XB_TMO], 1u); break; } } } } while (0)
#define LAS __attribute__((address_space(3)))
struct XcdBarrier { unsigned* bar; unsigned x; volatile LAS unsigned* st; };
DI XcdBarrier xcd_barrier_post(unsigned* bar, volatile LAS unsigned* st) {
  XcdBarrier b; b.bar = bar; b.x = xb_xcc_id(); b.st = st;
  if (threadIdx.x == 0) (void)xb_add(&bar[XB_XCNT(b.x)], 1u);
  return b;
}
DI void xcd_barrier_complete(unsigned* bar, unsigned x, unsigned& nloc, unsigned& nx) {
  const unsigned G = gridDim.x * gridDim.y * gridDim.z;
  unsigned sum, cnt, mine, sp = 0u;
  for (;;) {
    sum = 0u; cnt = 0u; mine = 0u;
#pragma unroll
    for (unsigned j = 0; j < 16; ++j) { const unsigned c = xb_ld(&bar[XB_XCNT(j)]); sum += c; cnt += (c > 0u) ? 1u : 0u; mine = (j == x) ? c : mine; }
    if (sum == G) break;
    __builtin_amdgcn_s_sleep(1);
    if ((++sp & 255u) == 0u) { if (xb_ld(&bar[XB_TMO])) break; if (sp > XB_SPIN_CAP) { atomicAdd(&bar[XB_TMO], 1u); break; } }
  }
  nloc = mine > 0u ? mine : 1u; nx = cnt > 0u ? cnt : 1u;
}
DI void xcd_barrier(const XcdBarrier& b) {
  asm volatile("s_waitcnt vmcnt(0)" ::: "memory");
  __syncthreads();
  if (threadIdx.x == 0) {
    unsigned* bar = b.bar;
    __builtin_amdgcn_s_waitcnt(0);
    unsigned nloc = b.st[0], nx = b.st[1];
    if (nloc == 0u) { xcd_barrier_complete(bar, b.x, nloc, nx); b.st[0] = nloc; b.st[1] = nx; }
    const unsigned old = xb_add(&bar[XB_XSUB(b.x)], 1u);
    const unsigned gen = old / nloc;
    if (old + 1u == (gen + 1u) * nloc) {
      __builtin_amdgcn_fence(__ATOMIC_RELEASE, "agent");
      asm volatile("s_waitcnt vmcnt(0)" ::: "memory");
      const unsigned og = xb_add(&bar[XB_TOP], 1u);
      const unsigned tg = og / nx;
      if (og + 1u == (tg + 1u) * nx) xb_add(&bar[XB_TOPGEN], 1u);
      else XB_SPIN(xb_ld(&bar[XB_TOPGEN]) == tg, bar);
      __builtin_amdgcn_fence(__ATOMIC_ACQUIRE, "agent");
      xb_add(&bar[XB_XGEN(b.x)], 1u);
      asm volatile("s_waitcnt vmcnt(0)" ::: "memory");
    } else {
      XB_SPIN(xb_ld(&bar[XB_XGEN(b.x)]) == gen, bar);
      __builtin_amdgcn_fence(__ATOMIC_ACQUIRE, "agent");
      asm volatile("s_waitcnt vmcnt(0)" ::: "memory");
    }
  }
  __syncthreads();
}

struct ColMapIn { DI int operator()(int n) const { if (n < 384) return n; if (n < 3712) return n + 32; if (n < 3744) return 384 + rope_perm(n - 3712); return -1; } };
struct ColMapId { DI int operator()(int n) const { return n; } };
struct ColMapUq { DI int operator()(int n) const { int h = n / 96, c = n - h * 96; if (c >= 64) c = 64 + rope_perm(c - 64); return h * 96 + c; } };

template <class CM>
DI void tconv_tile(const float* __restrict__ src, int ldsrc, bf16_t* __restrict__ dst, int K, int n0, int k0, const float* __restrict__ kscale, CM cm, float* sm, int tid) {
  const int tq = tid & 15, ty = tid >> 4;
  const int sc = cm(n0 + tq * 4);
  f32x4 v[4];
#pragma unroll
  for (int i = 0; i < 4; ++i) {
    const int kk = ty + i * 16;
    v[i] = (f32x4){0.f, 0.f, 0.f, 0.f};
    if (sc >= 0) v[i] = *(const f32x4*)(src + (size_t)(k0 + kk) * ldsrc + sc);
  }
#pragma unroll
  for (int i = 0; i < 4; ++i) {
    const int kk = ty + i * 16;
    const float s = kscale ? kscale[k0 + kk] : 1.f;
#pragma unroll
    for (int j = 0; j < 4; ++j) sm[kk * 65 + tq * 4 + j] = v[i][j] * s;
  }
  __syncthreads();
  const int kc = tid & 7, nn = tid >> 3;
#pragma unroll
  for (int ps = 0; ps < 2; ++ps) {
    const int n = nn + ps * 32;
    u32x4 o;
#pragma unroll
    for (int i = 0; i < 4; ++i) o[i] = pk2(sm[(kc * 8 + 2 * i) * 65 + n], sm[(kc * 8 + 2 * i + 1) * 65 + n]);
    *(u32x4*)(dst + (size_t)(n0 + n) * K + k0 + kc * 8) = o;
  }
  __syncthreads();
}

DI float silu_f(float x) { return x / (1.f + __expf(-x)); }

DI void mod_item(const Params& p, int it, float* sm, int tid) {
  const int l = it / 96, cb = it % 96;
  const int cqd = tid & 7, rg = tid >> 3;
  const float* W = p.ada_w + (size_t)l * 1024 * 3072 + cb * 32 + cqd * 4;
  float a0[4] = {0, 0, 0, 0}, a1[4] = {0, 0, 0, 0}, a2[4] = {0, 0, 0, 0};
#pragma unroll 16
  for (int i = 0; i < 32; ++i) {
    const int k = rg + i * 32;
    const f32x4 w = *(const f32x4*)(W + (size_t)k * 3072);
    const float s0 = silu_f(p.c_ctx[k]), s1 = silu_f(p.c[k]), s2 = silu_f(p.c[1024 + k]);
#pragma unroll
    for (int j = 0; j < 4; ++j) { a0[j] += s0 * w[j]; a1[j] += s1 * w[j]; a2[j] += s2 * w[j]; }
  }
#pragma unroll
  for (int j = 0; j < 4; ++j) {
    sm[(rg * 3 + 0) * 32 + cqd * 4 + j] = a0[j];
    sm[(rg * 3 + 1) * 32 + cqd * 4 + j] = a1[j];
    sm[(rg * 3 + 2) * 32 + cqd * 4 + j] = a2[j];
  }
  __syncthreads();
  if (tid < 96) {
    const int ci = tid >> 5, cc = tid & 31;
    float s = 0.f;
    for (int r = 0; r < 32; ++r) s += sm[(r * 3 + ci) * 32 + cc];
    const int col = cb * 32 + cc;
    p.mod()[(l * 3 + ci) * 3072 + col] = s + p.ada_b[l * 3072 + col];
  }
  __syncthreads();
}

DI void sincos_d(float ang, float& c, float& s) {
  const double TWO_PI = 6.283185307179586476925286766559;
  double x = (double)ang;
  x = x - TWO_PI * rint(x / TWO_PI);
  const double x2 = x * x;
  double ts = 1.0, tc = 1.0;
#pragma unroll
  for (int k = 12; k >= 1; --k) {
    ts = 1.0 - ts * x2 / (double)((2 * k) * (2 * k + 1));
    tc = 1.0 - tc * x2 / (double)((2 * k - 1) * (2 * k));
  }
  s = (float)(x * ts);
  c = (float)tc;
}

DI void phase0(const Params& p, char* smem) {
  float* sm = (float*)smem;
  const int tid = opaque_tid(), bid = opaque_bid();
  for (int it = bid; it < 2736; it += gridDim.x) {
    if (it < 1920) {
      const int l = it / 960, r = it % 960, kt = r / 60, nt = r % 60;
      tconv_tile(p.w_in + (size_t)l * 1024 * 3744, 3744, p.WinT() + (size_t)l * NP * 1024, 1024, nt * 64, kt * 64, nullptr, ColMapIn(), sm, tid);
    } else if (it < 2432) {
      const int j = it - 1920, l = j / 256, r = j % 256, kt = r / 16, nt = r % 16;
      tconv_tile(p.w_out + (size_t)l * 1024 * 1024, 1024, p.WoutT() + (size_t)l * 1024 * 1024, 1024, nt * 64, kt * 64, nullptr, ColMapId(), sm, tid);
    } else if (it < 2480) {
      const int j = it - 2432, l = j / 24, r = j % 24, kt = r / 6, nt = r % 6;
      tconv_tile(p.w_uq + (size_t)l * 256 * 384, 384, p.WuqT() + (size_t)l * 384 * 256, 256, nt * 64, kt * 64, p.q_norm + l * 256, ColMapUq(), sm, tid);
    } else if (it < 2512) {
      const int j = it - 2480, l = j / 16, r = j % 16, kt = r / 8, nt = r % 8;
      tconv_tile(p.w_ukv + (size_t)l * 128 * 512, 512, p.WukvTf() + (size_t)l * 512 * 128, 128, nt * 64, kt * 64, p.kv_norm + l * 128, ColMapId(), sm, tid);
    } else if (it < 2544) {
      const int j = it - 2512, l = j / 16, r = j % 16, kt = r / 8, nt = r % 8;
      tconv_tile(p.w_ukv + (size_t)l * 128 * 512, 512, p.WukvT() + (size_t)l * 512 * 128, 128, nt * 64, kt * 64, nullptr, ColMapId(), sm, tid);
    } else {
      mod_item(p, it - 2544, sm, tid);
    }
  }
  const int gstride = gridDim.x * 256, g0 = bid * 256 + tid;
  for (int i0 = g0; i0 < 524288; i0 += 4 * gstride) {
    float v[4];
#pragma unroll
    for (int u = 0; u < 4; ++u) {
      const int i = i0 + u * gstride;
      if (i < 524288) { const int cc = i & 511, t = (i >> 9) & 255, b = (i >> 17) & 1, l = i >> 18; v[u] = p.cache_dk[(size_t)((b * 2 + l) * 256 + t) * 512 + cc]; }
    }
#pragma unroll
    for (int u = 0; u < 4; ++u) {
      const int i = i0 + u * gstride;
      if (i < 524288) {
        const int cc = i & 511, t = (i >> 9) & 255, b = (i >> 17) & 1, l = i >> 18, h = cc >> 7, a = (cc >> 6) & 1, d = cc & 63;
        p.KdL()[(size_t)l * 1310720 + (size_t)(((b * 4 + h) * 2 + a) * 1280 + t) * 64 + d] = f2bf(v[u]);
      }
    }
  }
  for (int i0 = g0; i0 < 524288; i0 += 4 * gstride) {
    float v[4];
#pragma unroll
    for (int u = 0; u < 4; ++u) {
      const int j = i0 + u * gstride;
      if (j < 524288) { const int t = j & 255, e = (j >> 8) & 127, h = (j >> 15) & 3, b = (j >> 17) & 1, l = j >> 18; v[u] = p.cache_dv[(size_t)((b * 2 + l) * 256 + t) * 512 + h * 128 + e]; }
    }
#pragma unroll
    for (int u = 0; u < 4; ++u) {
      const int j = i0 + u * gstride;
      if (j < 524288) { const int t = j & 255, e = (j >> 8) & 127, h = (j >> 15) & 3, b = (j >> 17) & 1, l = j >> 18; p.VdL()[(size_t)l * 1310720 + (size_t)((b * 4 + h) * 128 + e) * 1280 + t] = f2bf(v[u]); }
    }
  }
  const int E2 = 131072, E3 = E2 + 131072, E4 = E3 + 1536, E5 = E4 + 40960 + 30720;
  for (int i = g0; i < E5; i += gstride) {
    if (i < E2) {
      const int j = i;
      const int r = j & 31, h = (j >> 5) & 3, t = (j >> 7) & 255, b = (j >> 15) & 1, l = j >> 16;
      p.KmL()[(size_t)l * 983040 + (size_t)((b * 4 + h) * 1280 + t) * 96 + 64 + r] = f2bf(p.cache_krope[(size_t)((b * 2 + l) * 256 + t) * 32 + r]);
    } else if (i < E3) {
      const int j = i - E2;
      const int cc = j & 127, t = (j >> 7) & 255, b = (j >> 15) & 1, l = j >> 16;
      p.cckv()[(size_t)l * 65536 + (b * 256 + t) * 128 + cc] = f2bf(p.cache_ckv[(size_t)((b * 2 + l) * 256 + t) * 128 + cc]);
    } else if (i < E4) {
      const int j = i - E3;
      float cs, sn;
      if (j < 1024) {
        const int pos = j >> 4, f = j & 15;
        sincos_d((float)pos * INV16[f], cs, sn);
        p.ropeD()[j] = cs; p.ropeD()[1024 + j] = sn;
      } else {
        const int jj = j - 1024, pos = jj >> 3, f = jj & 7;
        sincos_d((float)pos * INV8[f], cs, sn);
        p.ropeM()[jj] = cs; p.ropeM()[512 + jj] = sn;
      }
    } else {
      const int j = i - E4;
      if (j < 20480) p.ssq_q()[j] = 0.f; else if (j < 40960) p.ssq_kv()[j - 20480] = 0.f; else p.ssq_x()[j - 40960] = 0.f;
      if (j < 64) p.wq()[j] = 0;
    }
  }
}

DI void phase_norm(const Params& p, int l) {
  const int tid = opaque_tid(), bid = opaque_bid();
  const int lane = tid & 63;
  const int gw = bid * 4 + (tid >> 6), nw = gridDim.x * 4;
  if (l == 0) {
    for (int it = gw; it < 2 * NP; it += nw) {
      const int ll = it / NP, n = it % NP;
      const bf16_t* wrow = p.WinT() + ((size_t)ll * NP + n) * 1024 + lane * 16;
      const u32x4 w0 = *(const u32x4*)wrow, w1 = *(const u32x4*)(wrow + 8);
      float wv[16];
#pragma unroll
      for (int q = 0; q < 4; ++q) { wv[2 * q] = bflo(w0[q]); wv[2 * q + 1] = bfhi(w0[q]); wv[8 + 2 * q] = bflo(w1[q]); wv[8 + 2 * q + 1] = bfhi(w1[q]); }
#pragma unroll
      for (int ci = 0; ci < 3; ++ci) {
        const float* sh = p.mod() + (ll * 3 + ci) * 3072 + lane * 16;
        float s = 0.f;
#pragma unroll
        for (int q = 0; q < 4; ++q) { const f32x4 sv = *(const f32x4*)(sh + q * 4); s += sv[0] * wv[q * 4] + sv[1] * wv[q * 4 + 1] + sv[2] * wv[q * 4 + 2] + sv[3] * wv[q * 4 + 3]; }
        s = wave_sum(s, lane);
        if (lane == 0) p.bw()[(ll * 3 + ci) * NP + n] = s;
      }
    }
  }
  for (int row = gw; row < NTOK; row += nw) {
    const float* x = (l == 0) ? (row < NCTX ? p.x_prompt + (size_t)row * 1024 : p.x_sample + (size_t)(row - NCTX) * 1024) : p.xbuf() + (size_t)row * 1024;
    f32x4 v[4];
#pragma unroll
    for (int i = 0; i < 4; ++i) v[i] = *(const f32x4*)(x + i * 256 + lane * 4);
    if (l == 0) {
      float ss = 0.f;
#pragma unroll
      for (int i = 0; i < 4; ++i) ss += v[i][0] * v[i][0] + v[i][1] * v[i][1] + v[i][2] * v[i][2] + v[i][3] * v[i][3];
      ss = wave_sum(ss, lane);
      if (lane == 0) p.ssq_x()[row] = ss;
      const int ci = row < NCTX ? 0 : 1 + ((row - NCTX) >> 10);
      const float* md = p.mod() + ci * 3072;
#pragma unroll
      for (int i = 0; i < 4; ++i) {
        const int k = i * 256 + lane * 4;
        const f32x4 gg = *(const f32x4*)(p.norm_g + k), sc = *(const f32x4*)(md + 1024 + k);
        float o[4];
#pragma unroll
        for (int j = 0; j < 4; ++j) o[j] = v[i][j] * gg[j] * (1.f + sc[j]);
        u32x2 pk = {pk2(o[0], o[1]), pk2(o[2], o[3])};
        *(u32x2*)(p.hbuf() + (size_t)row * 1024 + k) = pk;
      }
    } else {
      const float rstd = rsqrtf(p.ssq_x()[2 * NTOK + row] * (1.f / 1024.f) + EPS);
#pragma unroll
      for (int i = 0; i < 4; ++i) {
        const int k = i * 256 + lane * 4;
        const f32x4 gg = *(const f32x4*)(p.final_norm + k);
        f32x4 o;
#pragma unroll
        for (int j = 0; j < 4; ++j) o[j] = v[i][j] * rstd * gg[j];
        *(f32x4*)(p.out + (size_t)row * 1024 + k) = o;
      }
    }
  }
}

template <int MB, int DEPTH, class Epi>
DI void gemm_tile(const bf16_t* __restrict__ A, int lda, const bf16_t* __restrict__ Bt, int ldb, int K, int row0, int col0, const Epi& epi, char* smem, int tid) {
  constexpr int ABYTES = MB * 32 * 128, STAGE = ABYTES + 16384;
  const int lane = tid & 63, w = tid >> 6, wr = w >> 1, wc = w & 1, fr = lane & 15, fq = lane >> 4;
  const int lrow = tid >> 3, lc8 = tid & 7, lch = lc8 >> 2, lrr = lrow & 15;
  const char* Ab = (const char*)(A + (size_t)row0 * lda);
  const char* Bb = (const char*)(Bt + (size_t)col0 * ldb);
  const unsigned voa = (unsigned)(lrow * lda + lc8 * 8) * 2u, vob = (unsigned)(lrow * ldb + lc8 * 8) * 2u;
  const int wbase = ((lrow >> 4) * 2 + lch) * 1024 + ((((lrr ^ lch) * 64) + (lc8 & 3) * 16) ^ ((lrr >> 3) << 5));
  const int rlo = (fr * 64 + fq * 16) ^ ((fr >> 3) << 5);
  u32x4 ra[DEPTH][MB], rb[DEPTH][4];
  f32x4 acc[MB][4];
#pragma unroll
  for (int m = 0; m < MB; ++m)
#pragma unroll
    for (int n = 0; n < 4; ++n) acc[m][n] = (f32x4){0.f, 0.f, 0.f, 0.f};
  const int nk = K >> 6;
#define GLOAD(S, K0)                                                                               \
  {                                                                                                \
    _Pragma("unroll") for (int ps = 0; ps < MB; ++ps) ra[S][ps] = *(const u32x4*)(Ab + ((size_t)ps * 64 * lda + (K0) * 2) + voa); \
    _Pragma("unroll") for (int ps = 0; ps < 4; ++ps) rb[S][ps] = *(const u32x4*)(Bb + ((size_t)ps * 64 * ldb + (K0) * 2) + vob);  \
    __builtin_amdgcn_sched_barrier(0);                                                             \
  }
#define SSTORE(S, BUF)                                                                             \
  {                                                                                                \
    char* sw = smem + (BUF) * STAGE + wbase;                                                       \
    _Pragma("unroll") for (int ps = 0; ps < MB; ++ps) *(u32x4*)(sw + ps * 4096) = ra[S][ps];        \
    _Pragma("unroll") for (int ps = 0; ps < 4; ++ps) *(u32x4*)(sw + ABYTES + ps * 4096) = rb[S][ps]; \
  }
#define COMPUTE(BUF)                                                                               \
  {                                                                                                \
    const char* sa = smem + (BUF) * STAGE;                                                         \
    const char* sb = sa + ABYTES;                                                                  \
    _Pragma("unroll") for (int kk = 0; kk < 2; ++kk) {                                             \
      bf16x8 af[MB], bfr[4];                                                                       \
      const int ro = kk * 1024 + (rlo ^ (kk * 64));                                                \
      _Pragma("unroll") for (int m = 0; m < MB; ++m) af[m] = *(const bf16x8*)(sa + (wr * MB + m) * 2048 + ro); \
      _Pragma("unroll") for (int n = 0; n < 4; ++n) bfr[n] = *(const bf16x8*)(sb + (wc * 4 + n) * 2048 + ro);  \
      __builtin_amdgcn_s_setprio(1);                                                               \
      _Pragma("unroll") for (int m = 0; m < MB; ++m) _Pragma("unroll") for (int n = 0; n < 4; ++n) acc[m][n] = MFMA16(bfr[n], af[m], acc[m][n]); \
      __builtin_amdgcn_s_setprio(0);                                                               \
    }                                                                                              \
  }
  if constexpr (DEPTH == 2) {
    GLOAD(0, 0);
    GLOAD(1, 64);
    SSTORE(0, 0);
    __syncthreads();
    for (int kt = 0; kt < nk; kt += 2) {
      if (kt + 2 < nk) GLOAD(0, (kt + 2) * 64);
      COMPUTE(0);
      SSTORE(1, 1);
      __syncthreads();
      if (kt + 3 < nk) GLOAD(1, (kt + 3) * 64);
      COMPUTE(1);
      if (kt + 2 < nk) SSTORE(0, 0);
      __syncthreads();
    }
  } else {
    GLOAD(0, 0);
    SSTORE(0, 0);
    __syncthreads();
    for (int kt = 0; kt < nk; kt += 2) {
      GLOAD(0, (kt + 1) * 64);
      COMPUTE(0);
      SSTORE(0, 1);
      __syncthreads();
      if (kt + 2 < nk) GLOAD(0, (kt + 2) * 64);
      COMPUTE(1);
      if (kt + 2 < nk) SSTORE(0, 0);
      __syncthreads();
    }
  }
#undef GLOAD
#undef SSTORE
#undef COMPUTE
  epi.template tile<MB>(row0 + wr * MB * 16 + fr, col0 + wc * 64, fq, acc);
}

DI void st_bf4(bf16_t* dst, const f32x4& v) {
  u32x2 o = {pk2(v[0], v[1]), pk2(v[2], v[3])};
  *(u32x2*)dst = o;
}

DI void rot4(f32x4& x0, f32x4& x1, const float* tab, int toff, int idx) {
  const f32x4 cs = *(const f32x4*)(tab + idx), sn = *(const f32x4*)(tab + toff + idx);
#pragma unroll
  for (int j = 0; j < 4; ++j) {
    const float a = x0[j], b = x1[j];
    x0[j] = a * cs[j] - b * sn[j];
    x1[j] = b * cs[j] + a * sn[j];
  }
}

struct EpiIn {
  const Params& p; int l; bool atom; bool skip;
  template <int MB> DI void tile(int rbase, int cb, int fq, f32x4 (&acc)[MB][4]) const {
    const float* bwp = p.bw() + (l * 3 + (rbase < NCTX ? 0 : 1 + ((rbase - NCTX) >> 10))) * NP + cb + fq * 4;
    f32x4 bb[4];
    float rs[MB];
#pragma unroll
    for (int n = 0; n < 4; ++n) bb[n] = *(const f32x4*)(bwp + n * 16);
#pragma unroll
    for (int m = 0; m < MB; ++m) rs[m] = p.ssq_x()[l * NTOK + rbase + m * 16];
#pragma unroll
    for (int m = 0; m < MB; ++m) {
      const float r = rsqrtf(rs[m] * (1.f / 1024.f) + EPS);
#pragma unroll
      for (int n = 0; n < 4; ++n)
#pragma unroll
        for (int j = 0; j < 4; ++j) acc[m][n][j] = acc[m][n][j] * r + bb[n][j];
      (*this)(rbase + m * 16, cb, fq, acc[m]);
    }
  }
  DI void operator()(int row, int cb, int fq, f32x4 (&v)[4]) const {
    if (skip) return;
    const bool ctx = row < NCTX;
    int b, t;
    if (ctx) { b = row >> 8; t = row & 255; } else { b = (row - NCTX) >> 10; t = (row - NCTX) & 1023; }
    const int pr = t >> 6, pc = t & 63;
    const int c4 = fq * 4;
    if (cb < 384) {
      float ss = 0.f;
#pragma unroll
      for (int n = 0; n < 4; ++n) ss += v[n][0] * v[n][0] + v[n][1] * v[n][1] + v[n][2] * v[n][2] + v[n][3] * v[n][3];
      { const int ln = fq * 16 + (row & 15); ss += shx(ss, 16, ln); ss += shx(ss, 32, ln); }
      if (cb < 256) {
        if (fq == 0 && atom) atomicAdd(p.ssq_q() + l * NTOK + row, ss);
#pragma unroll
        for (int n = 0; n < 4; ++n) st_bf4(p.cq() + (size_t)row * 256 + cb + n * 16 + c4, v[n]);
      } else {
        if (fq == 0 && atom) atomicAdd(p.ssq_kv() + l * NTOK + row, ss);
        const int c = cb - 256;
#pragma unroll
        for (int n = 0; n < 4; ++n) {
          st_bf4(p.ckvraw() + (size_t)row * 128 + c + n * 16 + c4, v[n]);
          if (ctx) *(f32x4*)(p.out + OUT_CKV + (size_t)((b * 2 + l) * 256 + t) * 128 + c + n * 16 + c4) = v[n];
        }
      }
    } else if (cb < 1152) {
      const int c = cb - 384;
#pragma unroll
      for (int n = 0; n < 4; ++n) st_bf4(p.convb() + (size_t)row * 768 + c + n * 16 + c4, v[n]);
    } else if (cb < 1664) {
      const int c = cb - 1152;
      if (!ctx) { rot4(v[0], v[1], p.ropeD(), 1024, pr * 16 + c4); rot4(v[2], v[3], p.ropeD(), 1024, pc * 16 + c4); }
#pragma unroll
      for (int n = 0; n < 4; ++n) { v[n] *= QSCALE_D; st_bf4(p.dq() + (size_t)row * 512 + c + n * 16 + c4, v[n]); }
    } else if (cb < 2176) {
      const int c = cb - 1664, h = c >> 7, a = (c >> 6) & 1;
      if (ctx) {
#pragma unroll
        for (int n = 0; n < 4; ++n) {
          *(f32x4*)(p.out + OUT_DK + (size_t)((b * 2 + l) * 256 + t) * 512 + c + n * 16 + c4) = v[n];
          st_bf4(p.KdC() + (size_t)(((b * 4 + h) * 2 + a) * 256 + t) * 64 + n * 16 + c4, v[n]);
        }
      } else {
        rot4(v[0], v[1], p.ropeD(), 1024, pr * 16 + c4); rot4(v[2], v[3], p.ropeD(), 1024, pc * 16 + c4);
#pragma unroll
        for (int n = 0; n < 4; ++n) st_bf4(p.KdL() + (size_t)l * 1310720 + (size_t)(((b * 4 + h) * 2 + a) * 1280 + 256 + t) * 64 + n * 16 + c4, v[n]);
      }
    } else if (cb < 2688) {
      const int c = cb - 2176, h = c >> 7, e0 = (c & 127) + c4;
      if (ctx) {
#pragma unroll
        for (int n = 0; n < 4; ++n) {
          *(f32x4*)(p.out + OUT_DV + (size_t)((b * 2 + l) * 256 + t) * 512 + c + n * 16 + c4) = v[n];
#pragma unroll
          for (int j = 0; j < 4; ++j) p.VdC()[(size_t)((b * 4 + h) * 128 + e0 + n * 16 + j) * 256 + t] = f2bf(v[n][j]);
        }
      } else {
#pragma unroll
        for (int n = 0; n < 4; ++n)
#pragma unroll
          for (int j = 0; j < 4; ++j) p.VdL()[(size_t)l * 1310720 + (size_t)((b * 4 + h) * 128 + e0 + n * 16 + j) * 1280 + 256 + t] = f2bf(v[n][j]);
      }
    } else if (cb < 3712) {
      const int c = cb - 2688;
#pragma unroll
      for (int n = 0; n < 4; ++n) {
        f32x4 s;
#pragma unroll
        for (int j = 0; j < 4; ++j) s[j] = silu_f(v[n][j]);
        st_bf4(p.zs() + (size_t)row * 1024 + c + n * 16 + c4, s);
      }
    } else if (cb == 3712) {
      const int o0 = (fq < 2) ? c4 : c4 + 8;
      if (ctx) {
        float* so = p.out + OUT_KR + (size_t)((b * 2 + l) * 256 + t) * 32 + o0;
        *(f32x4*)so = v[0];
        *(f32x4*)(so + 8) = v[1];
#pragma unroll
        for (int h = 0; h < 4; ++h) {
          bf16_t* d = p.KmC() + (size_t)((b * 4 + h) * 256 + t) * 96 + 64 + o0;
          st_bf4(d, v[0]); st_bf4(d + 8, v[1]);
        }
      } else {
        if (fq < 2) rot4(v[0], v[1], p.ropeM(), 512, pr * 8 + c4); else rot4(v[0], v[1], p.ropeM(), 512, pc * 8 + c4 - 8);
#pragma unroll
        for (int h = 0; h < 4; ++h) {
          bf16_t* d = p.KmL() + (size_t)l * 983040 + (size_t)((b * 4 + h) * 1280 + 256 + t) * 96 + 64 + o0;
          st_bf4(d, v[0]); st_bf4(d + 8, v[1]);
        }
      }
    }
  }
};

struct EpiQ {
  const Params& p; int l;
  template <int MB> DI void tile(int rbase, int cb, int fq, f32x4 (&acc)[MB][4]) const {
#pragma unroll
    for (int m = 0; m < MB; ++m) (*this)(rbase + m * 16, cb, fq, acc[m]);
  }
  DI void operator()(int row, int cb, int fq, f32x4 (&v)[4]) const {
    const bool ctx = row < NCTX;
    const int t = (row - NCTX) & 1023, pr = t >> 6, pc = t & 63, c4 = fq * 4;
    const float f = rsqrtf(p.ssq_q()[l * NTOK + row] * (1.f / 256.f) + EPS) * QSCALE_M;
#pragma unroll
    for (int g = 0; g < 2; ++g) {
      const int cs = cb + 32 * g;
      v[2 * g] *= f; v[2 * g + 1] *= f;
      if (cs % 96 == 64) {
        const int o0 = (fq < 2) ? c4 : c4 + 8;
        if (!ctx) { if (fq < 2) rot4(v[2 * g], v[2 * g + 1], p.ropeM(), 512, pr * 8 + c4); else rot4(v[2 * g], v[2 * g + 1], p.ropeM(), 512, pc * 8 + c4 - 8); }
        bf16_t* d = p.qm() + (size_t)row * 384 + cs + o0;
        st_bf4(d, v[2 * g]); st_bf4(d + 8, v[2 * g + 1]);
      } else {
        bf16_t* d = p.qm() + (size_t)row * 384 + cs + c4;
        st_bf4(d, v[2 * g]); st_bf4(d + 16, v[2 * g + 1]);
      }
    }
  }
};

struct EpiKV {
  const Params& p; int l; int mode;
  template <int MB> DI void tile(int rbase, int cb, int fq, f32x4 (&acc)[MB][4]) const {
#pragma unroll
    for (int m = 0; m < MB; ++m) (*this)(rbase + m * 16, cb, fq, acc[m]);
  }
  DI void operator()(int row, int cb, int fq, f32x4 (&v)[4]) const {
    const int h = cb >> 7, c4 = fq * 4;
    const bool isV = (cb & 64) != 0;
    float f = 1.f;
    bf16_t *kd, *vd; int vstride;
    if (mode == 0) {
      f = rsqrtf(p.ssq_kv()[l * NTOK + row] * (1.f / 128.f) + EPS);
      if (row < NCTX) {
        const int b = row >> 8, t = row & 255;
        kd = p.KmC() + (size_t)((b * 4 + h) * 256 + t) * 96; vd = p.VmC() + (size_t)((b * 4 + h) * 64) * 256 + t; vstride = 256;
      } else {
        const int b = (row - NCTX) >> 10, t = (row - NCTX) & 1023;
        kd = p.KmL() + (size_t)l * 983040 + (size_t)((b * 4 + h) * 1280 + 256 + t) * 96; vd = p.VmL() + (size_t)l * 655360 + (size_t)((b * 4 + h) * 64) * 1280 + 256 + t; vstride = 1280;
      }
    } else {
      const int b = row >> 8, t = row & 255;
      kd = p.KmL() + (size_t)l * 983040 + (size_t)((b * 4 + h) * 1280 + t) * 96; vd = p.VmL() + (size_t)l * 655360 + (size_t)((b * 4 + h) * 64) * 1280 + t; vstride = 1280;
    }
#pragma unroll
    for (int n = 0; n < 4; ++n) {
      v[n] *= f;
      if (!isV) st_bf4(kd + n * 16 + c4, v[n]);
      else {
#pragma unroll
        for (int j = 0; j < 4; ++j) vd[(size_t)(n * 16 + c4 + j) * vstride] = f2bf(v[n][j]);
      }
    }
  }
};

struct EpiOut {
  const Params& p; int l;
  template <int MB> DI void tile(int rbase, int cb, int fq, f32x4 (&acc)[MB][4]) const {
    const float* gate0 = p.mod() + (l * 3) * 3072 + 2048 + cb + fq * 4;
    f32x4 xv[MB][4];
#pragma unroll
    for (int m = 0; m < MB; ++m) {
      const int row = rbase + m * 16;
      const float* xo = (l == 0) ? (row < NCTX ? p.x_prompt + (size_t)row * 1024 : p.x_sample + (size_t)(row - NCTX) * 1024) : p.xbuf() + (size_t)row * 1024;
#pragma unroll
      for (int n = 0; n < 4; ++n) xv[m][n] = *(const f32x4*)(xo + cb + n * 16 + fq * 4);
    }
    __builtin_amdgcn_sched_barrier(0);
    const int ln = fq * 16 + (rbase & 15);
#pragma unroll
    for (int m = 0; m < MB; ++m) {
      const int row = rbase + m * 16;
      const int ci = row < NCTX ? 0 : 1 + ((row - NCTX) >> 10);
      float ss = 0.f;
#pragma unroll
      for (int n = 0; n < 4; ++n) {
        const int col = cb + n * 16 + fq * 4;
        const f32x4 g = *(const f32x4*)(gate0 + ci * 3072 + n * 16);
        f32x4 o;
#pragma unroll
        for (int j = 0; j < 4; ++j) { o[j] = xv[m][n][j] + g[j] * acc[m][n][j]; ss += o[j] * o[j]; }
        *(f32x4*)(p.xbuf() + (size_t)row * 1024 + col) = o;
        if (l == 0) {
          const f32x4 gg = *(const f32x4*)(p.norm_g + 1024 + col), sc = *(const f32x4*)(p.mod() + (3 + ci) * 3072 + 1024 + col);
          u32x2 pk = {pk2(o[0] * gg[0] * (1.f + sc[0]), o[1] * gg[1] * (1.f + sc[1])), pk2(o[2] * gg[2] * (1.f + sc[2]), o[3] * gg[3] * (1.f + sc[3]))};
          *(u32x2*)(p.hbuf() + (size_t)row * 1024 + col) = pk;
        }
      }
      ss += shx(ss, 16, ln); ss += shx(ss, 32, ln);
      if (fq == 0) atomicAdd(p.ssq_x() + (l + 1) * NTOK + row, ss);
    }
  }
};

template <int MINE, int THEIRS>
DI void diff_finalize(f32x16 (&O)[4], float f, float sgn, const float* __restrict__ subln, float osc, char* smem, int w, int lane, int hh,
                      bf16_t* __restrict__ orow, const bf16_t* __restrict__ zrow, bool active) {
  float* ex = (float*)smem;
  float* sx = ex + 4 * 32 * 64;
  if (active) {
#pragma unroll
    for (int d = 0; d < 2; ++d)
#pragma unroll
      for (int i = 0; i < 16; ++i) ex[(w * 32 + d * 16 + i) * 64 + lane] = O[THEIRS + d][i] * f;
  }
  __syncthreads();
  if (!active) { __syncthreads(); return; }
  const float* pe = ex + (w ^ 1) * 32 * 64;
  float ss = 0.f;
#pragma unroll
  for (int d = 0; d < 2; ++d)
#pragma unroll
    for (int i = 0; i < 16; ++i) {
      const float mine = O[MINE + d][i] * f, theirs = pe[(d * 16 + i) * 64 + lane];
      const float o = (sgn == 0.f) ? (mine - theirs) : (theirs - mine);
      O[MINE + d][i] = o; ss += o * o;
    }
  ss += shx(ss, 32, lane);
  sx[w * 64 + lane] = ss;
  __syncthreads();
  ss += sx[(w ^ 1) * 64 + lane];
  const float rs = rsqrtf(ss * (1.f / 128.f) + EPS) * osc;
#pragma unroll
  for (int d = 0; d < 2; ++d) {
#pragma unroll
    for (int g = 0; g < 4; ++g) {
      const int d0 = (MINE + d) * 32 + g * 8 + hh * 4;
      const f32x4 sg = *(const f32x4*)(subln + d0);
      const u32x2 z = *(const u32x2*)(zrow + d0);
      u32x2 o = {pk2(O[MINE + d][4 * g] * rs * sg[0] * bflo(z[0]), O[MINE + d][4 * g + 1] * rs * sg[1] * bfhi(z[0])),
                 pk2(O[MINE + d][4 * g + 2] * rs * sg[2] * bflo(z[1]), O[MINE + d][4 * g + 3] * rs * sg[3] * bfhi(z[1]))};
      *(u32x2*)(orow + d0) = o;
    }
    __builtin_amdgcn_sched_barrier(0);
  }
}

template <int DQK, int DV, bool DIFF, bool SPLIT>
DI void attn_item(const bf16_t* __restrict__ Qp, int ldq, const bf16_t* __restrict__ Kp, const bf16_t* __restrict__ Vtp, int nkeys,
                  bf16_t* __restrict__ outp, const bf16_t* __restrict__ zsp, float lamf, const float* __restrict__ subln, float osc, char* smem, int tid,
                  int warm_n = 0, int warm_share = 0) {
  constexpr int NMAPK = DIFF ? 2 : 1;
  constexpr int KROW = (DQK + 8) * 2;
  constexpr int KMAPB = 64 * KROW;
  constexpr int VROW = 136;
  constexpr int NS = DQK / 16, NDB = DV / 32;
  constexpr int BUFB = NMAPK * KMAPB + DV * VROW;
  constexpr int NT = SPLIT ? 2 : 1;
  char* sK = smem;
  char* sV = smem + NMAPK * KMAPB;
  const int lane = tid & 63, w = tid >> 6, r = lane & 31, hh = lane >> 5;
  const int kh = SPLIT ? (w >> 1) : 0;
  const int qb = SPLIT ? (DIFF ? 0 : (w & 1)) : (DIFF ? (w >> 1) : w);
  const int am = DIFF ? (w & 1) : 0;
  bf16x8 qf[NS];
#pragma unroll
  for (int s = 0; s < NS; ++s) qf[s] = *(const bf16x8*)(Qp + (size_t)(qb * 32 + r) * ldq + am * 64 + s * 16 + hh * 8);
  f32x16 O[NDB];
  float mrun = -1e30f, lrun = 0.f;
#pragma unroll
  for (int db = 0; db < NDB; ++db)
#pragma unroll
    for (int i = 0; i < 16; ++i) O[db][i] = 0.f;
  const char* sKa = sK + am * KMAPB + r * KROW + hh * 16;
  const char* sVa = sV + r * VROW + hh * 8;
  const int nkt = nkeys >> 6, nit = SPLIT ? (nkt >> 1) : nkt;
  constexpr int KCH = 64 * DQK / 8;
  constexpr int NKC = (KCH + 255) / 256, NVC = DV * 8 / 256;
  u32x4 kreg[NT][NMAPK][NKC], vreg[NT][NVC];
#define ATT_GLOAD(J)                                                                               \
  {                                                                                                \
    _Pragma("unroll") for (int t = 0; t < NT; ++t) {                                               \
      const int tile = t * nit + (J);                                                              \
      _Pragma("unroll") for (int a = 0; a < NMAPK; ++a) {                                          \
        const bf16_t* kg = Kp + (size_t)a * nkeys * DQK + (size_t)tile * 64 * DQK;                  \
        _Pragma("unroll") for (int c = 0; c < NKC; ++c) {                                          \
          const int ch = c * 256 + tid;                                                            \
          if (KCH % 256 == 0 || ch < KCH) kreg[t][a][c] = *(const u32x4*)(kg + (size_t)ch * 8);     \
        }                                                                                          \
      }                                                                                            \
      const bf16_t* vg = Vtp + (size_t)tile * 64;                                                   \
      _Pragma("unroll") for (int c = 0; c < NVC; ++c) {                                            \
        const int ch = c * 256 + tid, d = ch >> 3, part = ch & 7;                                  \
        vreg[t][c] = *(const u32x4*)(vg + (size_t)d * nkeys + part * 8);                            \
      }                                                                                            \
    }                                                                                              \
    __builtin_amdgcn_sched_barrier(0);                                                             \
  }
#define ATT_SWRITE(BUF)                                                                            \
  {                                                                                                \
    _Pragma("unroll") for (int t = 0; t < NT; ++t) {                                               \
      char* bK = sK + (SPLIT ? t : (BUF)) * BUFB;                                                  \
      char* bV = sV + (SPLIT ? t : (BUF)) * BUFB;                                                  \
      _Pragma("unroll") for (int a = 0; a < NMAPK; ++a) _Pragma("unroll") for (int c = 0; c < NKC; ++c) { \
        const int ch = c * 256 + tid;                                                              \
        if (KCH % 256 == 0 || ch < KCH) {                                                          \
          const int key = ch / (DQK / 8), part = ch % (DQK / 8);                                   \
          *(u32x4*)(bK + a * KMAPB + key * KROW + part * 16) = kreg[t][a][c];                       \
        }                                                                                          \
      }                                                                                            \
      _Pragma("unroll") for (int c = 0; c < NVC; ++c) {                                            \
        const int ch = c * 256 + tid, d = ch >> 3, part = ch & 7;                                  \
        u32x2 lo = {vreg[t][c][0], vreg[t][c][1]}, hi = {vreg[t][c][2], vreg[t][c][3]};            \
        *(u32x2*)(bV + d * VROW + part * 16) = lo;                                                 \
        *(u32x2*)(bV + d * VROW + part * 16 + 8) = hi;                                             \
      }                                                                                            \
    }                                                                                              \
  }
  auto compute = [&](const char* sKb, const char* sVb) {
    f32x16 st[2];
#pragma unroll
    for (int kb = 0; kb < 2; ++kb) {
#pragma unroll
      for (int i = 0; i < 16; ++i) st[kb][i] = 0.f;
#pragma unroll
      for (int s = 0; s < NS; ++s) {
        const bf16x8 kf = *(const bf16x8*)(sKb + kb * 32 * KROW + s * 32);
        st[kb] = MFMA32(kf, qf[s], st[kb]);
      }
    }
    float mx = st[0][0];
#pragma unroll
    for (int i = 1; i < 16; ++i) mx = fmaxf(mx, st[0][i]);
#pragma unroll
    for (int i = 0; i < 16; ++i) mx = fmaxf(mx, st[1][i]);
    mx = fmaxf(mx, shx(mx, 32, lane));
    const float mnew = fmaxf(mrun, mx);
    const float alpha = __builtin_amdgcn_exp2f(mrun - mnew);
    mrun = mnew;
    float ls = 0.f;
#pragma unroll
    for (int kb = 0; kb < 2; ++kb)
#pragma unroll
      for (int i = 0; i < 16; ++i) { const float e = __builtin_amdgcn_exp2f(st[kb][i] - mnew); st[kb][i] = e; ls += e; }
    lrun = lrun * alpha + ls;
    if (__builtin_amdgcn_ballot_w64(alpha != 1.f) != 0) {
#pragma unroll
      for (int db = 0; db < NDB; ++db)
#pragma unroll
        for (int i = 0; i < 16; ++i) O[db][i] *= alpha;
    }
#pragma unroll
    for (int kb = 0; kb < 2; ++kb)
#pragma unroll
      for (int t2 = 0; t2 < 2; ++t2) {
        u32x4 pp;
#pragma unroll
        for (int j = 0; j < 4; ++j) pp[j] = pk2(st[kb][8 * t2 + 2 * j], st[kb][8 * t2 + 2 * j + 1]);
        const bf16x8 pf = __builtin_bit_cast(bf16x8, pp);
#pragma unroll
        for (int db = 0; db < NDB; ++db) {
          const char* vb = sVb + db * 32 * VROW + (kb * 32 + 16 * t2) * 2;
          const u32x2 lo = *(const u32x2*)vb, hi = *(const u32x2*)(vb + 16);
          const u32x4 vv = {lo[0], lo[1], hi[0], hi[1]};
          O[db] = MFMA32(__builtin_bit_cast(bf16x8, vv), pf, O[db]);
        }
        if constexpr (DIFF && SPLIT) __builtin_amdgcn_sched_barrier(0);
      }
  };
  ATT_GLOAD(0);
  unsigned w0 = 0u, w1 = 0u;
  if (warm_n > 0) {
    const int lk = (NMAPK * nkeys * DQK * 2 / 128) / warm_n, lv = (DV * nkeys * 2 / 128) / warm_n;
    if (tid < lk) w0 = *(const volatile unsigned*)((const char*)Kp + (size_t)(warm_share * lk + tid) * 128);
    if (tid < lv) w1 = *(const volatile unsigned*)((const char*)Vtp + (size_t)(warm_share * lv + tid) * 128);
  }
  if constexpr (!SPLIT) {
    __syncthreads();
    ATT_SWRITE(0);
    if (nit > 1) ATT_GLOAD(1);
    __syncthreads();
    for (int kt = 0; kt < nit; ++kt) {
      if (kt + 1 < nit) {
        ATT_SWRITE((kt + 1) & 1);
        if (kt + 2 < nit) ATT_GLOAD(kt + 2);
      }
      compute(sKa + (kt & 1) * BUFB, sVa + (kt & 1) * BUFB);
      __syncthreads();
    }
  } else {
    for (int j = 0; j < nit; ++j) {
      __syncthreads();
      ATT_SWRITE(0);
      __syncthreads();
      if (j + 1 < nit) ATT_GLOAD(j + 1);
      compute(sKa + kh * BUFB, sVa + kh * BUFB);
    }
    __syncthreads();
    float* mg = (float*)(smem + 36864);
    float* mlb = mg + 2 * NDB * 16 * 64;
    const int wl = w & 1;
    if (kh == 1) {
#pragma unroll
      for (int db = 0; db < NDB; ++db)
#pragma unroll
        for (int i = 0; i < 16; ++i) mg[((wl * NDB + db) * 16 + i) * 64 + lane] = O[db][i];
      mlb[(wl * 2 + 0) * 64 + lane] = mrun;
      mlb[(wl * 2 + 1) * 64 + lane] = lrun;
    }
    __syncthreads();
    if (kh == 0) {
      const float m1 = mlb[(wl * 2 + 0) * 64 + lane], l1 = mlb[(wl * 2 + 1) * 64 + lane];
      const float mn = fmaxf(mrun, m1);
      const float s0 = __builtin_amdgcn_exp2f(mrun - mn), s1 = __builtin_amdgcn_exp2f(m1 - mn);
      lrun = lrun * s0 + l1 * s1;
      mrun = mn;
#pragma unroll
      for (int db = 0; db < NDB; ++db)
#pragma unroll
        for (int i = 0; i < 16; ++i) O[db][i] = O[db][i] * s0 + mg[((wl * NDB + db) * 16 + i) * 64 + lane] * s1;
    }
  }
#undef ATT_GLOAD
#undef ATT_SWRITE
  const float inv = 1.f / (lrun + shx(lrun, 32, lane));
  const size_t ro = (size_t)(qb * 32 + r) * 1024;
  const bool active = (kh == 0);
  if constexpr (DIFF) {
    __syncthreads();
    if (am == 0) diff_finalize<0, 2>(O, inv, 0.f, subln, osc, smem, w, lane, hh, outp + ro, zsp + ro, active);
    else diff_finalize<2, 0>(O, inv * lamf, 1.f, subln, osc, smem, w, lane, hh, outp + ro, zsp + ro, active);
  } else {
    if (active) {
#pragma unroll
      for (int db = 0; db < NDB; ++db) {
#pragma unroll
        for (int g = 0; g < 4; ++g) {
          const int d0 = db * 32 + g * 8 + hh * 4;
          const u32x2 z = *(const u32x2*)(zsp + ro + d0);
          u32x2 o = {pk2(O[db][4 * g] * inv * bflo(z[0]), O[db][4 * g + 1] * inv * bfhi(z[0])), pk2(O[db][4 * g + 2] * inv * bflo(z[1]), O[db][4 * g + 3] * inv * bfhi(z[1]))};
          *(u32x2*)(outp + ro + d0) = o;
        }
        __builtin_amdgcn_sched_barrier(0);
      }
    }
  }
  if ((w0 ^ w1) == 0x7fc54321u && warm_n < 0) ((volatile unsigned*)smem)[0] = w0;
}

DI void conv_item(const Params& p, int l, int it, int tid) {
  const int ch = (tid & 31) * 8, rr = tid >> 5;
  float w0[8], w1[8], w2[8];
#pragma unroll
  for (int j = 0; j < 8; ++j) { w0[j] = p.conv_w[l * 768 + ch + j]; w1[j] = p.conv_w[l * 768 + 256 + ch + j]; w2[j] = p.conv_w[l * 768 + 512 + ch + j]; }
  for (int i = 0; i < 16; ++i) {
    const int row = it * 128 + i * 8 + rr;
    int t, len;
    if (row < NCTX) { t = row & 255; len = 256; } else { t = (row - NCTX) & 1023; len = 1024; }
    const bf16_t* base = p.convb() + (size_t)row * 768;
    const u32x4 zero = {0u, 0u, 0u, 0u};
    const u32x4 cbv = *(const u32x4*)(base + ch);
    const u32x4 c1 = *(const u32x4*)(base + 256 + ch), x1 = *(const u32x4*)(base + 512 + ch);
    const u32x4 c0 = t > 0 ? *(const u32x4*)(base - 768 + 256 + ch) : zero, x0 = t > 0 ? *(const u32x4*)(base - 768 + 512 + ch) : zero;
    const u32x4 c2 = t < len - 1 ? *(const u32x4*)(base + 768 + 256 + ch) : zero, x2 = t < len - 1 ? *(const u32x4*)(base + 768 + 512 + ch) : zero;
    const u32x4 zv = *(const u32x4*)(p.zs() + (size_t)row * 1024 + 256 + ch);
    u32x4 o;
#pragma unroll
    for (int q = 0; q < 4; ++q) {
      const float ylo = bflo(c0[q]) * bflo(x0[q]) * w0[2 * q] + bflo(c1[q]) * bflo(x1[q]) * w1[2 * q] + bflo(c2[q]) * bflo(x2[q]) * w2[2 * q];
      const float yhi = bfhi(c0[q]) * bfhi(x0[q]) * w0[2 * q + 1] + bfhi(c1[q]) * bfhi(x1[q]) * w1[2 * q + 1] + bfhi(c2[q]) * bfhi(x2[q]) * w2[2 * q + 1];
      o[q] = pk2(bflo(cbv[q]) * ylo * bflo(zv[q]), bfhi(cbv[q]) * yhi * bfhi(zv[q]));
    }
    *(u32x4*)(p.mix() + (size_t)row * 1024 + 256 + ch) = o;
  }
}

DI void phase_mix(const Params& p, int l, char* smem, int mask = 7) {
  const int lane = opaque_tid() & 63;
  const float* lm = p.lam + l * 256;
  const float s01 = wave_sum(lm[lane] * lm[64 + lane], lane), s23 = wave_sum(lm[128 + lane] * lm[192 + lane], lane);
  const float lam_init = (l == 0) ? 0.2f : 0.35550906759096934f;
  const float lamf = __int_as_float(__builtin_amdgcn_readfirstlane(__float_as_int(__expf(s01) - __expf(s23) + lam_init)));
  const float osc = 1.f - lam_init;
  const int bid = opaque_bid(), G = gridDim.x;
  for (int slot = 0;; ++slot) {
    int it;
    if (G == 512) {
      if (slot == 0) it = bid;
      else if (slot == 1) it = bid < 128 ? -1 : bid < 192 ? 704 + (bid - 128) : bid < 384 ? 512 + (bid - 192) : 768 + (bid - 384);
      else if (slot == 2) it = bid < 384 ? -1 : bid < 448 ? 896 + (bid - 384) : 960 + (bid - 448);
      else if (slot == 3) it = (bid >= 192 && bid < 208) ? 1024 + (bid - 192) : -1;
      else break;
      if (it < 0) continue;
    } else {
      it = slot * G + bid;
      if (it >= 1040) break;
    }
    int tid = threadIdx.x;
    asm volatile("" : "+v"(tid));
#if REP >= 40
    { const bool isdiff = it < 128 || (it >= 192 && it < 704), ismla = (it >= 128 && it < 192) || (it >= 704 && it < 960), islat = it < 192;
      if (mask == 1 && !isdiff) continue; if (mask == 2 && !ismla) continue; if (mask == 3 && !islat) continue; if (mask == 4 && !(isdiff && islat)) continue; }
#endif
    if (it < 128 || (it >= 192 && it < 704)) {
      int b, h, qt; size_t row0; const bf16_t *kp, *vp; int nk;
      if (it < 128) {
        const int x = it & 7; b = x >> 2; h = x & 3; qt = it >> 3; row0 = NCTX + b * 1024 + qt * 64; nk = 1280;
        kp = p.KdL() + (size_t)l * 1310720 + (size_t)((b * 4 + h) * 2) * 1280 * 64; vp = p.VdL() + (size_t)l * 1310720 + (size_t)((b * 4 + h) * 128) * 1280;
      } else {
        const int j = it - 192, combo = (j & 7) | ((j >> 5) << 3); b = combo >> 2; h = combo & 3; qt = (j >> 3) & 3; row0 = b * 256 + qt * 64; nk = 256;
        kp = p.KdC() + (size_t)((b * 4 + h) * 2) * 256 * 64; vp = p.VdC() + (size_t)((b * 4 + h) * 128) * 256;
      }
      attn_item<64, 128, true, false>(p.dq() + row0 * 512 + h * 128, 512, kp, vp, nk, p.mix() + row0 * 1024 + 512 + h * 128, p.zs() + row0 * 1024 + 512 + h * 128,
                                      lamf, p.subln + l * 128, osc, smem, tid, it < 128 ? 16 : 0, qt);
    } else if (it < 960) {
      int b, h, qt; size_t row0; const bf16_t *kp, *vp; int nk;
      if (it < 192) {
        const int j = it - 128, x = j & 7; b = x >> 2; h = x & 3; qt = j >> 3; row0 = NCTX + b * 1024 + qt * 128; nk = 1280;
        kp = p.KmL() + (size_t)l * 983040 + (size_t)(b * 4 + h) * 1280 * 96; vp = p.VmL() + (size_t)l * 655360 + (size_t)((b * 4 + h) * 64) * 1280;
      } else {
        const int j = it - 704, combo = (j & 7) | ((j >> 4) << 3); b = combo >> 2; h = combo & 3; qt = (j >> 3) & 1; row0 = b * 256 + qt * 128; nk = 256;
        kp = p.KmC() + (size_t)(b * 4 + h) * 256 * 96; vp = p.VmC() + (size_t)((b * 4 + h) * 64) * 256;
      }
      attn_item<96, 64, false, false>(p.qm() + row0 * 384 + h * 96, 384, kp, vp, nk, p.mix() + row0 * 1024 + h * 64, p.zs() + row0 * 1024 + h * 64, 0.f, nullptr, 1.f, smem, tid, it < 192 ? 8 : 0, qt);
    } else {
      conv_item(p, l, it - 960, tid);
    }
  }
}

DI void phase_inproj(const Params& p, int l, char* smem, bool atom = true, bool skip = false) {
  EpiIn epi{p, l, atom, skip};
  const int tid = opaque_tid(), bid = opaque_bid();
  const int xcd = bid & 7, nloc = (gridDim.x + 7 - xcd) >> 3;
  for (int j = bid >> 3; j < 300; j += nloc) {
    const int mt = xcd * 10 + j % 10, nt = j / 10;
    gemm_tile<4, 2>(p.hbuf(), 1024, p.WinT() + (size_t)l * NP * 1024, 1024, 1024, mt * 128, nt * 128, epi, smem, tid);
  }
}

DI void phase_upproj(const Params& p, int l, char* smem, bool fix = true) {
  const int tid = opaque_tid(), bid = opaque_bid();
  if (fix) {
    const float* g = p.kv_norm + l * 128;
    for (int i = bid * 256 + tid; i < NCTX * 32; i += gridDim.x * 256) {
      const int row = i >> 5, c = (i & 31) * 4, b = row >> 8, t = row & 255;
      const float f = rsqrtf(p.ssq_kv()[l * NTOK + row] * (1.f / 128.f) + EPS);
      float* d = p.out + OUT_CKV + (size_t)((b * 2 + l) * 256 + t) * 128 + c;
      f32x4 v = *(f32x4*)d;
      const f32x4 gg = *(const f32x4*)(g + c);
#pragma unroll
      for (int j = 0; j < 4; ++j) v[j] *= f * gg[j];
      *(f32x4*)d = v;
    }
  }
  EpiQ eq{p, l};
  EpiKV ek0{p, l, 0}, ek1{p, l, 1};
  for (int it = bid; it < 464; it += gridDim.x) {
    if (it < 192) {
      const int mt = it / 3, nt = it % 3;
      gemm_tile<5, 1>(p.cq(), 256, p.WuqT() + (size_t)l * 384 * 256, 256, 256, mt * 160, nt * 128, eq, smem, tid);
    } else if (it < 448) {
      const int j = it - 192, mt = j >> 2, nt = j & 3;
      gemm_tile<5, 1>(p.ckvraw(), 128, p.WukvTf() + (size_t)l * 512 * 128, 128, 128, mt * 160, nt * 128, ek0, smem, tid);
    } else {
      const int j = it - 448, mt = j >> 2, nt = j & 3;
      gemm_tile<4, 1>(p.cckv() + (size_t)l * 65536, 128, p.WukvT() + (size_t)l * 512 * 128, 128, 128, mt * 128, nt * 128, ek1, smem, tid);
    }
  }
}

DI void phase_outproj(const Params& p, int l, char* smem) {
  EpiOut epi{p, l};
  const int tid = opaque_tid(), bid = opaque_bid();
  for (int it = bid; it < 512; it += gridDim.x) {
    const int mt = it >> 3, nt = it & 7;
    gemm_tile<5, 1>(p.mix(), 1024, p.WoutT() + (size_t)l * 1024 * 1024, 1024, 1024, mt * 160, nt * 128, epi, smem, tid);
  }
}

__global__ void __launch_bounds__(256, 2) fwd_megakernel(Params p) {
  __shared__ __attribute__((aligned(16))) char smem[73728];
  __shared__ __attribute__((aligned(16))) unsigned xb_words[4];
  cg::grid_group grid = cg::this_grid();
  if (p.ws == nullptr) grid.sync();
  if (threadIdx.x == 0) { xb_words[0] = 0u; xb_words[1] = 0u; xb_words[2] = 0u; xb_words[3] = 0u; }
  __syncthreads();
  const XcdBarrier xb = xcd_barrier_post(p.bar(), (volatile LAS unsigned*)xb_words);
#define GSYNC() xcd_barrier(xb)
  phase0(p, smem);
#if REP == 0
  GSYNC(); phase0(p, smem);
#endif
#pragma unroll
  for (int l = 0; l < 2; ++l) {
    GSYNC();
    if (l == 0) { phase_norm(p, 0); GSYNC(); }
#if REP == 2
    phase_inproj(p, l, smem, false); GSYNC();
#endif
#if REP == 7
    phase_inproj(p, l, smem, false, p.ws != nullptr); GSYNC();
#endif
    phase_inproj(p, l, smem);
    GSYNC();
#if REP == 3
    phase_upproj(p, l, smem, false); GSYNC();
#endif
    phase_upproj(p, l, smem);
    GSYNC();
#if REP == 4
    phase_mix(p, l, smem); GSYNC();
#endif
#if REP >= 40
    phase_mix(p, l, smem, REP - 40); GSYNC();
#endif
    phase_mix(p, l, smem);
    GSYNC();
#if REP == 5
    if (l == 0) { phase_outproj(p, l, smem); GSYNC(); }
#endif
    phase_outproj(p, l, smem);
  }
  GSYNC();
  phase_norm(p, 2);
#if REP == 6
  for (int i = 0; i < 10; ++i) GSYNC();
#endif
}

extern "C" void kernel_launch(void* const* d_in, const int* in_sizes, int n_in, void* d_out, int out_size, void* d_ws, size_t ws_size, hipStream_t stream) {
  static int grid_blocks = 0;
  if (!grid_blocks) {
    int dev = 0, cus = 0, per_cu = 0;
    hipGetDevice(&dev);
    hipDeviceGetAttribute(&cus, hipDeviceAttributeMultiprocessorCount, dev);
    hipOccupancyMaxActiveBlocksPerMultiprocessor(&per_cu, fwd_megakernel, 256, 0);
    if (per_cu > 2) per_cu = 2;
    if (per_cu < 1) per_cu = 1;
    grid_blocks = cus * per_cu;
  }
  Params p{};
  p.x_prompt = (const float*)d_in[0]; p.x_sample = (const float*)d_in[1]; p.c = (const float*)d_in[2];
  p.cache_ckv = (const float*)d_in[3]; p.cache_krope = (const float*)d_in[4]; p.cache_dk = (const float*)d_in[5]; p.cache_dv = (const float*)d_in[6];
  p.c_ctx = (const float*)d_in[7]; p.norm_g = (const float*)d_in[8]; p.ada_w = (const float*)d_in[9]; p.ada_b = (const float*)d_in[10];
  p.w_in = (const float*)d_in[11]; p.q_norm = (const float*)d_in[12]; p.w_uq = (const float*)d_in[13]; p.kv_norm = (const float*)d_in[14];
  p.w_ukv = (const float*)d_in[15]; p.conv_w = (const float*)d_in[16]; p.lam = (const float*)d_in[17]; p.subln = (const float*)d_in[18];
  p.w_out = (const float*)d_in[19]; p.final_norm = (const float*)d_in[20];
  p.out = (float*)d_out;
  p.ws = (char*)d_ws;
  if (ws_size < WS_TOTAL) fprintf(stderr, "workspace too small\n");
  hipMemsetAsync(d_ws, 0, XCD_BAR_WORDS * 4, stream);
  void* args[] = {&p};
  hipError_t e = hipLaunchCooperativeKernel((void*)fwd_megakernel, dim3(grid_blocks), dim3(256), args, 0, stream);
  if (e != hipSuccess) fprintf(stderr, "cooperative launch failed: %s (grid %d)\n", hipGetErrorString(e), grid_blocks);
}
```

```cpp
#include <hip/hip_runtime.h>
#include <hip/hip_cooperative_groups.h>
#include <cstdio>
namespace cg = cooperative_groups;

typedef unsigned short bf16_t;
typedef short bf16x8 __attribute__((ext_vector_type(8)));
typedef float f32x2 __attribute__((ext_vector_type(2)));
typedef float f32x4 __attribute__((ext_vector_type(4)));
typedef float f32x16 __attribute__((ext_vector_type(16)));
typedef unsigned u32x2 __attribute__((ext_vector_type(2)));
typedef unsigned u32x4 __attribute__((ext_vector_type(4)));
typedef __bf16 bf16x2_t __attribute__((ext_vector_type(2)));

#ifndef REP
#define REP -1
#endif
#define DI __device__ __forceinline__
#define MFMA16(a, b, c) __builtin_amdgcn_mfma_f32_16x16x32_bf16((a), (b), (c), 0, 0, 0)
#define MFMA32(a, b, c) __builtin_amdgcn_mfma_f32_32x32x16_bf16((a), (b), (c), 0, 0, 0)

#define XCD_BAR_WORDS 3456
constexpr int NCTX = 8192, NTOK = 10240, NP = 3840;
constexpr float EPS = 1e-6f;
constexpr float QSCALE_M = 0.14724444602590306f;
constexpr float QSCALE_D = 0.18033688011112042f;
constexpr size_t OUT_CKV = 10485760, OUT_KR = 12582912, OUT_DK = 13107200, OUT_DV = 21495808;

__constant__ float INV16[16] = {1.000000000e+00f, 5.623413324e-01f, 3.162277639e-01f, 1.778279394e-01f, 1.000000015e-01f, 5.623413250e-02f, 3.162277490e-02f, 1.778279431e-02f,
                                9.999999776e-03f, 5.623413250e-03f, 3.162277630e-03f, 1.778279431e-03f, 1.000000047e-03f, 5.623413017e-04f, 3.162277571e-04f, 1.778279402e-04f};
__constant__ float INV8[8] = {1.000000000e+00f, 3.162277639e-01f, 1.000000015e-01f, 3.162277490e-02f, 9.999999776e-03f, 3.162277630e-03f, 1.000000047e-03f, 3.162277571e-04f};

constexpr size_t al256(size_t x) { return (x + 255) & ~(size_t)255; }
constexpr size_t OFF_bar = 0;
constexpr size_t OFF_mod = OFF_bar + al256(XCD_BAR_WORDS * 4);
constexpr size_t OFF_WinT = OFF_mod + al256((size_t)2 * 3 * 3072 * 4);
constexpr size_t OFF_WoutT = OFF_WinT + al256((size_t)2 * NP * 1024 * 2);
constexpr size_t OFF_WuqT = OFF_WoutT + al256((size_t)2 * 1024 * 1024 * 2);
constexpr size_t OFF_WukvTf = OFF_WuqT + al256((size_t)2 * 384 * 256 * 2);
constexpr size_t OFF_WukvT = OFF_WukvTf + al256((size_t)2 * 512 * 128 * 2);
constexpr size_t OFF_ssq_q = OFF_WukvT + al256((size_t)2 * 512 * 128 * 2);
constexpr size_t OFF_ssq_kv = OFF_ssq_q + al256((size_t)2 * NTOK * 4);
constexpr size_t OFF_ssq_x = OFF_ssq_kv + al256((size_t)2 * NTOK * 4);
constexpr size_t OFF_bw = OFF_ssq_x + al256((size_t)3 * NTOK * 4);
constexpr size_t OFF_ropeD = OFF_bw + al256((size_t)2 * 3 * NP * 4);
constexpr size_t OFF_ropeM = OFF_ropeD + al256(2048 * 4);
constexpr size_t OFF_wq = OFF_ropeM + al256(1024 * 4);
constexpr size_t OFF_hbuf = OFF_wq + al256(256);
constexpr size_t OFF_cq = OFF_hbuf + al256((size_t)NTOK * 1024 * 2);
constexpr size_t OFF_ckvraw = OFF_cq + al256((size_t)NTOK * 256 * 2);
constexpr size_t OFF_cckv = OFF_ckvraw + al256((size_t)NTOK * 128 * 2);
constexpr size_t OFF_convb = OFF_cckv + al256((size_t)2 * 512 * 128 * 2);
constexpr size_t OFF_dq = OFF_convb + al256((size_t)NTOK * 768 * 2);
constexpr size_t OFF_zs = OFF_dq + al256((size_t)NTOK * 512 * 2);
constexpr size_t OFF_qm = OFF_zs + al256((size_t)NTOK * 1024 * 2);
constexpr size_t OFF_KmC = OFF_qm + al256((size_t)NTOK * 384 * 2);
constexpr size_t OFF_KmL = OFF_KmC + al256((size_t)32 * 4 * 256 * 96 * 2);
constexpr size_t OFF_VmC = OFF_KmL + al256((size_t)2 * 983040 * 2);
constexpr size_t OFF_VmL = OFF_VmC + al256((size_t)32 * 4 * 64 * 256 * 2);
constexpr size_t OFF_KdC = OFF_VmL + al256((size_t)2 * 655360 * 2);
constexpr size_t OFF_KdL = OFF_KdC + al256((size_t)32 * 4 * 2 * 256 * 64 * 2);
constexpr size_t OFF_VdC = OFF_KdL + al256((size_t)2 * 1310720 * 2);
constexpr size_t OFF_VdL = OFF_VdC + al256((size_t)32 * 4 * 128 * 256 * 2);
constexpr size_t OFF_mix = OFF_VdL + al256((size_t)2 * 1310720 * 2);
constexpr size_t OFF_xbuf = OFF_mix + al256((size_t)NTOK * 1024 * 2);
constexpr size_t WS_TOTAL = OFF_xbuf + al256((size_t)NTOK * 1024 * 4);

struct Params {
  const float *x_prompt, *x_sample, *c, *cache_ckv, *cache_krope, *cache_dk, *cache_dv, *c_ctx;
  const float *norm_g, *ada_w, *ada_b, *w_in, *q_norm, *w_uq, *kv_norm, *w_ukv, *conv_w, *lam, *subln, *w_out, *final_norm;
  float* out;
  char* ws;
  DI unsigned* bar() const { return (unsigned*)(ws + OFF_bar); }
  DI bf16_t* WinT() const { return (bf16_t*)(ws + OFF_WinT); }
  DI bf16_t* WoutT() const { return (bf16_t*)(ws + OFF_WoutT); }
  DI bf16_t* WuqT() const { return (bf16_t*)(ws + OFF_WuqT); }
  DI bf16_t* WukvTf() const { return (bf16_t*)(ws + OFF_WukvTf); }
  DI bf16_t* WukvT() const { return (bf16_t*)(ws + OFF_WukvT); }
  DI float* mod() const { return (float*)(ws + OFF_mod); }
  DI float* ssq_q() const { return (float*)(ws + OFF_ssq_q); }
  DI float* ssq_kv() const { return (float*)(ws + OFF_ssq_kv); }
  DI float* ssq_x() const { return (float*)(ws + OFF_ssq_x); }
  DI float* bw() const { return (float*)(ws + OFF_bw); }
  DI float* ropeD() const { return (float*)(ws + OFF_ropeD); }
  DI float* ropeM() const { return (float*)(ws + OFF_ropeM); }
  DI int* wq() const { return (int*)(ws + OFF_wq); }
  DI bf16_t* hbuf() const { return (bf16_t*)(ws + OFF_hbuf); }
  DI bf16_t* cq() const { return (bf16_t*)(ws + OFF_cq); }
  DI bf16_t* ckvraw() const { return (bf16_t*)(ws + OFF_ckvraw); }
  DI bf16_t* cckv() const { return (bf16_t*)(ws + OFF_cckv); }
  DI bf16_t* convb() const { return (bf16_t*)(ws + OFF_convb); }
  DI bf16_t* dq() const { return (bf16_t*)(ws + OFF_dq); }
  DI bf16_t* zs() const { return (bf16_t*)(ws + OFF_zs); }
  DI bf16_t* qm() const { return (bf16_t*)(ws + OFF_qm); }
  DI bf16_t* KmC() const { return (bf16_t*)(ws + OFF_KmC); }
  DI bf16_t* KmL() const { return (bf16_t*)(ws + OFF_KmL); }
  DI bf16_t* VmC() const { return (bf16_t*)(ws + OFF_VmC); }
  DI bf16_t* VmL() const { return (bf16_t*)(ws + OFF_VmL); }
  DI bf16_t* KdC() const { return (bf16_t*)(ws + OFF_KdC); }
  DI bf16_t* KdL() const { return (bf16_t*)(ws + OFF_KdL); }
  DI bf16_t* VdC() const { return (bf16_t*)(ws + OFF_VdC); }
  DI bf16_t* VdL() const { return (bf16_t*)(ws + OFF_VdL); }
  DI bf16_t* mix() const { return (bf16_t*)(ws + OFF_mix); }
  DI float* xbuf() const { return (float*)(ws + OFF_xbuf); }
};

DI unsigned pk2(float a, float b) {
  f32x2 v = {a, b};
  bf16x2_t r = __builtin_convertvector(v, bf16x2_t);
  return __builtin_bit_cast(unsigned, r);
}
DI float bflo(unsigned u) { return __uint_as_float(u << 16); }
DI float bfhi(unsigned u) { return __uint_as_float(u & 0xffff0000u); }
DI bf16_t f2bf(float a) { return (bf16_t)(pk2(a, 0.f) & 0xffffu); }
DI float shx(float v, int o, int lane) { return __int_as_float(__builtin_amdgcn_ds_bpermute((lane ^ o) << 2, __float_as_int(v))); }
DI float wave_sum(float v, int lane) {
#pragma unroll
  for (int o = 32; o >= 1; o >>= 1) v += shx(v, o, lane);
  return v;
}
DI int opaque_tid() { int t = threadIdx.x; asm volatile("" : "+v"(t)); return t; }
DI int opaque_bid() { int b = blockIdx.x; asm volatile("" : "+s"(b)); return b; }
DI int rope_perm(int P) { return (P & 7) | ((P & 8) << 1) | ((P & 16) >> 1); }


#define XB_TMO      128
#define XB_XCNT(j)  (256  + 64 * (j))
#define XB_XSUB(j)  (1280 + 64 * (j))
#define XB_XGEN(j)  (2304 + 64 * (j))
#define XB_TOP      3328
#define XB_TOPGEN   3392
#define XB_SPIN_CAP (1u << 18)
DI unsigned xb_ld(unsigned* p)              { return __hip_atomic_load(p, __ATOMIC_RELAXED, __HIP_MEMORY_SCOPE_AGENT); }
DI unsigned xb_add(unsigned* p, unsigned v) { return __hip_atomic_fetch_add(p, v, __ATOMIC_RELAXED, __HIP_MEMORY_SCOPE_AGENT); }
DI unsigned xb_xcc_id() { return (unsigned)__builtin_amdgcn_s_getreg((3 << 11) | 20) & 0xFu; }
#define XB_SPIN(cond, bar) do { unsigned _sp = 0; while (cond) { __builtin_amdgcn_s_sleep(1); \
    if ((++_sp & 255u) == 0u) { if (xb_ld(&(bar)[XB_TMO])) break; if (_sp > XB_SPIN_CAP) { atomicAdd(&(bar)[XB_TMO], 1u); break; } } } } while (0)
#define LAS __attribute__((address_space(3)))
struct XcdBarrier { unsigned* bar; unsigned x; volatile LAS unsigned* st; };
DI XcdBarrier xcd_barrier_post(unsigned* bar, volatile LAS unsigned* st) {
  XcdBarrier b; b.bar = bar; b.x = xb_xcc_id(); b.st = st;
  if (threadIdx.x == 0) (void)xb_add(&bar[XB_XCNT(b.x)], 1u);
  return b;
}
DI void xcd_barrier_complete(unsigned* bar, unsigned x, unsigned& nloc, unsigned& nx) {
  const unsigned G = gridDim.x * gridDim.y * gridDim.z;
  unsigned sum, cnt, mine, sp = 0u;
  for (;;) {
    sum = 0u; cnt = 0u; mine = 0u;
#pragma unroll
    for (unsigned j = 0; j < 16; ++j) { const unsigned c = xb_ld(&bar[XB_XCNT(j)]); sum += c; cnt += (c > 0u) ? 1u : 0u; mine = (j == x) ? c : mine; }
    if (sum == G) break;
    __builtin_amdgcn_s_sleep(1);
    if ((++sp & 255u) == 0u) { if (xb_ld(&bar[XB_TMO])) break; if (sp > XB_SPIN_CAP) { atomicAdd(&bar[XB_TMO], 1u); break; } }
  }
  nloc = mine > 0u ? mine : 1u; nx = cnt > 0u ? cnt : 1u;
}
DI void xcd_barrier(const XcdBarrier& b) {
  asm volatile("s_waitcnt vmcnt(0)" ::: "memory");
  __syncthreads();
  if (threadIdx.x == 0) {
    unsigned* bar = b.bar;
    __builtin_amdgcn_s_waitcnt(0);
    unsigned nloc = b.st[0], nx = b.st[1];
    if (nloc == 0u) { xcd_barrier_complete(bar, b.x, nloc, nx); b.st[0] = nloc; b.st[1] = nx; }
    const unsigned old = xb_add(&bar[XB_XSUB(b.x)], 1u);
    const unsigned gen = old / nloc;
    if (old + 1u == (gen + 1u) * nloc) {
      __builtin_amdgcn_fence(__ATOMIC_RELEASE, "agent");
      asm volatile("s_waitcnt vmcnt(0)" ::: "memory");
      const unsigned og = xb_add(&bar[XB_TOP], 1u);
      const unsigned tg = og / nx;
      if (og + 1u == (tg + 1u) * nx) xb_add(&bar[XB_TOPGEN], 1u);
      else XB_SPIN(xb_ld(&bar[XB_TOPGEN]) == tg, bar);
      __builtin_amdgcn_fence(__ATOMIC_ACQUIRE, "agent");
      xb_add(&bar[XB_XGEN(b.x)], 1u);
      asm volatile("s_waitcnt vmcnt(0)" ::: "memory");
    } else {
      XB_SPIN(xb_ld(&bar[XB_XGEN(b.x)]) == gen, bar);
      __builtin_amdgcn_fence(__ATOMIC_ACQUIRE, "agent");
      asm volatile("s_waitcnt vmcnt(0)" ::: "memory");
    }
  }
  __syncthreads();
}

struct ColMapIn { DI int operator()(int n) const { if (n < 384) return n; if (n < 3712) return n + 32; if (n < 3744) return 384 + rope_perm(n - 3712); return -1; } };
struct ColMapId { DI int operator()(int n) const { return n; } };
struct ColMapUq { DI int operator()(int n) const { int h = n / 96, c = n - h * 96; if (c >= 64) c = 64 + rope_perm(c - 64); return h * 96 + c; } };

template <class CM>
DI void tconv_tile(const float* __restrict__ src, int ldsrc, bf16_t* __restrict__ dst, int K, int n0, int k0, const float* __restrict__ kscale, CM cm, float* sm, int tid) {
  const int tq = tid & 15, ty = tid >> 4;
  const int sc = cm(n0 + tq * 4);
  f32x4 v[4];
#pragma unroll
  for (int i = 0; i < 4; ++i) {
    const int kk = ty + i * 16;
    v[i] = (f32x4){0.f, 0.f, 0.f, 0.f};
    if (sc >= 0) v[i] = *(const f32x4*)(src + (size_t)(k0 + kk) * ldsrc + sc);
  }
#pragma unroll
  for (int i = 0; i < 4; ++i) {
    const int kk = ty + i * 16;
    const float s = kscale ? kscale[k0 + kk] : 1.f;
#pragma unroll
    for (int j = 0; j < 4; ++j) sm[kk * 65 + tq * 4 + j] = v[i][j] * s;
  }
  __syncthreads();
  const int kc = tid & 7, nn = tid >> 3;
#pragma unroll
  for (int ps = 0; ps < 2; ++ps) {
    const int n = nn + ps * 32;
    u32x4 o;
#pragma unroll
    for (int i = 0; i < 4; ++i) o[i] = pk2(sm[(kc * 8 + 2 * i) * 65 + n], sm[(kc * 8 + 2 * i + 1) * 65 + n]);
    *(u32x4*)(dst + (size_t)(n0 + n) * K + k0 + kc * 8) = o;
  }
  __syncthreads();
}

DI float silu_f(float x) { return x / (1.f + __expf(-x)); }

DI void mod_item(const Params& p, int it, float* sm, int tid) {
  const int l = it / 192, r = it % 192, cg = r >> 4, kc = r & 15;
  const int c4 = tid & 63, rg = tid >> 6;
  const int k0 = kc * 64 + rg * 16;
  const float* W = p.ada_w + (size_t)l * 1024 * 3072 + (size_t)k0 * 3072 + cg * 256 + c4 * 4;
  f32x4 w[16];
#pragma unroll
  for (int i = 0; i < 16; ++i) w[i] = *(const f32x4*)(W + (size_t)i * 3072);
  float a0[4] = {0, 0, 0, 0}, a1[4] = {0, 0, 0, 0}, a2[4] = {0, 0, 0, 0};
#pragma unroll
  for (int i = 0; i < 16; ++i) {
    const int k = k0 + i;
    const float s0 = silu_f(p.c_ctx[k]), s1 = silu_f(p.c[k]), s2 = silu_f(p.c[1024 + k]);
#pragma unroll
    for (int j = 0; j < 4; ++j) { a0[j] += s0 * w[i][j]; a1[j] += s1 * w[i][j]; a2[j] += s2 * w[i][j]; }
  }
#pragma unroll
  for (int j = 0; j < 4; ++j) {
    sm[(rg * 3 + 0) * 256 + c4 * 4 + j] = a0[j];
    sm[(rg * 3 + 1) * 256 + c4 * 4 + j] = a1[j];
    sm[(rg * 3 + 2) * 256 + c4 * 4 + j] = a2[j];
  }
  __syncthreads();
#pragma unroll
  for (int ci = 0; ci < 3; ++ci) {
    float s = sm[(0 * 3 + ci) * 256 + tid] + sm[(1 * 3 + ci) * 256 + tid] + sm[(2 * 3 + ci) * 256 + tid] + sm[(3 * 3 + ci) * 256 + tid];
    const int col = cg * 256 + tid;
    if (kc == 0) s += p.ada_b[l * 3072 + col];
    atomicAdd(p.mod() + (l * 3 + ci) * 3072 + col, s);
  }
  __syncthreads();
}

DI void sincos_d(float ang, float& c, float& s) {
  const double TWO_PI = 6.283185307179586476925286766559;
  double x = (double)ang;
  x = x - TWO_PI * rint(x / TWO_PI);
  const double x2 = x * x;
  double ts = 1.0, tc = 1.0;
#pragma unroll
  for (int k = 12; k >= 1; --k) {
    ts = 1.0 - ts * x2 / (double)((2 * k) * (2 * k + 1));
    tc = 1.0 - tc * x2 / (double)((2 * k - 1) * (2 * k));
  }
  s = (float)(x * ts);
  c = (float)tc;
}

struct TcDesc { const float* src; bf16_t* dst; const float* kscale; int ld, K, n0, k0, sc; };
DI void tc_decode(const Params& p, int it, int tid, TcDesc& d) {
  const int tq = tid & 15;
  if (it < 1920) {
    const int l = it / 960, r = it % 960;
    d.src = p.w_in + (size_t)l * 1024 * 3744; d.ld = 3744; d.dst = p.WinT() + (size_t)l * NP * 1024; d.K = 1024; d.n0 = (r % 60) * 64; d.k0 = (r / 60) * 64; d.kscale = nullptr;
    d.sc = ColMapIn()(d.n0 + tq * 4);
  } else if (it < 2432) {
    const int j = it - 1920, l = j / 256, r = j % 256;
    d.src = p.w_out + (size_t)l * 1024 * 1024; d.ld = 1024; d.dst = p.WoutT() + (size_t)l * 1024 * 1024; d.K = 1024; d.n0 = (r % 16) * 64; d.k0 = (r / 16) * 64; d.kscale = nullptr;
    d.sc = d.n0 + tq * 4;
  } else if (it < 2480) {
    const int j = it - 2432, l = j / 24, r = j % 24;
    d.src = p.w_uq + (size_t)l * 256 * 384; d.ld = 384; d.dst = p.WuqT() + (size_t)l * 384 * 256; d.K = 256; d.n0 = (r % 6) * 64; d.k0 = (r / 6) * 64; d.kscale = p.q_norm + l * 256;
    d.sc = ColMapUq()(d.n0 + tq * 4);
  } else {
    const int j = (it - 2480) & 31, l = j / 16, r = j % 16;
    const bool folded = it < 2512;
    d.src = p.w_ukv + (size_t)l * 128 * 512; d.ld = 512; d.dst = (folded ? p.WukvTf() : p.WukvT()) + (size_t)l * 512 * 128; d.K = 128; d.n0 = (r % 8) * 64; d.k0 = (r / 8) * 64;
    d.kscale = folded ? p.kv_norm + l * 128 : nullptr;
    d.sc = d.n0 + tq * 4;
  }
}
DI void tc_load(const TcDesc& d, int tid, f32x4 (&v)[4]) {
  const int ty = tid >> 4;
#pragma unroll
  for (int i = 0; i < 4; ++i) {
    v[i] = (f32x4){0.f, 0.f, 0.f, 0.f};
    if (d.sc >= 0) v[i] = *(const f32x4*)(d.src + (size_t)(d.k0 + ty + i * 16) * d.ld + d.sc);
  }
  __builtin_amdgcn_sched_barrier(0);
}
DI void tc_finish(const TcDesc& d, int tid, f32x4 (&v)[4], float* sm) {
  const int tq = tid & 15, ty = tid >> 4;
#pragma unroll
  for (int i = 0; i < 4; ++i) {
    const int kk = ty + i * 16;
    const float s = d.kscale ? d.kscale[d.k0 + kk] : 1.f;
#pragma unroll
    for (int j = 0; j < 4; ++j) sm[kk * 65 + tq * 4 + j] = v[i][j] * s;
  }
  __syncthreads();
  const int kc = tid & 7, nn = tid >> 3;
#pragma unroll
  for (int ps = 0; ps < 2; ++ps) {
    const int n = nn + ps * 32;
    u32x4 o;
#pragma unroll
    for (int i = 0; i < 4; ++i) o[i] = pk2(sm[(kc * 8 + 2 * i) * 65 + n], sm[(kc * 8 + 2 * i + 1) * 65 + n]);
    *(u32x4*)(d.dst + (size_t)(d.n0 + n) * d.K + d.k0 + kc * 8) = o;
  }
  __syncthreads();
}

DI void phase0(const Params& p, char* smem) {
  float* sm = (float*)smem;
  const int tid = opaque_tid(), bid = opaque_bid();
  const int G = gridDim.x;
  for (int it = bid; it < 384; it += G) mod_item(p, it, sm, tid);
  {
    TcDesc da, db;
    f32x4 va[4], vb[4];
    int it = bid;
    bool ha = it < 2544;
    if (ha) { tc_decode(p, it, tid, da); tc_load(da, tid, va); }
    while (ha) {
      const int itb = it + G;
      const bool hb = itb < 2544;
      if (hb) { tc_decode(p, itb, tid, db); tc_load(db, tid, vb); }
      tc_finish(da, tid, va, sm);
      if (!hb) break;
      it = itb + G;
      ha = it < 2544;
      if (ha) { tc_decode(p, it, tid, da); tc_load(da, tid, va); }
      tc_finish(db, tid, vb, sm);
    }
  }
  const int gstride = gridDim.x * 256, g0 = bid * 256 + tid;
  for (int i0 = g0; i0 < 524288; i0 += 4 * gstride) {
    float v[4];
#pragma unroll
    for (int u = 0; u < 4; ++u) {
      const int i = i0 + u * gstride;
      if (i < 524288) { const int cc = i & 511, t = (i >> 9) & 255, b = (i >> 17) & 1, l = i >> 18; v[u] = p.cache_dk[(size_t)((b * 2 + l) * 256 + t) * 512 + cc]; }
    }
#pragma unroll
    for (int u = 0; u < 4; ++u) {
      const int i = i0 + u * gstride;
      if (i < 524288) {
        const int cc = i & 511, t = (i >> 9) & 255, b = (i >> 17) & 1, l = i >> 18, h = cc >> 7, a = (cc >> 6) & 1, d = cc & 63;
        p.KdL()[(size_t)l * 1310720 + (size_t)(((b * 4 + h) * 2 + a) * 1280 + t) * 64 + d] = f2bf(v[u]);
      }
    }
  }
  for (int i0 = g0; i0 < 524288; i0 += 4 * gstride) {
    float v[4];
#pragma unroll
    for (int u = 0; u < 4; ++u) {
      const int j = i0 + u * gstride;
      if (j < 524288) { const int t = j & 255, e = (j >> 8) & 127, h = (j >> 15) & 3, b = (j >> 17) & 1, l = j >> 18; v[u] = p.cache_dv[(size_t)((b * 2 + l) * 256 + t) * 512 + h * 128 + e]; }
    }
#pragma unroll
    for (int u = 0; u < 4; ++u) {
      const int j = i0 + u * gstride;
      if (j < 524288) { const int t = j & 255, e = (j >> 8) & 127, h = (j >> 15) & 3, b = (j >> 17) & 1, l = j >> 18; p.VdL()[(size_t)l * 1310720 + (size_t)((b * 4 + h) * 128 + e) * 1280 + t] = f2bf(v[u]); }
    }
  }
  const int E2 = 131072, E3 = E2 + 131072, E4 = E3 + 1536, E5 = E4 + 40960 + 30720;
  for (int i = g0; i < E5; i += gstride) {
    if (i < E2) {
      const int j = i;
      const int r = j & 31, h = (j >> 5) & 3, t = (j >> 7) & 255, b = (j >> 15) & 1, l = j >> 16;
      p.KmL()[(size_t)l * 983040 + (size_t)((b * 4 + h) * 1280 + t) * 96 + 64 + r] = f2bf(p.cache_krope[(size_t)((b * 2 + l) * 256 + t) * 32 + r]);
    } else if (i < E3) {
      const int j = i - E2;
      const int cc = j & 127, t = (j >> 7) & 255, b = (j >> 15) & 1, l = j >> 16;
      p.cckv()[(size_t)l * 65536 + (b * 256 + t) * 128 + cc] = f2bf(p.cache_ckv[(size_t)((b * 2 + l) * 256 + t) * 128 + cc]);
    } else if (i < E4) {
      const int j = i - E3;
      float cs, sn;
      if (j < 1024) {
        const int pos = j >> 4, f = j & 15;
        sincos_d((float)pos * INV16[f], cs, sn);
        p.ropeD()[j] = cs; p.ropeD()[1024 + j] = sn;
      } else {
        const int jj = j - 1024, pos = jj >> 3, f = jj & 7;
        sincos_d((float)pos * INV8[f], cs, sn);
        p.ropeM()[jj] = cs; p.ropeM()[512 + jj] = sn;
      }
    } else {
      const int j = i - E4;
      if (j < 20480) p.ssq_q()[j] = 0.f; else if (j < 40960) p.ssq_kv()[j - 20480] = 0.f; else p.ssq_x()[j - 40960] = 0.f;
      if (j < 64) p.wq()[j] = 0;
    }
  }
}

DI void phase_norm(const Params& p, int l) {
  const int tid = opaque_tid(), bid = opaque_bid();
  const int lane = tid & 63;
  const int gw = bid * 4 + (tid >> 6), nw = gridDim.x * 4;
  if (l == 0) {
    for (int it = gw; it < 2 * NP; it += nw) {
      const int ll = it / NP, n = it % NP;
      const bf16_t* wrow = p.WinT() + ((size_t)ll * NP + n) * 1024 + lane * 16;
      const u32x4 w0 = *(const u32x4*)wrow, w1 = *(const u32x4*)(wrow + 8);
      float wv[16];
#pragma unroll
      for (int q = 0; q < 4; ++q) { wv[2 * q] = bflo(w0[q]); wv[2 * q + 1] = bfhi(w0[q]); wv[8 + 2 * q] = bflo(w1[q]); wv[8 + 2 * q + 1] = bfhi(w1[q]); }
#pragma unroll
      for (int ci = 0; ci < 3; ++ci) {
        const float* sh = p.mod() + (ll * 3 + ci) * 3072 + lane * 16;
        float s = 0.f;
#pragma unroll
        for (int q = 0; q < 4; ++q) { const f32x4 sv = *(const f32x4*)(sh + q * 4); s += sv[0] * wv[q * 4] + sv[1] * wv[q * 4 + 1] + sv[2] * wv[q * 4 + 2] + sv[3] * wv[q * 4 + 3]; }
        s = wave_sum(s, lane);
        if (lane == 0) p.bw()[(ll * 3 + ci) * NP + n] = s;
      }
    }
  }
  for (int row = gw; row < NTOK; row += nw) {
    const float* x = (l == 0) ? (row < NCTX ? p.x_prompt + (size_t)row * 1024 : p.x_sample + (size_t)(row - NCTX) * 1024) : p.xbuf() + (size_t)row * 1024;
    f32x4 v[4];
#pragma unroll
    for (int i = 0; i < 4; ++i) v[i] = *(const f32x4*)(x + i * 256 + lane * 4);
    if (l == 0) {
      float ss = 0.f;
#pragma unroll
      for (int i = 0; i < 4; ++i) ss += v[i][0] * v[i][0] + v[i][1] * v[i][1] + v[i][2] * v[i][2] + v[i][3] * v[i][3];
      ss = wave_sum(ss, lane);
      if (lane == 0) p.ssq_x()[row] = ss;
      const int ci = row < NCTX ? 0 : 1 + ((row - NCTX) >> 10);
      const float* md = p.mod() + ci * 3072;
#pragma unroll
      for (int i = 0; i < 4; ++i) {
        const int k = i * 256 + lane * 4;
        const f32x4 gg = *(const f32x4*)(p.norm_g + k), sc = *(const f32x4*)(md + 1024 + k);
        float o[4];
#pragma unroll
        for (int j = 0; j < 4; ++j) o[j] = v[i][j] * gg[j] * (1.f + sc[j]);
        u32x2 pk = {pk2(o[0], o[1]), pk2(o[2], o[3])};
        *(u32x2*)(p.hbuf() + (size_t)row * 1024 + k) = pk;
      }
    } else {
      const float rstd = rsqrtf(p.ssq_x()[2 * NTOK + row] * (1.f / 1024.f) + EPS);
#pragma unroll
      for (int i = 0; i < 4; ++i) {
        const int k = i * 256 + lane * 4;
        const f32x4 gg = *(const f32x4*)(p.final_norm + k);
        f32x4 o;
#pragma unroll
        for (int j = 0; j < 4; ++j) o[j] = v[i][j] * rstd * gg[j];
        *(f32x4*)(p.out + (size_t)row * 1024 + k) = o;
      }
    }
  }
}

template <int MB, int DEPTH, class Epi>
DI void gemm_tile(const bf16_t* __restrict__ A, int lda, const bf16_t* __restrict__ Bt, int ldb, int K, int row0, int col0, const Epi& epi, char* smem, int tid) {
  constexpr int ABYTES = MB * 32 * 128, STAGE = ABYTES + 16384;
  const int lane = tid & 63, w = tid >> 6, wr = w >> 1, wc = w & 1, fr = lane & 15, fq = lane >> 4;
  const int lrow = tid >> 3, lc8 = tid & 7, lch = lc8 >> 2, lrr = lrow & 15;
  const char* Ab = (const char*)(A + (size_t)row0 * lda);
  const char* Bb = (const char*)(Bt + (size_t)col0 * ldb);
  const unsigned voa = (unsigned)(lrow * lda + lc8 * 8) * 2u, vob = (unsigned)(lrow * ldb + lc8 * 8) * 2u;
  const int wbase = ((lrow >> 4) * 2 + lch) * 1024 + ((((lrr ^ lch) * 64) + (lc8 & 3) * 16) ^ ((lrr >> 3) << 5));
  const int rlo = (fr * 64 + fq * 16) ^ ((fr >> 3) << 5);
  u32x4 ra[DEPTH][MB], rb[DEPTH][4];
  f32x4 acc[MB][4];
#pragma unroll
  for (int m = 0; m < MB; ++m)
#pragma unroll
    for (int n = 0; n < 4; ++n) acc[m][n] = (f32x4){0.f, 0.f, 0.f, 0.f};
  const int nk = K >> 6;
#define GLOAD(S, K0)                                                                               \
  {                                                                                                \
    _Pragma("unroll") for (int ps = 0; ps < MB; ++ps) ra[S][ps] = *(const u32x4*)(Ab + ((size_t)ps * 64 * lda + (K0) * 2) + voa); \
    _Pragma("unroll") for (int ps = 0; ps < 4; ++ps) rb[S][ps] = *(const u32x4*)(Bb + ((size_t)ps * 64 * ldb + (K0) * 2) + vob);  \
    __builtin_amdgcn_sched_barrier(0);                                                             \
  }
#define SSTORE(S, BUF)                                                                             \
  {                                                                                                \
    char* sw = smem + (BUF) * STAGE + wbase;                                                       \
    _Pragma("unroll") for (int ps = 0; ps < MB; ++ps) *(u32x4*)(sw + ps * 4096) = ra[S][ps];        \
    _Pragma("unroll") for (int ps = 0; ps < 4; ++ps) *(u32x4*)(sw + ABYTES + ps * 4096) = rb[S][ps]; \
  }
#define COMPUTE(BUF)                                                                               \
  {                                                                                                \
    const char* sa = smem + (BUF) * STAGE;                                                         \
    const char* sb = sa + ABYTES;                                                                  \
    _Pragma("unroll") for (int kk = 0; kk < 2; ++kk) {                                             \
      bf16x8 af[MB], bfr[4];                                                                       \
      const int ro = kk * 1024 + (rlo ^ (kk * 64));                                                \
      _Pragma("unroll") for (int m = 0; m < MB; ++m) af[m] = *(const bf16x8*)(sa + (wr * MB + m) * 2048 + ro); \
      _Pragma("unroll") for (int n = 0; n < 4; ++n) bfr[n] = *(const bf16x8*)(sb + (wc * 4 + n) * 2048 + ro);  \
      __builtin_amdgcn_s_setprio(1);                                                               \
      _Pragma("unroll") for (int m = 0; m < MB; ++m) _Pragma("unroll") for (int n = 0; n < 4; ++n) acc[m][n] = MFMA16(bfr[n], af[m], acc[m][n]); \
      __builtin_amdgcn_s_setprio(0);                                                               \
    }                                                                                              \
  }
  if constexpr (DEPTH == 2) {
    GLOAD(0, 0);
    GLOAD(1, 64);
    SSTORE(0, 0);
    __syncthreads();
    for (int kt = 0; kt < nk; kt += 2) {
      if (kt + 2 < nk) GLOAD(0, (kt + 2) * 64);
      COMPUTE(0);
      SSTORE(1, 1);
      __syncthreads();
      if (kt + 3 < nk) GLOAD(1, (kt + 3) * 64);
      COMPUTE(1);
      if (kt + 2 < nk) SSTORE(0, 0);
      __syncthreads();
    }
  } else {
    GLOAD(0, 0);
    SSTORE(0, 0);
    __syncthreads();
    for (int kt = 0; kt < nk; kt += 2) {
      GLOAD(0, (kt + 1) * 64);
      COMPUTE(0);
      SSTORE(0, 1);
      __syncthreads();
      if (kt + 2 < nk) GLOAD(0, (kt + 2) * 64);
      COMPUTE(1);
      if (kt + 2 < nk) SSTORE(0, 0);
      __syncthreads();
    }
  }
#undef GLOAD
#undef SSTORE
#undef COMPUTE
  epi.template tile<MB>(row0 + wr * MB * 16 + fr, col0 + wc * 64, fq, acc);
}

DI void st_bf4(bf16_t* dst, const f32x4& v) {
  u32x2 o = {pk2(v[0], v[1]), pk2(v[2], v[3])};
  *(u32x2*)dst = o;
}

DI void rot4(f32x4& x0, f32x4& x1, const float* tab, int toff, int idx) {
  const f32x4 cs = *(const f32x4*)(tab + idx), sn = *(const f32x4*)(tab + toff + idx);
#pragma unroll
  for (int j = 0; j < 4; ++j) {
    const float a = x0[j], b = x1[j];
    x0[j] = a * cs[j] - b * sn[j];
    x1[j] = b * cs[j] + a * sn[j];
  }
}

struct EpiIn {
  const Params& p; int l; bool atom; bool skip;
  template <int MB> DI void tile(int rbase, int cb, int fq, f32x4 (&acc)[MB][4]) const {
    const float* bwp = p.bw() + (l * 3 + (rbase < NCTX ? 0 : 1 + ((rbase - NCTX) >> 10))) * NP + cb + fq * 4;
    f32x4 bb[4];
    float rs[MB];
#pragma unroll
    for (int n = 0; n < 4; ++n) bb[n] = *(const f32x4*)(bwp + n * 16);
#pragma unroll
    for (int m = 0; m < MB; ++m) rs[m] = p.ssq_x()[l * NTOK + rbase + m * 16];
#pragma unroll
    for (int m = 0; m < MB; ++m) {
      const float r = rsqrtf(rs[m] * (1.f / 1024.f) + EPS);
#pragma unroll
      for (int n = 0; n < 4; ++n)
#pragma unroll
        for (int j = 0; j < 4; ++j) acc[m][n][j] = acc[m][n][j] * r + bb[n][j];
      (*this)(rbase + m * 16, cb, fq, acc[m]);
    }
  }
  DI void operator()(int row, int cb, int fq, f32x4 (&v)[4]) const {
    if (skip) return;
    const bool ctx = row < NCTX;
    int b, t;
    if (ctx) { b = row >> 8; t = row & 255; } else { b = (row - NCTX) >> 10; t = (row - NCTX) & 1023; }
    const int pr = t >> 6, pc = t & 63;
    const int c4 = fq * 4;
    if (cb < 384) {
      float ss = 0.f;
#pragma unroll
      for (int n = 0; n < 4; ++n) ss += v[n][0] * v[n][0] + v[n][1] * v[n][1] + v[n][2] * v[n][2] + v[n][3] * v[n][3];
      { const int ln = fq * 16 + (row & 15); ss += shx(ss, 16, ln); ss += shx(ss, 32, ln); }
      if (cb < 256) {
        if (fq == 0 && atom) atomicAdd(p.ssq_q() + l * NTOK + row, ss);
#pragma unroll
        for (int n = 0; n < 4; ++n) st_bf4(p.cq() + (size_t)row * 256 + cb + n * 16 + c4, v[n]);
      } else {
        if (fq == 0 && atom) atomicAdd(p.ssq_kv() + l * NTOK + row, ss);
        const int c = cb - 256;
#pragma unroll
        for (int n = 0; n < 4; ++n) {
          st_bf4(p.ckvraw() + (size_t)row * 128 + c + n * 16 + c4, v[n]);
          if (ctx) *(f32x4*)(p.out + OUT_CKV + (size_t)((b * 2 + l) * 256 + t) * 128 + c + n * 16 + c4) = v[n];
        }
      }
    } else if (cb < 1152) {
      const int c = cb - 384;
#pragma unroll
      for (int n = 0; n < 4; ++n) st_bf4(p.convb() + (size_t)row * 768 + c + n * 16 + c4, v[n]);
    } else if (cb < 1664) {
      const int c = cb - 1152;
      if (!ctx) { rot4(v[0], v[1], p.ropeD(), 1024, pr * 16 + c4); rot4(v[2], v[3], p.ropeD(), 1024, pc * 16 + c4); }
#pragma unroll
      for (int n = 0; n < 4; ++n) { v[n] *= QSCALE_D; st_bf4(p.dq() + (size_t)row * 512 + c + n * 16 + c4, v[n]); }
    } else if (cb < 2176) {
      const int c = cb - 1664, h = c >> 7, a = (c >> 6) & 1;
      if (ctx) {
#pragma unroll
        for (int n = 0; n < 4; ++n) {
          *(f32x4*)(p.out + OUT_DK + (size_t)((b * 2 + l) * 256 + t) * 512 + c + n * 16 + c4) = v[n];
          st_bf4(p.KdC() + (size_t)(((b * 4 + h) * 2 + a) * 256 + t) * 64 + n * 16 + c4, v[n]);
        }
      } else {
        rot4(v[0], v[1], p.ropeD(), 1024, pr * 16 + c4); rot4(v[2], v[3], p.ropeD(), 1024, pc * 16 + c4);
#pragma unroll
        for (int n = 0; n < 4; ++n) st_bf4(p.KdL() + (size_t)l * 1310720 + (size_t)(((b * 4 + h) * 2 + a) * 1280 + 256 + t) * 64 + n * 16 + c4, v[n]);
      }
    } else if (cb < 2688) {
      const int c = cb - 2176, h = c >> 7, e0 = (c & 127) + c4;
      if (ctx) {
#pragma unroll
        for (int n = 0; n < 4; ++n) {
          *(f32x4*)(p.out + OUT_DV + (size_t)((b * 2 + l) * 256 + t) * 512 + c + n * 16 + c4) = v[n];
#pragma unroll
          for (int j = 0; j < 4; ++j) p.VdC()[(size_t)((b * 4 + h) * 128 + e0 + n * 16 + j) * 256 + t] = f2bf(v[n][j]);
        }
      } else {
#pragma unroll
        for (int n = 0; n < 4; ++n)
#pragma unroll
          for (int j = 0; j < 4; ++j) p.VdL()[(size_t)l * 1310720 + (size_t)((b * 4 + h) * 128 + e0 + n * 16 + j) * 1280 + 256 + t] = f2bf(v[n][j]);
      }
    } else if (cb < 3712) {
      const int c = cb - 2688;
#pragma unroll
      for (int n = 0; n < 4; ++n) {
        f32x4 s;
#pragma unroll
        for (int j = 0; j < 4; ++j) s[j] = silu_f(v[n][j]);
        st_bf4(p.zs() + (size_t)row * 1024 + c + n * 16 + c4, s);
      }
    } else if (cb == 3712) {
      const int o0 = (fq < 2) ? c4 : c4 + 8;
      if (ctx) {
        float* so = p.out + OUT_KR + (size_t)((b * 2 + l) * 256 + t) * 32 + o0;
        *(f32x4*)so = v[0];
        *(f32x4*)(so + 8) = v[1];
#pragma unroll
        for (int h = 0; h < 4; ++h) {
          bf16_t* d = p.KmC() + (size_t)((b * 4 + h) * 256 + t) * 96 + 64 + o0;
          st_bf4(d, v[0]); st_bf4(d + 8, v[1]);
        }
      } else {
        if (fq < 2) rot4(v[0], v[1], p.ropeM(), 512, pr * 8 + c4); else rot4(v[0], v[1], p.ropeM(), 512, pc * 8 + c4 - 8);
#pragma unroll
        for (int h = 0; h < 4; ++h) {
          bf16_t* d = p.KmL() + (size_t)l * 983040 + (size_t)((b * 4 + h) * 1280 + 256 + t) * 96 + 64 + o0;
          st_bf4(d, v[0]); st_bf4(d + 8, v[1]);
        }
      }
    }
  }
};

struct EpiQ {
  const Params& p; int l;
  template <int MB> DI void tile(int rbase, int cb, int fq, f32x4 (&acc)[MB][4]) const {
#pragma unroll
    for (int m = 0; m < MB; ++m) (*this)(rbase + m * 16, cb, fq, acc[m]);
  }
  DI void operator()(int row, int cb, int fq, f32x4 (&v)[4]) const {
    const bool ctx = row < NCTX;
    const int t = (row - NCTX) & 1023, pr = t >> 6, pc = t & 63, c4 = fq * 4;
    const float f = rsqrtf(p.ssq_q()[l * NTOK + row] * (1.f / 256.f) + EPS) * QSCALE_M;
#pragma unroll
    for (int g = 0; g < 2; ++g) {
      const int cs = cb + 32 * g;
      v[2 * g] *= f; v[2 * g + 1] *= f;
      if (cs % 96 == 64) {
        const int o0 = (fq < 2) ? c4 : c4 + 8;
        if (!ctx) { if (fq < 2) rot4(v[2 * g], v[2 * g + 1], p.ropeM(), 512, pr * 8 + c4); else rot4(v[2 * g], v[2 * g + 1], p.ropeM(), 512, pc * 8 + c4 - 8); }
        bf16_t* d = p.qm() + (size_t)row * 384 + cs + o0;
        st_bf4(d, v[2 * g]); st_bf4(d + 8, v[2 * g + 1]);
      } else {
        bf16_t* d = p.qm() + (size_t)row * 384 + cs + c4;
        st_bf4(d, v[2 * g]); st_bf4(d + 16, v[2 * g + 1]);
      }
    }
  }
};

struct EpiKV {
  const Params& p; int l; int mode;
  template <int MB> DI void tile(int rbase, int cb, int fq, f32x4 (&acc)[MB][4]) const {
#pragma unroll
    for (int m = 0; m < MB; ++m) (*this)(rbase + m * 16, cb, fq, acc[m]);
  }
  DI void operator()(int row, int cb, int fq, f32x4 (&v)[4]) const {
    const int h = cb >> 7, c4 = fq * 4;
    const bool isV = (cb & 64) != 0;
    float f = 1.f;
    bf16_t *kd, *vd; int vstride;
    if (mode == 0) {
      f = rsqrtf(p.ssq_kv()[l * NTOK + row] * (1.f / 128.f) + EPS);
      if (row < NCTX) {
        const int b = row >> 8, t = row & 255;
        kd = p.KmC() + (size_t)((b * 4 + h) * 256 + t) * 96; vd = p.VmC() + (size_t)((b * 4 + h) * 64) * 256 + t; vstride = 256;
      } else {
        const int b = (row - NCTX) >> 10, t = (row - NCTX) & 1023;
        kd = p.KmL() + (size_t)l * 983040 + (size_t)((b * 4 + h) * 1280 + 256 + t) * 96; vd = p.VmL() + (size_t)l * 655360 + (size_t)((b * 4 + h) * 64) * 1280 + 256 + t; vstride = 1280;
      }
    } else {
      const int b = row >> 8, t = row & 255;
      kd = p.KmL() + (size_t)l * 983040 + (size_t)((b * 4 + h) * 1280 + t) * 96; vd = p.VmL() + (size_t)l * 655360 + (size_t)((b * 4 + h) * 64) * 1280 + t; vstride = 1280;
    }
#pragma unroll
    for (int n = 0; n < 4; ++n) {
      v[n] *= f;
      if (!isV) st_bf4(kd + n * 16 + c4, v[n]);
      else {
#pragma unroll
        for (int j = 0; j < 4; ++j) vd[(size_t)(n * 16 + c4 + j) * vstride] = f2bf(v[n][j]);
      }
    }
  }
};

struct EpiOut {
  const Params& p; int l;
  template <int MB> DI void tile(int rbase, int cb, int fq, f32x4 (&acc)[MB][4]) const {
    const float* gate0 = p.mod() + (l * 3) * 3072 + 2048 + cb + fq * 4;
    f32x4 xv[MB][4];
#pragma unroll
    for (int m = 0; m < MB; ++m) {
      const int row = rbase + m * 16;
      const float* xo = (l == 0) ? (row < NCTX ? p.x_prompt + (size_t)row * 1024 : p.x_sample + (size_t)(row - NCTX) * 1024) : p.xbuf() + (size_t)row * 1024;
#pragma unroll
      for (int n = 0; n < 4; ++n) xv[m][n] = *(const f32x4*)(xo + cb + n * 16 + fq * 4);
    }
    __builtin_amdgcn_sched_barrier(0);
    const int ln = fq * 16 + (rbase & 15);
#pragma unroll
    for (int m = 0; m < MB; ++m) {
      const int row = rbase + m * 16;
      const int ci = row < NCTX ? 0 : 1 + ((row - NCTX) >> 10);
      float ss = 0.f;
#pragma unroll
      for (int n = 0; n < 4; ++n) {
        const int col = cb + n * 16 + fq * 4;
        const f32x4 g = *(const f32x4*)(gate0 + ci * 3072 + n * 16);
        f32x4 o;
#pragma unroll
        for (int j = 0; j < 4; ++j) { o[j] = xv[m][n][j] + g[j] * acc[m][n][j]; ss += o[j] * o[j]; }
        *(f32x4*)(p.xbuf() + (size_t)row * 1024 + col) = o;
        if (l == 0) {
          const f32x4 gg = *(const f32x4*)(p.norm_g + 1024 + col), sc = *(const f32x4*)(p.mod() + (3 + ci) * 3072 + 1024 + col);
          u32x2 pk = {pk2(o[0] * gg[0] * (1.f + sc[0]), o[1] * gg[1] * (1.f + sc[1])), pk2(o[2] * gg[2] * (1.f + sc[2]), o[3] * gg[3] * (1.f + sc[3]))};
          *(u32x2*)(p.hbuf() + (size_t)row * 1024 + col) = pk;
        }
      }
      ss += shx(ss, 16, ln); ss += shx(ss, 32, ln);
      if (fq == 0) atomicAdd(p.ssq_x() + (l + 1) * NTOK + row, ss);
    }
  }
};

template <int MINE, int THEIRS>
DI void diff_finalize(f32x16 (&O)[4], float f, float sgn, const float* __restrict__ subln, float osc, char* smem, int w, int lane, int hh,
                      bf16_t* __restrict__ orow, const bf16_t* __restrict__ zrow, bool active) {
  float* ex = (float*)smem;
  float* sx = ex + 4 * 32 * 64;
  if (active) {
#pragma unroll
    for (int d = 0; d < 2; ++d)
#pragma unroll
      for (int i = 0; i < 16; ++i) ex[(w * 32 + d * 16 + i) * 64 + lane] = O[THEIRS + d][i] * f;
  }
  __syncthreads();
  if (!active) { __syncthreads(); return; }
  const float* pe = ex + (w ^ 1) * 32 * 64;
  float ss = 0.f;
#pragma unroll
  for (int d = 0; d < 2; ++d)
#pragma unroll
    for (int i = 0; i < 16; ++i) {
      const float mine = O[MINE + d][i] * f, theirs = pe[(d * 16 + i) * 64 + lane];
      const float o = (sgn == 0.f) ? (mine - theirs) : (theirs - mine);
      O[MINE + d][i] = o; ss += o * o;
    }
  ss += shx(ss, 32, lane);
  sx[w * 64 + lane] = ss;
  __syncthreads();
  ss += sx[(w ^ 1) * 64 + lane];
  const float rs = rsqrtf(ss * (1.f / 128.f) + EPS) * osc;
#pragma unroll
  for (int d = 0; d < 2; ++d) {
#pragma unroll
    for (int g = 0; g < 4; ++g) {
      const int d0 = (MINE + d) * 32 + g * 8 + hh * 4;
      const f32x4 sg = *(const f32x4*)(subln + d0);
      const u32x2 z = *(const u32x2*)(zrow + d0);
      u32x2 o = {pk2(O[MINE + d][4 * g] * rs * sg[0] * bflo(z[0]), O[MINE + d][4 * g + 1] * rs * sg[1] * bfhi(z[0])),
                 pk2(O[MINE + d][4 * g + 2] * rs * sg[2] * bflo(z[1]), O[MINE + d][4 * g + 3] * rs * sg[3] * bfhi(z[1]))};
      *(u32x2*)(orow + d0) = o;
    }
    __builtin_amdgcn_sched_barrier(0);
  }
}

template <int DQK, int DV, bool DIFF, bool SPLIT>
DI void attn_item(const bf16_t* __restrict__ Qp, int ldq, const bf16_t* __restrict__ Kp, const bf16_t* __restrict__ Vtp, int nkeys,
                  bf16_t* __restrict__ outp, const bf16_t* __restrict__ zsp, float lamf, const float* __restrict__ subln, float osc, char* smem, int tid,
                  int warm_n = 0, int warm_share = 0) {
  constexpr int NMAPK = DIFF ? 2 : 1;
  constexpr int KROW = (DQK + 8) * 2;
  constexpr int KMAPB = 64 * KROW;
  constexpr int VROW = 136;
  constexpr int NS = DQK / 16, NDB = DV / 32;
  constexpr int BUFB = NMAPK * KMAPB + DV * VROW;
  constexpr int NT = SPLIT ? 2 : 1;
  char* sK = smem;
  char* sV = smem + NMAPK * KMAPB;
  const int lane = tid & 63, w = tid >> 6, r = lane & 31, hh = lane >> 5;
  const int kh = SPLIT ? (w >> 1) : 0;
  const int qb = SPLIT ? (DIFF ? 0 : (w & 1)) : (DIFF ? (w >> 1) : w);
  const int am = DIFF ? (w & 1) : 0;
  bf16x8 qf[NS];
#pragma unroll
  for (int s = 0; s < NS; ++s) qf[s] = *(const bf16x8*)(Qp + (size_t)(qb * 32 + r) * ldq + am * 64 + s * 16 + hh * 8);
  f32x16 O[NDB];
  float mrun = -1e30f, lrun = 0.f;
#pragma unroll
  for (int db = 0; db < NDB; ++db)
#pragma unroll
    for (int i = 0; i < 16; ++i) O[db][i] = 0.f;
  const char* sKa = sK + am * KMAPB + r * KROW + hh * 16;
  const char* sVa = sV + r * VROW + hh * 8;
  const int nkt = nkeys >> 6, nit = SPLIT ? (nkt >> 1) : nkt;
  constexpr int KCH = 64 * DQK / 8;
  constexpr int NKC = (KCH + 255) / 256, NVC = DV * 8 / 256;
  u32x4 kreg[NT][NMAPK][NKC], vreg[NT][NVC];
#define ATT_GLOAD(J)                                                                               \
  {                                                                                                \
    _Pragma("unroll") for (int t = 0; t < NT; ++t) {                                               \
      const int tile = t * nit + (J);                                                              \
      _Pragma("unroll") for (int a = 0; a < NMAPK; ++a) {                                          \
        const bf16_t* kg = Kp + (size_t)a * nkeys * DQK + (size_t)tile * 64 * DQK;                  \
        _Pragma("unroll") for (int c = 0; c < NKC; ++c) {                                          \
          const int ch = c * 256 + tid;                                                            \
          if (KCH % 256 == 0 || ch < KCH) kreg[t][a][c] = *(const u32x4*)(kg + (size_t)ch * 8);     \
        }                                                                                          \
      }                                                                                            \
      const bf16_t* vg = Vtp + (size_t)tile * 64;                                                   \
      _Pragma("unroll") for (int c = 0; c < NVC; ++c) {                                            \
        const int ch = c * 256 + tid, d = ch >> 3, part = ch & 7;                                  \
        vreg[t][c] = *(const u32x4*)(vg + (size_t)d * nkeys + part * 8);                            \
      }                                                                                            \
    }                                                                                              \
    __builtin_amdgcn_sched_barrier(0);                                                             \
  }
#define ATT_SWRITE(BUF)                                                                            \
  {                                                                                                \
    _Pragma("unroll") for (int t = 0; t < NT; ++t) {                                               \
      char* bK = sK + (SPLIT ? t : (BUF)) * BUFB;                                                  \
      char* bV = sV + (SPLIT ? t : (BUF)) * BUFB;                                                  \
      _Pragma("unroll") for (int a = 0; a < NMAPK; ++a) _Pragma("unroll") for (int c = 0; c < NKC; ++c) { \
        const int ch = c * 256 + tid;                                                              \
        if (KCH % 256 == 0 || ch < KCH) {                                                          \
          const int key = ch / (DQK / 8), part = ch % (DQK / 8);                                   \
          *(u32x4*)(bK + a * KMAPB + key * KROW + part * 16) = kreg[t][a][c];                       \
        }                                                                                          \
      }                                                                                            \
      _Pragma("unroll") for (int c = 0; c < NVC; ++c) {                                            \
        const int ch = c * 256 + tid, d = ch >> 3, part = ch & 7;                                  \
        u32x2 lo = {vreg[t][c][0], vreg[t][c][1]}, hi = {vreg[t][c][2], vreg[t][c][3]};            \
        *(u32x2*)(bV + d * VROW + part * 16) = lo;                                                 \
        *(u32x2*)(bV + d * VROW + part * 16 + 8) = hi;                                             \
      }                                                                                            \
    }                                                                                              \
  }
  auto compute = [&](const char* sKb, const char* sVb) {
    f32x16 st[2];
#pragma unroll
    for (int kb = 0; kb < 2; ++kb) {
#pragma unroll
      for (int i = 0; i < 16; ++i) st[kb][i] = 0.f;
#pragma unroll
      for (int s = 0; s < NS; ++s) {
        const bf16x8 kf = *(const bf16x8*)(sKb + kb * 32 * KROW + s * 32);
        st[kb] = MFMA32(kf, qf[s], st[kb]);
      }
    }
    float mx = st[0][0];
#pragma unroll
    for (int i = 1; i < 16; ++i) mx = fmaxf(mx, st[0][i]);
#pragma unroll
    for (int i = 0; i < 16; ++i) mx = fmaxf(mx, st[1][i]);
    mx = fmaxf(mx, shx(mx, 32, lane));
    const float mnew = fmaxf(mrun, mx);
    const float alpha = __builtin_amdgcn_exp2f(mrun - mnew);
    mrun = mnew;
    float ls = 0.f;
#pragma unroll
    for (int kb = 0; kb < 2; ++kb)
#pragma unroll
      for (int i = 0; i < 16; ++i) { const float e = __builtin_amdgcn_exp2f(st[kb][i] - mnew); st[kb][i] = e; ls += e; }
    lrun = lrun * alpha + ls;
    if (__builtin_amdgcn_ballot_w64(alpha != 1.f) != 0) {
#pragma unroll
      for (int db = 0; db < NDB; ++db)
#pragma unroll
        for (int i = 0; i < 16; ++i) O[db][i] *= alpha;
    }
#pragma unroll
    for (int kb = 0; kb < 2; ++kb)
#pragma unroll
      for (int t2 = 0; t2 < 2; ++t2) {
        u32x4 pp;
#pragma unroll
        for (int j = 0; j < 4; ++j) pp[j] = pk2(st[kb][8 * t2 + 2 * j], st[kb][8 * t2 + 2 * j + 1]);
        const bf16x8 pf = __builtin_bit_cast(bf16x8, pp);
#pragma unroll
        for (int db = 0; db < NDB; ++db) {
          const char* vb = sVb + db * 32 * VROW + (kb * 32 + 16 * t2) * 2;
          const u32x2 lo = *(const u32x2*)vb, hi = *(const u32x2*)(vb + 16);
          const u32x4 vv = {lo[0], lo[1], hi[0], hi[1]};
          O[db] = MFMA32(__builtin_bit_cast(bf16x8, vv), pf, O[db]);
        }
        if constexpr (DIFF && SPLIT) __builtin_amdgcn_sched_barrier(0);
      }
  };
  ATT_GLOAD(0);
  unsigned w0 = 0u, w1 = 0u;
  if (warm_n > 0) {
    const int lk = (NMAPK * nkeys * DQK * 2 / 128) / warm_n, lv = (DV * nkeys * 2 / 128) / warm_n;
    if (tid < lk) w0 = *(const volatile unsigned*)((const char*)Kp + (size_t)(warm_share * lk + tid) * 128);
    if (tid < lv) w1 = *(const volatile unsigned*)((const char*)Vtp + (size_t)(warm_share * lv + tid) * 128);
  }
  if constexpr (!SPLIT) {
    __syncthreads();
    ATT_SWRITE(0);
    if (nit > 1) ATT_GLOAD(1);
    __syncthreads();
    for (int kt = 0; kt < nit; ++kt) {
      if (kt + 1 < nit) {
        ATT_SWRITE((kt + 1) & 1);
        if (kt + 2 < nit) ATT_GLOAD(kt + 2);
      }
      compute(sKa + (kt & 1) * BUFB, sVa + (kt & 1) * BUFB);
      __syncthreads();
    }
  } else {
    for (int j = 0; j < nit; ++j) {
      __syncthreads();
      ATT_SWRITE(0);
      __syncthreads();
      if (j + 1 < nit) ATT_GLOAD(j + 1);
      compute(sKa + kh * BUFB, sVa + kh * BUFB);
    }
    __syncthreads();
    float* mg = (float*)(smem + 36864);
    float* mlb = mg + 2 * NDB * 16 * 64;
    const int wl = w & 1;
    if (kh == 1) {
#pragma unroll
      for (int db = 0; db < NDB; ++db)
#pragma unroll
        for (int i = 0; i < 16; ++i) mg[((wl * NDB + db) * 16 + i) * 64 + lane] = O[db][i];
      mlb[(wl * 2 + 0) * 64 + lane] = mrun;
      mlb[(wl * 2 + 1) * 64 + lane] = lrun;
    }
    __syncthreads();
    if (kh == 0) {
      const float m1 = mlb[(wl * 2 + 0) * 64 + lane], l1 = mlb[(wl * 2 + 1) * 64 + lane];
      const float mn = fmaxf(mrun, m1);
      const float s0 = __builtin_amdgcn_exp2f(mrun - mn), s1 = __builtin_amdgcn_exp2f(m1 - mn);
      lrun = lrun * s0 + l1 * s1;
      mrun = mn;
#pragma unroll
      for (int db = 0; db < NDB; ++db)
#pragma unroll
        for (int i = 0; i < 16; ++i) O[db][i] = O[db][i] * s0 + mg[((wl * NDB + db) * 16 + i) * 64 + lane] * s1;
    }
  }
#undef ATT_GLOAD
#undef ATT_SWRITE
  const float inv = 1.f / (lrun + shx(lrun, 32, lane));
  const size_t ro = (size_t)(qb * 32 + r) * 1024;
  const bool active = (kh == 0);
  if constexpr (DIFF) {
    __syncthreads();
    if (am == 0) diff_finalize<0, 2>(O, inv, 0.f, subln, osc, smem, w, lane, hh, outp + ro, zsp + ro, active);
    else diff_finalize<2, 0>(O, inv * lamf, 1.f, subln, osc, smem, w, lane, hh, outp + ro, zsp + ro, active);
  } else {
    if (active) {
#pragma unroll
      for (int db = 0; db < NDB; ++db) {
#pragma unroll
        for (int g = 0; g < 4; ++g) {
          const int d0 = db * 32 + g * 8 + hh * 4;
          const u32x2 z = *(const u32x2*)(zsp + ro + d0);
          u32x2 o = {pk2(O[db][4 * g] * inv * bflo(z[0]), O[db][4 * g + 1] * inv * bfhi(z[0])), pk2(O[db][4 * g + 2] * inv * bflo(z[1]), O[db][4 * g + 3] * inv * bfhi(z[1]))};
          *(u32x2*)(outp + ro + d0) = o;
        }
        __builtin_amdgcn_sched_barrier(0);
      }
    }
  }
  if ((w0 ^ w1) == 0x7fc54321u && warm_n < 0) ((volatile unsigned*)smem)[0] = w0;
}

DI void conv_item(const Params& p, int l, int it, int tid) {
  const int ch = (tid & 31) * 8, rr = tid >> 5;
  float w0[8], w1[8], w2[8];
#pragma unroll
  for (int j = 0; j < 8; ++j) { w0[j] = p.conv_w[l * 768 + ch + j]; w1[j] = p.conv_w[l * 768 + 256 + ch + j]; w2[j] = p.conv_w[l * 768 + 512 + ch + j]; }
  for (int i = 0; i < 16; ++i) {
    const int row = it * 128 + i * 8 + rr;
    int t, len;
    if (row < NCTX) { t = row & 255; len = 256; } else { t = (row - NCTX) & 1023; len = 1024; }
    const bf16_t* base = p.convb() + (size_t)row * 768;
    const u32x4 zero = {0u, 0u, 0u, 0u};
    const u32x4 cbv = *(const u32x4*)(base + ch);
    const u32x4 c1 = *(const u32x4*)(base + 256 + ch), x1 = *(const u32x4*)(base + 512 + ch);
    const u32x4 c0 = t > 0 ? *(const u32x4*)(base - 768 + 256 + ch) : zero, x0 = t > 0 ? *(const u32x4*)(base - 768 + 512 + ch) : zero;
    const u32x4 c2 = t < len - 1 ? *(const u32x4*)(base + 768 + 256 + ch) : zero, x2 = t < len - 1 ? *(const u32x4*)(base + 768 + 512 + ch) : zero;
    const u32x4 zv = *(const u32x4*)(p.zs() + (size_t)row * 1024 + 256 + ch);
    u32x4 o;
#pragma unroll
    for (int q = 0; q < 4; ++q) {
      const float ylo = bflo(c0[q]) * bflo(x0[q]) * w0[2 * q] + bflo(c1[q]) * bflo(x1[q]) * w1[2 * q] + bflo(c2[q]) * bflo(x2[q]) * w2[2 * q];
      const float yhi = bfhi(c0[q]) * bfhi(x0[q]) * w0[2 * q + 1] + bfhi(c1[q]) * bfhi(x1[q]) * w1[2 * q + 1] + bfhi(c2[q]) * bfhi(x2[q]) * w2[2 * q + 1];
      o[q] = pk2(bflo(cbv[q]) * ylo * bflo(zv[q]), bfhi(cbv[q]) * yhi * bfhi(zv[q]));
    }
    *(u32x4*)(p.mix() + (size_t)row * 1024 + 256 + ch) = o;
  }
}

DI void phase_mix(const Params& p, int l, char* smem, int mask = 7) {
  const int lane = opaque_tid() & 63;
  const float* lm = p.lam + l * 256;
  const float s01 = wave_sum(lm[lane] * lm[64 + lane], lane), s23 = wave_sum(lm[128 + lane] * lm[192 + lane], lane);
  const float lam_init = (l == 0) ? 0.2f : 0.35550906759096934f;
  const float lamf = __int_as_float(__builtin_amdgcn_readfirstlane(__float_as_int(__expf(s01) - __expf(s23) + lam_init)));
  const float osc = 1.f - lam_init;
  const int bid = opaque_bid(), G = gridDim.x;
  for (int slot = 0;; ++slot) {
    int it;
    if (G == 512) {
      if (slot == 0) it = bid;
      else if (slot == 1) it = bid < 128 ? -1 : bid < 192 ? 704 + (bid - 128) : bid < 384 ? 512 + (bid - 192) : 768 + (bid - 384);
      else if (slot == 2) it = bid < 384 ? -1 : bid < 448 ? 896 + (bid - 384) : 960 + (bid - 448);
      else if (slot == 3) it = (bid >= 192 && bid < 208) ? 1024 + (bid - 192) : -1;
      else break;
      if (it < 0) continue;
    } else {
      it = slot * G + bid;
      if (it >= 1040) break;
    }
    int tid = threadIdx.x;
    asm volatile("" : "+v"(tid));
#if REP >= 40
    { const bool isdiff = it < 128 || (it >= 192 && it < 704), ismla = (it >= 128 && it < 192) || (it >= 704 && it < 960), islat = it < 192;
      if (mask == 1 && !isdiff) continue; if (mask == 2 && !ismla) continue; if (mask == 3 && !islat) continue; if (mask == 4 && !(isdiff && islat)) continue; }
#endif
    if (it < 128 || (it >= 192 && it < 704)) {
      int b, h, qt; size_t row0; const bf16_t *kp, *vp; int nk;
      if (it < 128) {
        const int x = it & 7; b = x >> 2; h = x & 3; qt = it >> 3; row0 = NCTX + b * 1024 + qt * 64; nk = 1280;
        kp = p.KdL() + (size_t)l * 1310720 + (size_t)((b * 4 + h) * 2) * 1280 * 64; vp = p.VdL() + (size_t)l * 1310720 + (size_t)((b * 4 + h) * 128) * 1280;
      } else {
        const int j = it - 192, combo = (j & 7) | ((j >> 5) << 3); b = combo >> 2; h = combo & 3; qt = (j >> 3) & 3; row0 = b * 256 + qt * 64; nk = 256;
        kp = p.KdC() + (size_t)((b * 4 + h) * 2) * 256 * 64; vp = p.VdC() + (size_t)((b * 4 + h) * 128) * 256;
      }
      attn_item<64, 128, true, false>(p.dq() + row0 * 512 + h * 128, 512, kp, vp, nk, p.mix() + row0 * 1024 + 512 + h * 128, p.zs() + row0 * 1024 + 512 + h * 128,
                                      lamf, p.subln + l * 128, osc, smem, tid, it < 128 ? 16 : 0, qt);
    } else if (it < 960) {
      int b, h, qt; size_t row0; const bf16_t *kp, *vp; int nk;
      if (it < 192) {
        const int j = it - 128, x = j & 7; b = x >> 2; h = x & 3; qt = j >> 3; row0 = NCTX + b * 1024 + qt * 128; nk = 1280;
        kp = p.KmL() + (size_t)l * 983040 + (size_t)(b * 4 + h) * 1280 * 96; vp = p.VmL() + (size_t)l * 655360 + (size_t)((b * 4 + h) * 64) * 1280;
      } else {
        const int j = it - 704, combo = (j & 7) | ((j >> 4) << 3); b = combo >> 2; h = combo & 3; qt = (j >> 3) & 1; row0 = b * 256 + qt * 128; nk = 256;
        kp = p.KmC() + (size_t)(b * 4 + h) * 256 * 96; vp = p.VmC() + (size_t)((b * 4 + h) * 64) * 256;
      }
      attn_item<96, 64, false, false>(p.qm() + row0 * 384 + h * 96, 384, kp, vp, nk, p.mix() + row0 * 1024 + h * 64, p.zs() + row0 * 1024 + h * 64, 0.f, nullptr, 1.f, smem, tid, it < 192 ? 8 : 0, qt);
    } else {
      conv_item(p, l, it - 960, tid);
    }
  }
}

DI void phase_inproj(const Params& p, int l, char* smem, bool atom = true, bool skip = false) {
  EpiIn epi{p, l, atom, skip};
  const int tid = opaque_tid(), bid = opaque_bid();
  const int xcd = bid & 7, nloc = (gridDim.x + 7 - xcd) >> 3;
  for (int j = bid >> 3; j < 300; j += nloc) {
    const int mt = xcd * 10 + j % 10, nt = j / 10;
    gemm_tile<4, 2>(p.hbuf(), 1024, p.WinT() + (size_t)l * NP * 1024, 1024, 1024, mt * 128, nt * 128, epi, smem, tid);
  }
}

DI void phase_upproj(const Params& p, int l, char* smem, bool fix = true) {
  const int tid = opaque_tid(), bid = opaque_bid();
  if (fix) {
    const float* g = p.kv_norm + l * 128;
    for (int i = bid * 256 + tid; i < NCTX * 32; i += gridDim.x * 256) {
      const int row = i >> 5, c = (i & 31) * 4, b = row >> 8, t = row & 255;
      const float f = rsqrtf(p.ssq_kv()[l * NTOK + row] * (1.f / 128.f) + EPS);
      float* d = p.out + OUT_CKV + (size_t)((b * 2 + l) * 256 + t) * 128 + c;
      f32x4 v = *(f32x4*)d;
      const f32x4 gg = *(const f32x4*)(g + c);
#pragma unroll
      for (int j = 0; j < 4; ++j) v[j] *= f * gg[j];
      *(f32x4*)d = v;
    }
  }
  EpiQ eq{p, l};
  EpiKV ek0{p, l, 0}, ek1{p, l, 1};
  for (int it = bid; it < 464; it += gridDim.x) {
    if (it < 192) {
      const int mt = it / 3, nt = it % 3;
      gemm_tile<5, 1>(p.cq(), 256, p.WuqT() + (size_t)l * 384 * 256, 256, 256, mt * 160, nt * 128, eq, smem, tid);
    } else if (it < 448) {
      const int j = it - 192, mt = j >> 2, nt = j & 3;
      gemm_tile<5, 1>(p.ckvraw(), 128, p.WukvTf() + (size_t)l * 512 * 128, 128, 128, mt * 160, nt * 128, ek0, smem, tid);
    } else {
      const int j = it - 448, mt = j >> 2, nt = j & 3;
      gemm_tile<4, 1>(p.cckv() + (size_t)l * 65536, 128, p.WukvT() + (size_t)l * 512 * 128, 128, 128, mt * 128, nt * 128, ek1, smem, tid);
    }
  }
}

DI void phase_outproj(const Params& p, int l, char* smem) {
  EpiOut epi{p, l};
  const int tid = opaque_tid(), bid = opaque_bid();
  for (int it = bid; it < 512; it += gridDim.x) {
    const int mt = it >> 3, nt = it & 7;
    gemm_tile<5, 1>(p.mix(), 1024, p.WoutT() + (size_t)l * 1024 * 1024, 1024, 1024, mt * 160, nt * 128, epi, smem, tid);
  }
}

__global__ void __launch_bounds__(256, 2) fwd_megakernel(Params p) {
  __shared__ __attribute__((aligned(16))) char smem[73728];
  __shared__ __attribute__((aligned(16))) unsigned xb_words[4];
  cg::grid_group grid = cg::this_grid();
  if (p.ws == nullptr) grid.sync();
  if (threadIdx.x == 0) { xb_words[0] = 0u; xb_words[1] = 0u; xb_words[2] = 0u; xb_words[3] = 0u; }
  __syncthreads();
  const XcdBarrier xb = xcd_barrier_post(p.bar(), (volatile LAS unsigned*)xb_words);
#define GSYNC() xcd_barrier(xb)
  phase0(p, smem);
#if REP == 0
  GSYNC(); phase0(p, smem);
#endif
#pragma unroll
  for (int l = 0; l < 2; ++l) {
    GSYNC();
    if (l == 0) { phase_norm(p, 0); GSYNC(); }
#if REP == 2
    phase_inproj(p, l, smem, false); GSYNC();
#endif
#if REP == 7
    phase_inproj(p, l, smem, false, p.ws != nullptr); GSYNC();
#endif
    phase_inproj(p, l, smem);
    GSYNC();
#if REP == 3
    phase_upproj(p, l, smem, false); GSYNC();
#endif
    phase_upproj(p, l, smem);
    GSYNC();
#if REP == 4
    phase_mix(p, l, smem); GSYNC();
#endif
#if REP >= 40
    phase_mix(p, l, smem, REP - 40); GSYNC();
#endif
    phase_mix(p, l, smem);
    GSYNC();
#if REP == 5
    if (l == 0) { phase_outproj(p, l, smem); GSYNC(); }
#endif
    phase_outproj(p, l, smem);
  }
  GSYNC();
  phase_norm(p, 2);
#if REP == 6
  for (int i = 0; i < 10; ++i) GSYNC();
#endif
}

extern "C" void kernel_launch(void* const* d_in, const int* in_sizes, int n_in, void* d_out, int out_size, void* d_ws, size_t ws_size, hipStream_t stream) {
  static int grid_blocks = 0;
  if (!grid_blocks) {
    int dev = 0, cus = 0, per_cu = 0;
    hipGetDevice(&dev);
    hipDeviceGetAttribute(&cus, hipDeviceAttributeMultiprocessorCount, dev);
    hipOccupancyMaxActiveBlocksPerMultiprocessor(&per_cu, fwd_megakernel, 256, 0);
    if (per_cu > 2) per_cu = 2;
    if (per_cu < 1) per_cu = 1;
    grid_blocks = cus * per_cu;
  }
  Params p{};
  p.x_prompt = (const float*)d_in[0]; p.x_sample = (const float*)d_in[1]; p.c = (const float*)d_in[2];
  p.cache_ckv = (const float*)d_in[3]; p.cache_krope = (const float*)d_in[4]; p.cache_dk = (const float*)d_in[5]; p.cache_dv = (const float*)d_in[6];
  p.c_ctx = (const float*)d_in[7]; p.norm_g = (const float*)d_in[8]; p.ada_w = (const float*)d_in[9]; p.ada_b = (const float*)d_in[10];
  p.w_in = (const float*)d_in[11]; p.q_norm = (const float*)d_in[12]; p.w_uq = (const float*)d_in[13]; p.kv_norm = (const float*)d_in[14];
  p.w_ukv = (const float*)d_in[15]; p.conv_w = (const float*)d_in[16]; p.lam = (const float*)d_in[17]; p.subln = (const float*)d_in[18];
  p.w_out = (const float*)d_in[19]; p.final_norm = (const float*)d_in[20];
  p.out = (float*)d_out;
  p.ws = (char*)d_ws;
  if (ws_size < WS_TOTAL) fprintf(stderr, "workspace too small\n");
  hipMemsetAsync(d_ws, 0, OFF_WinT, stream);
  void* args[] = {&p};
  hipError_t e = hipLaunchCooperativeKernel((void*)fwd_megakernel, dim3(grid_blocks), dim3(256), args, 0, stream);
  if (e != hipSuccess) fprintf(stderr, "cooperative launch failed: %s (grid %d)\n", hipGetErrorString(e), grid_blocks);
}
```

```cpp
#include <hip/hip_runtime.h>
#include <hip/hip_cooperative_groups.h>
#include <cstdio>
namespace cg = cooperative_groups;

typedef unsigned short bf16_t;
typedef short bf16x8 __attribute__((ext_vector_type(8)));
typedef float f32x2 __attribute__((ext_vector_type(2)));
typedef float f32x4 __attribute__((ext_vector_type(4)));
typedef float f32x16 __attribute__((ext_vector_type(16)));
typedef unsigned u32x2 __attribute__((ext_vector_type(2)));
typedef unsigned u32x4 __attribute__((ext_vector_type(4)));
typedef __bf16 bf16x2_t __attribute__((ext_vector_type(2)));

#ifndef REP
#define REP -1
#endif
#define DI __device__ __forceinline__
#define MFMA16(a, b, c) __builtin_amdgcn_mfma_f32_16x16x32_bf16((a), (b), (c), 0, 0, 0)
#define MFMA32(a, b, c) __builtin_amdgcn_mfma_f32_32x32x16_bf16((a), (b), (c), 0, 0, 0)

#define XCD_BAR_WORDS 3456
constexpr int NCTX = 8192, NTOK = 10240, NP = 3840;
constexpr float EPS = 1e-6f;
constexpr float QSCALE_M = 0.14724444602590306f;
constexpr float QSCALE_D = 0.18033688011112042f;
constexpr size_t OUT_CKV = 10485760, OUT_KR = 12582912, OUT_DK = 13107200, OUT_DV = 21495808;

__constant__ float INV16[16] = {1.000000000e+00f, 5.623413324e-01f, 3.162277639e-01f, 1.778279394e-01f, 1.000000015e-01f, 5.623413250e-02f, 3.162277490e-02f, 1.778279431e-02f,
                                9.999999776e-03f, 5.623413250e-03f, 3.162277630e-03f, 1.778279431e-03f, 1.000000047e-03f, 5.623413017e-04f, 3.162277571e-04f, 1.778279402e-04f};
__constant__ float INV8[8] = {1.000000000e+00f, 3.162277639e-01f, 1.000000015e-01f, 3.162277490e-02f, 9.999999776e-03f, 3.162277630e-03f, 1.000000047e-03f, 3.162277571e-04f};

constexpr size_t al256(size_t x) { return (x + 255) & ~(size_t)255; }
constexpr size_t OFF_bar = 0;
constexpr size_t OFF_mod = OFF_bar + al256(XCD_BAR_WORDS * 4);
constexpr size_t OFF_WinT = OFF_mod + al256((size_t)2 * 3 * 3072 * 4);
constexpr size_t OFF_WoutT = OFF_WinT + al256((size_t)2 * NP * 1024 * 2);
constexpr size_t OFF_WuqT = OFF_WoutT + al256((size_t)2 * 1024 * 1024 * 2);
constexpr size_t OFF_WukvTf = OFF_WuqT + al256((size_t)2 * 384 * 256 * 2);
constexpr size_t OFF_WukvT = OFF_WukvTf + al256((size_t)2 * 512 * 128 * 2);
constexpr size_t OFF_ssq_q = OFF_WukvT + al256((size_t)2 * 512 * 128 * 2);
constexpr size_t OFF_ssq_kv = OFF_ssq_q + al256((size_t)2 * NTOK * 4);
constexpr size_t OFF_ssq_x = OFF_ssq_kv + al256((size_t)2 * NTOK * 4);
constexpr size_t OFF_bw = OFF_ssq_x + al256((size_t)3 * NTOK * 4);
constexpr size_t OFF_ropeD = OFF_bw + al256((size_t)2 * 3 * NP * 4);
constexpr size_t OFF_ropeM = OFF_ropeD + al256(2048 * 4);
constexpr size_t OFF_wq = OFF_ropeM + al256(1024 * 4);
constexpr size_t OFF_hbuf = OFF_wq + al256(256);
constexpr size_t OFF_cq = OFF_hbuf + al256((size_t)NTOK * 1024 * 2);
constexpr size_t OFF_ckvraw = OFF_cq + al256((size_t)NTOK * 256 * 2);
constexpr size_t OFF_cckv = OFF_ckvraw + al256((size_t)NTOK * 128 * 2);
constexpr size_t OFF_convb = OFF_cckv + al256((size_t)2 * 512 * 128 * 2);
constexpr size_t OFF_dq = OFF_convb + al256((size_t)NTOK * 768 * 2);
constexpr size_t OFF_zs = OFF_dq + al256((size_t)NTOK * 512 * 2);
constexpr size_t OFF_qm = OFF_zs + al256((size_t)NTOK * 1024 * 2);
constexpr size_t OFF_KmC = OFF_qm + al256((size_t)NTOK * 384 * 2);
constexpr size_t OFF_KmL = OFF_KmC + al256((size_t)32 * 4 * 256 * 96 * 2);
constexpr size_t OFF_VmC = OFF_KmL + al256((size_t)2 * 983040 * 2);
constexpr size_t OFF_VmL = OFF_VmC + al256((size_t)32 * 4 * 64 * 256 * 2);
constexpr size_t OFF_KdC = OFF_VmL + al256((size_t)2 * 655360 * 2);
constexpr size_t OFF_KdL = OFF_KdC + al256((size_t)32 * 4 * 2 * 256 * 64 * 2);
constexpr size_t OFF_VdC = OFF_KdL + al256((size_t)2 * 1310720 * 2);
constexpr size_t OFF_VdL = OFF_VdC + al256((size_t)32 * 4 * 128 * 256 * 2);
constexpr size_t OFF_mix = OFF_VdL + al256((size_t)2 * 1310720 * 2);
constexpr size_t OFF_xbuf = OFF_mix + al256((size_t)NTOK * 1024 * 2);
constexpr size_t WS_TOTAL = OFF_xbuf + al256((size_t)NTOK * 1024 * 4);

struct Params {
  const float *x_prompt, *x_sample, *c, *cache_ckv, *cache_krope, *cache_dk, *cache_dv, *c_ctx;
  const float *norm_g, *ada_w, *ada_b, *w_in, *q_norm, *w_uq, *kv_norm, *w_ukv, *conv_w, *lam, *subln, *w_out, *final_norm;
  float* out;
  char* ws;
  DI unsigned* bar() const { return (unsigned*)(ws + OFF_bar); }
  DI bf16_t* WinT() const { return (bf16_t*)(ws + OFF_WinT); }
  DI bf16_t* WoutT() const { return (bf16_t*)(ws + OFF_WoutT); }
  DI bf16_t* WuqT() const { return (bf16_t*)(ws + OFF_WuqT); }
  DI bf16_t* WukvTf() const { return (bf16_t*)(ws + OFF_WukvTf); }
  DI bf16_t* WukvT() const { return (bf16_t*)(ws + OFF_WukvT); }
  DI float* mod() const { return (float*)(ws + OFF_mod); }
  DI float* ssq_q() const { return (float*)(ws + OFF_ssq_q); }
  DI float* ssq_kv() const { return (float*)(ws + OFF_ssq_kv); }
  DI float* ssq_x() const { return (float*)(ws + OFF_ssq_x); }
  DI float* bw() const { return (float*)(ws + OFF_bw); }
  DI float* ropeD() const { return (float*)(ws + OFF_ropeD); }
  DI float* ropeM() const { return (float*)(ws + OFF_ropeM); }
  DI int* wq() const { return (int*)(ws + OFF_wq); }
  DI bf16_t* hbuf() const { return (bf16_t*)(ws + OFF_hbuf); }
  DI bf16_t* cq() const { return (bf16_t*)(ws + OFF_cq); }
  DI bf16_t* ckvraw() const { return (bf16_t*)(ws + OFF_ckvraw); }
  DI bf16_t* cckv() const { return (bf16_t*)(ws + OFF_cckv); }
  DI bf16_t* convb() const { return (bf16_t*)(ws + OFF_convb); }
  DI bf16_t* dq() const { return (bf16_t*)(ws + OFF_dq); }
  DI bf16_t* zs() const { return (bf16_t*)(ws + OFF_zs); }
  DI bf16_t* qm() const { return (bf16_t*)(ws + OFF_qm); }
  DI bf16_t* KmC() const { return (bf16_t*)(ws + OFF_KmC); }
  DI bf16_t* KmL() const { return (bf16_t*)(ws + OFF_KmL); }
  DI bf16_t* VmC() const { return (bf16_t*)(ws + OFF_VmC); }
  DI bf16_t* VmL() const { return (bf16_t*)(ws + OFF_VmL); }
  DI bf16_t* KdC() const { return (bf16_t*)(ws + OFF_KdC); }
  DI bf16_t* KdL() const { return (bf16_t*)(ws + OFF_KdL); }
  DI bf16_t* VdC() const { return (bf16_t*)(ws + OFF_VdC); }
  DI bf16_t* VdL() const { return (bf16_t*)(ws + OFF_VdL); }
  DI bf16_t* mix() const { return (bf16_t*)(ws + OFF_mix); }
  DI float* xbuf() const { return (float*)(ws + OFF_xbuf); }
};

DI unsigned pk2(float a, float b) {
  f32x2 v = {a, b};
  bf16x2_t r = __builtin_convertvector(v, bf16x2_t);
  return __builtin_bit_cast(unsigned, r);
}
DI float bflo(unsigned u) { return __uint_as_float(u << 16); }
DI float bfhi(unsigned u) { return __uint_as_float(u & 0xffff0000u); }
DI bf16_t f2bf(float a) { return (bf16_t)(pk2(a, 0.f) & 0xffffu); }
DI float shx(float v, int o, int lane) { return __int_as_float(__builtin_amdgcn_ds_bpermute((lane ^ o) << 2, __float_as_int(v))); }
DI float wave_sum(float v, int lane) {
#pragma unroll
  for (int o = 32; o >= 1; o >>= 1) v += shx(v, o, lane);
  return v;
}
DI int opaque_tid() { int t = threadIdx.x; asm volatile("" : "+v"(t)); return t; }
DI int opaque_bid() { int b = blockIdx.x; asm volatile("" : "+s"(b)); return b; }
DI int rope_perm(int P) { return (P & 7) | ((P & 8) << 1) | ((P & 16) >> 1); }


#define XB_TMO      128
#define XB_XCNT(j)  (256  + 64 * (j))
#define XB_XSUB(j)  (1280 + 64 * (j))
#define XB_XGEN(j)  (2304 + 64 * (j))
#define XB_TOP      3328
#define XB_TOPGEN   3392
#define XB_SPIN_CAP (1u << 18)
DI unsigned xb_ld(unsigned* p)              { return __hip_atomic_load(p, __ATOMIC_RELAXED, __HIP_MEMORY_SCOPE_AGENT); }
DI unsigned xb_add(unsigned* p, unsigned v) { return __hip_atomic_fetch_add(p, v, __ATOMIC_RELAXED, __HIP_MEMORY_SCOPE_AGENT); }
DI unsigned xb_xcc_id() { return (unsigned)__builtin_amdgcn_s_getreg((3 << 11) | 20) & 0xFu; }
#define XB_SPIN(cond, bar) do { unsigned _sp = 0; while (cond) { __builtin_amdgcn_s_sleep(1); \
    if ((++_sp & 255u) == 0u) { if (xb_ld(&(bar)[XB_TMO])) break; if (_sp > XB_SPIN_CAP) { atomicAdd(&(bar)[XB_TMO], 1u); break; } } } } while (0)
#define LAS __attribute__((address_space(3)))
struct XcdBarrier { unsigned* bar; unsigned x; volatile LAS unsigned* st; };
DI XcdBarrier xcd_barrier_post(unsigned* bar, volatile LAS unsigned* st) {
  XcdBarrier b; b.bar = bar; b.x = xb_xcc_id(); b.st = st;
  if (threadIdx.x == 0) (void)xb_add(&bar[XB_XCNT(b.x)], 1u);
  return b;
}
DI void xcd_barrier_complete(unsigned* bar, unsigned x, unsigned& nloc, unsigned& nx) {
  const unsigned G = gridDim.x * gridDim.y * gridDim.z;
  unsigned sum, cnt, mine, sp = 0u;
  for (;;) {
    sum = 0u; cnt = 0u; mine = 0u;
#pragma unroll
    for (unsigned j = 0; j < 16; ++j) { const unsigned c = xb_ld(&bar[XB_XCNT(j)]); sum += c; cnt += (c > 0u) ? 1u : 0u; mine = (j == x) ? c : mine; }
    if (sum == G) break;
    __builtin_amdgcn_s_sleep(1);
    if ((++sp & 255u) == 0u) { if (xb_ld(&bar[XB_TMO])) break; if (sp > XB_SPIN_CAP) { atomicAdd(&bar[XB_TMO], 1u); break; } }
  }
  nloc = mine > 0u ? mine : 1u; nx = cnt > 0u ? cnt : 1u;
}
DI void xcd_barrier(const XcdBarrier& b) {
  asm volatile("s_waitcnt vmcnt(0)" ::: "memory");
  __syncthreads();
  if (threadIdx.x == 0) {
    unsigned* bar = b.bar;
    __builtin_amdgcn_s_waitcnt(0);
    unsigned nloc = b.st[0], nx = b.st[1];
    if (nloc == 0u) { xcd_barrier_complete(bar, b.x, nloc, nx); b.st[0] = nloc; b.st[1] = nx; }
    const unsigned old = xb_add(&bar[XB_XSUB(b.x)], 1u);
    const unsigned gen = old / nloc;
    if (old + 1u == (gen + 1u) * nloc) {
      __builtin_amdgcn_fence(__ATOMIC_RELEASE, "agent");
      asm volatile("s_waitcnt vmcnt(0)" ::: "memory");
      const unsigned og = xb_add(&bar[XB_TOP], 1u);
      const unsigned tg = og / nx;
      if (og + 1u == (tg + 1u) * nx) xb_add(&bar[XB_TOPGEN], 1u);
      else XB_SPIN(xb_ld(&bar[XB_TOPGEN]) == tg, bar);
      __builtin_amdgcn_fence(__ATOMIC_ACQUIRE, "agent");
      xb_add(&bar[XB_XGEN(b.x)], 1u);
      asm volatile("s_waitcnt vmcnt(0)" ::: "memory");
    } else {
      XB_SPIN(xb_ld(&bar[XB_XGEN(b.x)]) == gen, bar);
      __builtin_amdgcn_fence(__ATOMIC_ACQUIRE, "agent");
      asm volatile("s_waitcnt vmcnt(0)" ::: "memory");
    }
  }
  __syncthreads();
}

struct ColMapIn { DI int operator()(int n) const { if (n < 384) return n; if (n < 3712) return n + 32; if (n < 3744) return 384 + rope_perm(n - 3712); return -1; } };
struct ColMapId { DI int operator()(int n) const { return n; } };
struct ColMapUq { DI int operator()(int n) const { int h = n / 96, c = n - h * 96; if (c >= 64) c = 64 + rope_perm(c - 64); return h * 96 + c; } };

template <class CM>
DI void tconv_tile(const float* __restrict__ src, int ldsrc, bf16_t* __restrict__ dst, int K, int n0, int k0, const float* __restrict__ kscale, CM cm, float* sm, int tid) {
  const int tq = tid & 15, ty = tid >> 4;
  const int sc = cm(n0 + tq * 4);
  f32x4 v[4];
#pragma unroll
  for (int i = 0; i < 4; ++i) {
    const int kk = ty + i * 16;
    v[i] = (f32x4){0.f, 0.f, 0.f, 0.f};
    if (sc >= 0) v[i] = *(const f32x4*)(src + (size_t)(k0 + kk) * ldsrc + sc);
  }
#pragma unroll
  for (int i = 0; i < 4; ++i) {
    const int kk = ty + i * 16;
    const float s = kscale ? kscale[k0 + kk] : 1.f;
#pragma unroll
    for (int j = 0; j < 4; ++j) sm[kk * 65 + tq * 4 + j] = v[i][j] * s;
  }
  __syncthreads();
  const int kc = tid & 7, nn = tid >> 3;
#pragma unroll
  for (int ps = 0; ps < 2; ++ps) {
    const int n = nn + ps * 32;
    u32x4 o;
#pragma unroll
    for (int i = 0; i < 4; ++i) o[i] = pk2(sm[(kc * 8 + 2 * i) * 65 + n], sm[(kc * 8 + 2 * i + 1) * 65 + n]);
    *(u32x4*)(dst + (size_t)(n0 + n) * K + k0 + kc * 8) = o;
  }
  __syncthreads();
}

DI float silu_f(float x) { return x / (1.f + __expf(-x)); }

DI void mod_item(const Params& p, int it, float* sm, int tid) {
  const int l = it / 192, r = it % 192, cg = r >> 4, kc = r & 15;
  const int c4 = tid & 63, rg = tid >> 6;
  const int k0 = kc * 64 + rg * 16;
  const float* W = p.ada_w + (size_t)l * 1024 * 3072 + (size_t)k0 * 3072 + cg * 256 + c4 * 4;
  f32x4 w[16];
#pragma unroll
  for (int i = 0; i < 16; ++i) w[i] = *(const f32x4*)(W + (size_t)i * 3072);
  float a0[4] = {0, 0, 0, 0}, a1[4] = {0, 0, 0, 0}, a2[4] = {0, 0, 0, 0};
#pragma unroll
  for (int i = 0; i < 16; ++i) {
    const int k = k0 + i;
    const float s0 = silu_f(p.c_ctx[k]), s1 = silu_f(p.c[k]), s2 = silu_f(p.c[1024 + k]);
#pragma unroll
    for (int j = 0; j < 4; ++j) { a0[j] += s0 * w[i][j]; a1[j] += s1 * w[i][j]; a2[j] += s2 * w[i][j]; }
  }
#pragma unroll
  for (int j = 0; j < 4; ++j) {
    sm[(rg * 3 + 0) * 256 + c4 * 4 + j] = a0[j];
    sm[(rg * 3 + 1) * 256 + c4 * 4 + j] = a1[j];
    sm[(rg * 3 + 2) * 256 + c4 * 4 + j] = a2[j];
  }
  __syncthreads();
#pragma unroll
  for (int ci = 0; ci < 3; ++ci) {
    float s = sm[(0 * 3 + ci) * 256 + tid] + sm[(1 * 3 + ci) * 256 + tid] + sm[(2 * 3 + ci) * 256 + tid] + sm[(3 * 3 + ci) * 256 + tid];
    const int col = cg * 256 + tid;
    if (kc == 0) s += p.ada_b[l * 3072 + col];
    atomicAdd(p.mod() + (l * 3 + ci) * 3072 + col, s);
  }
  __syncthreads();
}

DI void sincos_d(float ang, float& c, float& s) {
  const double TWO_PI = 6.283185307179586476925286766559;
  double x = (double)ang;
  x = x - TWO_PI * rint(x / TWO_PI);
  const double x2 = x * x;
  double ts = 1.0, tc = 1.0;
#pragma unroll
  for (int k = 12; k >= 1; --k) {
    ts = 1.0 - ts * x2 / (double)((2 * k) * (2 * k + 1));
    tc = 1.0 - tc * x2 / (double)((2 * k - 1) * (2 * k));
  }
  s = (float)(x * ts);
  c = (float)tc;
}

struct TcDesc { const float* src; bf16_t* dst; const float* kscale; int ld, K, n0, k0, sc; };
DI void tc_decode(const Params& p, int it, int tid, TcDesc& d) {
  const int tq = tid & 15;
  if (it < 1920) {
    const int l = it / 960, r = it % 960;
    d.src = p.w_in + (size_t)l * 1024 * 3744; d.ld = 3744; d.dst = p.WinT() + (size_t)l * NP * 1024; d.K = 1024; d.n0 = (r % 60) * 64; d.k0 = (r / 60) * 64; d.kscale = nullptr;
    d.sc = ColMapIn()(d.n0 + tq * 4);
  } else if (it < 2432) {
    const int j = it - 1920, l = j / 256, r = j % 256;
    d.src = p.w_out + (size_t)l * 1024 * 1024; d.ld = 1024; d.dst = p.WoutT() + (size_t)l * 1024 * 1024; d.K = 1024; d.n0 = (r % 16) * 64; d.k0 = (r / 16) * 64; d.kscale = nullptr;
    d.sc = d.n0 + tq * 4;
  } else if (it < 2480) {
    const int j = it - 2432, l = j / 24, r = j % 24;
    d.src = p.w_uq + (size_t)l * 256 * 384; d.ld = 384; d.dst = p.WuqT() + (size_t)l * 384 * 256; d.K = 256; d.n0 = (r % 6) * 64; d.k0 = (r / 6) * 64; d.kscale = p.q_norm + l * 256;
    d.sc = ColMapUq()(d.n0 + tq * 4);
  } else {
    const int j = (it - 2480) & 31, l = j / 16, r = j % 16;
    const bool folded = it < 2512;
    d.src = p.w_ukv + (size_t)l * 128 * 512; d.ld = 512; d.dst = (folded ? p.WukvTf() : p.WukvT()) + (size_t)l * 512 * 128; d.K = 128; d.n0 = (r % 8) * 64; d.k0 = (r / 8) * 64;
    d.kscale = folded ? p.kv_norm + l * 128 : nullptr;
    d.sc = d.n0 + tq * 4;
  }
}
DI void tc_load(const TcDesc& d, int tid, f32x4 (&v)[4]) {
  const int ty = tid >> 4;
#pragma unroll
  for (int i = 0; i < 4; ++i) {
    v[i] = (f32x4){0.f, 0.f, 0.f, 0.f};
    if (d.sc >= 0) v[i] = *(const f32x4*)(d.src + (size_t)(d.k0 + ty + i * 16) * d.ld + d.sc);
  }
  __builtin_amdgcn_sched_barrier(0);
}
DI void tc_finish(const TcDesc& d, int tid, f32x4 (&v)[4], float* sm) {
  const int tq = tid & 15, ty = tid >> 4;
#pragma unroll
  for (int i = 0; i < 4; ++i) {
    const int kk = ty + i * 16;
    const float s = d.kscale ? d.kscale[d.k0 + kk] : 1.f;
#pragma unroll
    for (int j = 0; j < 4; ++j) sm[kk * 65 + tq * 4 + j] = v[i][j] * s;
  }
  __syncthreads();
  const int kc = tid & 7, nn = tid >> 3;
#pragma unroll
  for (int ps = 0; ps < 2; ++ps) {
    const int n = nn + ps * 32;
    u32x4 o;
#pragma unroll
    for (int i = 0; i < 4; ++i) o[i] = pk2(sm[(kc * 8 + 2 * i) * 65 + n], sm[(kc * 8 + 2 * i + 1) * 65 + n]);
    *(u32x4*)(d.dst + (size_t)(d.n0 + n) * d.K + d.k0 + kc * 8) = o;
  }
  __syncthreads();
}

DI void phase0(const Params& p, char* smem) {
  float* sm = (float*)smem;
  const int tid = opaque_tid(), bid = opaque_bid();
  const int G = gridDim.x;
  for (int it = bid; it < 384; it += G) mod_item(p, it, sm, tid);
  {
    TcDesc da, db;
    f32x4 va[4], vb[4];
    int it = bid;
    bool ha = it < 2544;
    if (ha) { tc_decode(p, it, tid, da); tc_load(da, tid, va); }
    while (ha) {
      const int itb = it + G;
      const bool hb = itb < 2544;
      if (hb) { tc_decode(p, itb, tid, db); tc_load(db, tid, vb); }
      tc_finish(da, tid, va, sm);
      if (!hb) break;
      it = itb + G;
      ha = it < 2544;
      if (ha) { tc_decode(p, it, tid, da); tc_load(da, tid, va); }
      tc_finish(db, tid, vb, sm);
    }
  }
  const int gstride = gridDim.x * 256, g0 = bid * 256 + tid;
  for (int i0 = g0; i0 < 524288; i0 += 4 * gstride) {
    float v[4];
#pragma unroll
    for (int u = 0; u < 4; ++u) {
      const int i = i0 + u * gstride;
      if (i < 524288) { const int cc = i & 511, t = (i >> 9) & 255, b = (i >> 17) & 1, l = i >> 18; v[u] = p.cache_dk[(size_t)((b * 2 + l) * 256 + t) * 512 + cc]; }
    }
#pragma unroll
    for (int u = 0; u < 4; ++u) {
      const int i = i0 + u * gstride;
      if (i < 524288) {
        const int cc = i & 511, t = (i >> 9) & 255, b = (i >> 17) & 1, l = i >> 18, h = cc >> 7, a = (cc >> 6) & 1, d = cc & 63;
        p.KdL()[(size_t)l * 1310720 + (size_t)(((b * 4 + h) * 2 + a) * 1280 + t) * 64 + d] = f2bf(v[u]);
      }
    }
  }
  for (int i0 = g0; i0 < 524288; i0 += 4 * gstride) {
    float v[4];
#pragma unroll
    for (int u = 0; u < 4; ++u) {
      const int j = i0 + u * gstride;
      if (j < 524288) { const int t = j & 255, e = (j >> 8) & 127, h = (j >> 15) & 3, b = (j >> 17) & 1, l = j >> 18; v[u] = p.cache_dv[(size_t)((b * 2 + l) * 256 + t) * 512 + h * 128 + e]; }
    }
#pragma unroll
    for (int u = 0; u < 4; ++u) {
      const int j = i0 + u * gstride;
      if (j < 524288) { const int t = j & 255, e = (j >> 8) & 127, h = (j >> 15) & 3, b = (j >> 17) & 1, l = j >> 18; p.VdL()[(size_t)l * 1310720 + (size_t)((b * 4 + h) * 128 + e) * 1280 + t] = f2bf(v[u]); }
    }
  }
  const int E2 = 131072, E3 = E2 + 131072, E4 = E3 + 1536, E5 = E4 + 40960 + 30720;
  for (int i = g0; i < E5; i += gstride) {
    if (i < E2) {
      const int j = i;
      const int r = j & 31, h = (j >> 5) & 3, t = (j >> 7) & 255, b = (j >> 15) & 1, l = j >> 16;
      p.KmL()[(size_t)l * 983040 + (size_t)((b * 4 + h) * 1280 + t) * 96 + 64 + r] = f2bf(p.cache_krope[(size_t)((b * 2 + l) * 256 + t) * 32 + r]);
    } else if (i < E3) {
      const int j = i - E2;
      const int cc = j & 127, t = (j >> 7) & 255, b = (j >> 15) & 1, l = j >> 16;
      p.cckv()[(size_t)l * 65536 + (b * 256 + t) * 128 + cc] = f2bf(p.cache_ckv[(size_t)((b * 2 + l) * 256 + t) * 128 + cc]);
    } else if (i < E4) {
      const int j = i - E3;
      float cs, sn;
      if (j < 1024) {
        const int pos = j >> 4, f = j & 15;
        sincos_d((float)pos * INV16[f], cs, sn);
        p.ropeD()[j] = cs; p.ropeD()[1024 + j] = sn;
      } else {
        const int jj = j - 1024, pos = jj >> 3, f = jj & 7;
        sincos_d((float)pos * INV8[f], cs, sn);
        p.ropeM()[jj] = cs; p.ropeM()[512 + jj] = sn;
      }
    } else {
      const int j = i - E4;
      if (j < 20480) p.ssq_q()[j] = 0.f; else if (j < 40960) p.ssq_kv()[j - 20480] = 0.f; else p.ssq_x()[j - 40960] = 0.f;
      if (j < 64) p.wq()[j] = 0;
    }
  }
}

DI void phase_norm(const Params& p, int l) {
  const int tid = opaque_tid(), bid = opaque_bid();
  const int lane = tid & 63;
  const int gw = bid * 4 + (tid >> 6), nw = gridDim.x * 4;
  if (l == 0) {
    for (int it = gw; it < 2 * NP; it += nw) {
      const int ll = it / NP, n = it % NP;
      const bf16_t* wrow = p.WinT() + ((size_t)ll * NP + n) * 1024 + lane * 16;
      const u32x4 w0 = *(const u32x4*)wrow, w1 = *(const u32x4*)(wrow + 8);
      float wv[16];
#pragma unroll
      for (int q = 0; q < 4; ++q) { wv[2 * q] = bflo(w0[q]); wv[2 * q + 1] = bfhi(w0[q]); wv[8 + 2 * q] = bflo(w1[q]); wv[8 + 2 * q + 1] = bfhi(w1[q]); }
#pragma unroll
      for (int ci = 0; ci < 3; ++ci) {
        const float* sh = p.mod() + (ll * 3 + ci) * 3072 + lane * 16;
        float s = 0.f;
#pragma unroll
        for (int q = 0; q < 4; ++q) { const f32x4 sv = *(const f32x4*)(sh + q * 4); s += sv[0] * wv[q * 4] + sv[1] * wv[q * 4 + 1] + sv[2] * wv[q * 4 + 2] + sv[3] * wv[q * 4 + 3]; }
        s = wave_sum(s, lane);
        if (lane == 0) p.bw()[(ll * 3 + ci) * NP + n] = s;
      }
    }
  }
  for (int row = gw; row < NTOK; row += nw) {
    const float* x = (l == 0) ? (row < NCTX ? p.x_prompt + (size_t)row * 1024 : p.x_sample + (size_t)(row - NCTX) * 1024) : p.xbuf() + (size_t)row * 1024;
    f32x4 v[4];
#pragma unroll
    for (int i = 0; i < 4; ++i) v[i] = *(const f32x4*)(x + i * 256 + lane * 4);
    if (l == 0) {
      float ss = 0.f;
#pragma unroll
      for (int i = 0; i < 4; ++i) ss += v[i][0] * v[i][0] + v[i][1] * v[i][1] + v[i][2] * v[i][2] + v[i][3] * v[i][3];
      ss = wave_sum(ss, lane);
      if (lane == 0) p.ssq_x()[row] = ss;
      const int ci = row < NCTX ? 0 : 1 + ((row - NCTX) >> 10);
      const float* md = p.mod() + ci * 3072;
#pragma unroll
      for (int i = 0; i < 4; ++i) {
        const int k = i * 256 + lane * 4;
        const f32x4 gg = *(const f32x4*)(p.norm_g + k), sc = *(const f32x4*)(md + 1024 + k);
        float o[4];
#pragma unroll
        for (int j = 0; j < 4; ++j) o[j] = v[i][j] * gg[j] * (1.f + sc[j]);
        u32x2 pk = {pk2(o[0], o[1]), pk2(o[2], o[3])};
        *(u32x2*)(p.hbuf() + (size_t)row * 1024 + k) = pk;
      }
    } else {
      const float rstd = rsqrtf(p.ssq_x()[2 * NTOK + row] * (1.f / 1024.f) + EPS);
#pragma unroll
      for (int i = 0; i < 4; ++i) {
        const int k = i * 256 + lane * 4;
        const f32x4 gg = *(const f32x4*)(p.final_norm + k);
        f32x4 o;
#pragma unroll
        for (int j = 0; j < 4; ++j) o[j] = v[i][j] * rstd * gg[j];
        *(f32x4*)(p.out + (size_t)row * 1024 + k) = o;
      }
    }
  }
}

template <int MB, int DEPTH, class Epi>
DI void gemm_tile(const bf16_t* __restrict__ A, int lda, const bf16_t* __restrict__ Bt, int ldb, int K, int row0, int col0, const Epi& epi, char* smem, int tid) {
  constexpr int ABYTES = MB * 32 * 128, STAGE = ABYTES + 16384;
  const int lane = tid & 63, w = tid >> 6, wr = w >> 1, wc = w & 1, fr = lane & 15, fq = lane >> 4;
  const int lrow = tid >> 3, lc8 = tid & 7, lch = lc8 >> 2, lrr = lrow & 15;
  const char* Ab = (const char*)(A + (size_t)row0 * lda);
  const char* Bb = (const char*)(Bt + (size_t)col0 * ldb);
  const unsigned voa = (unsigned)(lrow * lda + lc8 * 8) * 2u, vob = (unsigned)(lrow * ldb + lc8 * 8) * 2u;
  const int wbase = ((lrow >> 4) * 2 + lch) * 1024 + ((((lrr ^ lch) * 64) + (lc8 & 3) * 16) ^ ((lrr >> 3) << 5));
  const int rlo = (fr * 64 + fq * 16) ^ ((fr >> 3) << 5);
  u32x4 ra[DEPTH][MB], rb[DEPTH][4];
  f32x4 acc[MB][4];
#pragma unroll
  for (int m = 0; m < MB; ++m)
#pragma unroll
    for (int n = 0; n < 4; ++n) acc[m][n] = (f32x4){0.f, 0.f, 0.f, 0.f};
  const int nk = K >> 6;
#define GLOAD(S, K0)                                                                               \
  {                                                                                                \
    _Pragma("unroll") for (int ps = 0; ps < MB; ++ps) ra[S][ps] = *(const u32x4*)(Ab + ((size_t)ps * 64 * lda + (K0) * 2) + voa); \
    _Pragma("unroll") for (int ps = 0; ps < 4; ++ps) rb[S][ps] = *(const u32x4*)(Bb + ((size_t)ps * 64 * ldb + (K0) * 2) + vob);  \
    __builtin_amdgcn_sched_barrier(0);                                                             \
  }
#define SSTORE(S, BUF)                                                                             \
  {                                                                                                \
    char* sw = smem + (BUF) * STAGE + wbase;                                                       \
    _Pragma("unroll") for (int ps = 0; ps < MB; ++ps) *(u32x4*)(sw + ps * 4096) = ra[S][ps];        \
    _Pragma("unroll") for (int ps = 0; ps < 4; ++ps) *(u32x4*)(sw + ABYTES + ps * 4096) = rb[S][ps]; \
  }
#define COMPUTE(BUF)                                                                               \
  {                                                                                                \
    const char* sa = smem + (BUF) * STAGE;                                                         \
    const char* sb = sa + ABYTES;                                                                  \
    _Pragma("unroll") for (int kk = 0; kk < 2; ++kk) {                                             \
      bf16x8 af[MB], bfr[4];                                                                       \
      const int ro = kk * 1024 + (rlo ^ (kk * 64));                                                \
      _Pragma("unroll") for (int m = 0; m < MB; ++m) af[m] = *(const bf16x8*)(sa + (wr * MB + m) * 2048 + ro); \
      _Pragma("unroll") for (int n = 0; n < 4; ++n) bfr[n] = *(const bf16x8*)(sb + (wc * 4 + n) * 2048 + ro);  \
      __builtin_amdgcn_s_setprio(1);                                                               \
      _Pragma("unroll") for (int m = 0; m < MB; ++m) _Pragma("unroll") for (int n = 0; n < 4; ++n) acc[m][n] = MFMA16(bfr[n], af[m], acc[m][n]); \
      __builtin_amdgcn_s_setprio(0);                                                               \
    }                                                                                              \
  }
  if constexpr (DEPTH == 2) {
    GLOAD(0, 0);
    GLOAD(1, 64);
    SSTORE(0, 0);
    __syncthreads();
    for (int kt = 0; kt < nk; kt += 2) {
      if (kt + 2 < nk) GLOAD(0, (kt + 2) * 64);
      COMPUTE(0);
      SSTORE(1, 1);
      __syncthreads();
      if (kt + 3 < nk) GLOAD(1, (kt + 3) * 64);
      COMPUTE(1);
      if (kt + 2 < nk) SSTORE(0, 0);
      __syncthreads();
    }
  } else {
    GLOAD(0, 0);
    SSTORE(0, 0);
    __syncthreads();
    for (int kt = 0; kt < nk; kt += 2) {
      GLOAD(0, (kt + 1) * 64);
      COMPUTE(0);
      SSTORE(0, 1);
      __syncthreads();
      if (kt + 2 < nk) GLOAD(0, (kt + 2) * 64);
      COMPUTE(1);
      if (kt + 2 < nk) SSTORE(0, 0);
      __syncthreads();
    }
  }
#undef GLOAD
#undef SSTORE
#undef COMPUTE
  epi.template tile<MB>(row0 + wr * MB * 16 + fr, col0 + wc * 64, fq, acc);
}

DI void st_bf4(bf16_t* dst, const f32x4& v) {
  u32x2 o = {pk2(v[0], v[1]), pk2(v[2], v[3])};
  *(u32x2*)dst = o;
}

DI void rot4(f32x4& x0, f32x4& x1, const float* tab, int toff, int idx) {
  const f32x4 cs = *(const f32x4*)(tab + idx), sn = *(const f32x4*)(tab + toff + idx);
#pragma unroll
  for (int j = 0; j < 4; ++j) {
    const float a = x0[j], b = x1[j];
    x0[j] = a * cs[j] - b * sn[j];
    x1[j] = b * cs[j] + a * sn[j];
  }
}

struct EpiIn {
  const Params& p; int l; bool atom; bool skip;
  template <int MB> DI void tile(int rbase, int cb, int fq, f32x4 (&acc)[MB][4]) const {
    const float* bwp = p.bw() + (l * 3 + (rbase < NCTX ? 0 : 1 + ((rbase - NCTX) >> 10))) * NP + cb + fq * 4;
    f32x4 bb[4];
    float rs[MB];
#pragma unroll
    for (int n = 0; n < 4; ++n) bb[n] = *(const f32x4*)(bwp + n * 16);
#pragma unroll
    for (int m = 0; m < MB; ++m) rs[m] = p.ssq_x()[l * NTOK + rbase + m * 16];
#pragma unroll
    for (int m = 0; m < MB; ++m) {
      const float r = rsqrtf(rs[m] * (1.f / 1024.f) + EPS);
#pragma unroll
      for (int n = 0; n < 4; ++n)
#pragma unroll
        for (int j = 0; j < 4; ++j) acc[m][n][j] = acc[m][n][j] * r + bb[n][j];
      (*this)(rbase + m * 16, cb, fq, acc[m]);
    }
  }
  DI void operator()(int row, int cb, int fq, f32x4 (&v)[4]) const {
    if (skip) return;
    const bool ctx = row < NCTX;
    int b, t;
    if (ctx) { b = row >> 8; t = row & 255; } else { b = (row - NCTX) >> 10; t = (row - NCTX) & 1023; }
    const int pr = t >> 6, pc = t & 63;
    const int c4 = fq * 4;
    if (cb < 384) {
      float ss = 0.f;
#pragma unroll
      for (int n = 0; n < 4; ++n) ss += v[n][0] * v[n][0] + v[n][1] * v[n][1] + v[n][2] * v[n][2] + v[n][3] * v[n][3];
      { const int ln = fq * 16 + (row & 15); ss += shx(ss, 16, ln); ss += shx(ss, 32, ln); }
      if (cb < 256) {
        if (fq == 0 && atom) atomicAdd(p.ssq_q() + l * NTOK + row, ss);
#pragma unroll
        for (int n = 0; n < 4; ++n) st_bf4(p.cq() + (size_t)row * 256 + cb + n * 16 + c4, v[n]);
      } else {
        if (fq == 0 && atom) atomicAdd(p.ssq_kv() + l * NTOK + row, ss);
        const int c = cb - 256;
#pragma unroll
        for (int n = 0; n < 4; ++n) {
          st_bf4(p.ckvraw() + (size_t)row * 128 + c + n * 16 + c4, v[n]);
          if (ctx) *(f32x4*)(p.out + OUT_CKV + (size_t)((b * 2 + l) * 256 + t) * 128 + c + n * 16 + c4) = v[n];
        }
      }
    } else if (cb < 1152) {
      const int c = cb - 384;
#pragma unroll
      for (int n = 0; n < 4; ++n) st_bf4(p.convb() + (size_t)row * 768 + c + n * 16 + c4, v[n]);
    } else if (cb < 1664) {
      const int c = cb - 1152;
      if (!ctx) { rot4(v[0], v[1], p.ropeD(), 1024, pr * 16 + c4); rot4(v[2], v[3], p.ropeD(), 1024, pc * 16 + c4); }
#pragma unroll
      for (int n = 0; n < 4; ++n) { v[n] *= QSCALE_D; st_bf4(p.dq() + (size_t)row * 512 + c + n * 16 + c4, v[n]); }
    } else if (cb < 2176) {
      const int c = cb - 1664, h = c >> 7, a = (c >> 6) & 1;
      if (ctx) {
#pragma unroll
        for (int n = 0; n < 4; ++n) {
          *(f32x4*)(p.out + OUT_DK + (size_t)((b * 2 + l) * 256 + t) * 512 + c + n * 16 + c4) = v[n];
          st_bf4(p.KdC() + (size_t)(((b * 4 + h) * 2 + a) * 256 + t) * 64 + n * 16 + c4, v[n]);
        }
      } else {
        rot4(v[0], v[1], p.ropeD(), 1024, pr * 16 + c4); rot4(v[2], v[3], p.ropeD(), 1024, pc * 16 + c4);
#pragma unroll
        for (int n = 0; n < 4; ++n) st_bf4(p.KdL() + (size_t)l * 1310720 + (size_t)(((b * 4 + h) * 2 + a) * 1280 + 256 + t) * 64 + n * 16 + c4, v[n]);
      }
    } else if (cb < 2688) {
      const int c = cb - 2176, h = c >> 7, e0 = (c & 127) + c4;
      if (ctx) {
#pragma unroll
        for (int n = 0; n < 4; ++n) {
          *(f32x4*)(p.out + OUT_DV + (size_t)((b * 2 + l) * 256 + t) * 512 + c + n * 16 + c4) = v[n];
#pragma unroll
          for (int j = 0; j < 4; ++j) p.VdC()[(size_t)((b * 4 + h) * 128 + e0 + n * 16 + j) * 256 + t] = f2bf(v[n][j]);
        }
      } else {
#pragma unroll
        for (int n = 0; n < 4; ++n)
#pragma unroll
          for (int j = 0; j < 4; ++j) p.VdL()[(size_t)l * 1310720 + (size_t)((b * 4 + h) * 128 + e0 + n * 16 + j) * 1280 + 256 + t] = f2bf(v[n][j]);
      }
    } else if (cb < 3712) {
      const int c = cb - 2688;
#pragma unroll
      for (int n = 0; n < 4; ++n) {
        f32x4 s;
#pragma unroll
        for (int j = 0; j < 4; ++j) s[j] = silu_f(v[n][j]);
        st_bf4(p.zs() + (size_t)row * 1024 + c + n * 16 + c4, s);
      }
    } else if (cb == 3712) {
      const int o0 = (fq < 2) ? c4 : c4 + 8;
      if (ctx) {
        float* so = p.out + OUT_KR + (size_t)((b * 2 + l) * 256 + t) * 32 + o0;
        *(f32x4*)so = v[0];
        *(f32x4*)(so + 8) = v[1];
#pragma unroll
        for (int h = 0; h < 4; ++h) {
          bf16_t* d = p.KmC() + (size_t)((b * 4 + h) * 256 + t) * 96 + 64 + o0;
          st_bf4(d, v[0]); st_bf4(d + 8, v[1]);
        }
      } else {
        if (fq < 2) rot4(v[0], v[1], p.ropeM(), 512, pr * 8 + c4); else rot4(v[0], v[1], p.ropeM(), 512, pc * 8 + c4 - 8);
#pragma unroll
        for (int h = 0; h < 4; ++h) {
          bf16_t* d = p.KmL() + (size_t)l * 983040 + (size_t)((b * 4 + h) * 1280 + 256 + t) * 96 + 64 + o0;
          st_bf4(d, v[0]); st_bf4(d + 8, v[1]);
        }
      }
    }
  }
};

struct EpiQ {
  const Params& p; int l;
  template <int MB> DI void tile(int rbase, int cb, int fq, f32x4 (&acc)[MB][4]) const {
#pragma unroll
    for (int m = 0; m < MB; ++m) (*this)(rbase + m * 16, cb, fq, acc[m]);
  }
  DI void operator()(int row, int cb, int fq, f32x4 (&v)[4]) const {
    const bool ctx = row < NCTX;
    const int t = (row - NCTX) & 1023, pr = t >> 6, pc = t & 63, c4 = fq * 4;
    const float f = rsqrtf(p.ssq_q()[l * NTOK + row] * (1.f / 256.f) + EPS) * QSCALE_M;
#pragma unroll
    for (int g = 0; g < 2; ++g) {
      const int cs = cb + 32 * g;
      v[2 * g] *= f; v[2 * g + 1] *= f;
      if (cs % 96 == 64) {
        const int o0 = (fq < 2) ? c4 : c4 + 8;
        if (!ctx) { if (fq < 2) rot4(v[2 * g], v[2 * g + 1], p.ropeM(), 512, pr * 8 + c4); else rot4(v[2 * g], v[2 * g + 1], p.ropeM(), 512, pc * 8 + c4 - 8); }
        bf16_t* d = p.qm() + (size_t)row * 384 + cs + o0;
        st_bf4(d, v[2 * g]); st_bf4(d + 8, v[2 * g + 1]);
      } else {
        bf16_t* d = p.qm() + (size_t)row * 384 + cs + c4;
        st_bf4(d, v[2 * g]); st_bf4(d + 16, v[2 * g + 1]);
      }
    }
  }
};

struct EpiKV {
  const Params& p; int l; int mode;
  template <int MB> DI void tile(int rbase, int cb, int fq, f32x4 (&acc)[MB][4]) const {
#pragma unroll
    for (int m = 0; m < MB; ++m) (*this)(rbase + m * 16, cb, fq, acc[m]);
  }
  DI void operator()(int row, int cb, int fq, f32x4 (&v)[4]) const {
    const int h = cb >> 7, c4 = fq * 4;
    const bool isV = (cb & 64) != 0;
    float f = 1.f;
    bf16_t *kd, *vd; int vstride;
    if (mode == 0) {
      f = rsqrtf(p.ssq_kv()[l * NTOK + row] * (1.f / 128.f) + EPS);
      if (row < NCTX) {
        const int b = row >> 8, t = row & 255;
        kd = p.KmC() + (size_t)((b * 4 + h) * 256 + t) * 96; vd = p.VmC() + (size_t)((b * 4 + h) * 64) * 256 + t; vstride = 256;
      } else {
        const int b = (row - NCTX) >> 10, t = (row - NCTX) & 1023;
        kd = p.KmL() + (size_t)l * 983040 + (size_t)((b * 4 + h) * 1280 + 256 + t) * 96; vd = p.VmL() + (size_t)l * 655360 + (size_t)((b * 4 + h) * 64) * 1280 + 256 + t; vstride = 1280;
      }
    } else {
      const int b = row >> 8, t = row & 255;
      kd = p.KmL() + (size_t)l * 983040 + (size_t)((b * 4 + h) * 1280 + t) * 96; vd = p.VmL() + (size_t)l * 655360 + (size_t)((b * 4 + h) * 64) * 1280 + t; vstride = 1280;
    }
#pragma unroll
    for (int n = 0; n < 4; ++n) {
      v[n] *= f;
      if (!isV) st_bf4(kd + n * 16 + c4, v[n]);
      else {
#pragma unroll
        for (int j = 0; j < 4; ++j) vd[(size_t)(n * 16 + c4 + j) * vstride] = f2bf(v[n][j]);
      }
    }
  }
};

struct EpiOut {
  const Params& p; int l;
  template <int MB> DI void tile(int rbase, int cb, int fq, f32x4 (&acc)[MB][4]) const {
    const float* gate0 = p.mod() + (l * 3) * 3072 + 2048 + cb + fq * 4;
    f32x4 xv[MB][4];
#pragma unroll
    for (int m = 0; m < MB; ++m) {
      const int row = rbase + m * 16;
      const float* xo = (l == 0) ? (row < NCTX ? p.x_prompt + (size_t)row * 1024 : p.x_sample + (size_t)(row - NCTX) * 1024) : p.xbuf() + (size_t)row * 1024;
#pragma unroll
      for (int n = 0; n < 4; ++n) xv[m][n] = *(const f32x4*)(xo + cb + n * 16 + fq * 4);
    }
    __builtin_amdgcn_sched_barrier(0);
    const int ln = fq * 16 + (rbase & 15);
#pragma unroll
    for (int m = 0; m < MB; ++m) {
      const int row = rbase + m * 16;
      const int ci = row < NCTX ? 0 : 1 + ((row - NCTX) >> 10);
      float ss = 0.f;
#pragma unroll
      for (int n = 0; n < 4; ++n) {
        const int col = cb + n * 16 + fq * 4;
        const f32x4 g = *(const f32x4*)(gate0 + ci * 3072 + n * 16);
        f32x4 o;
#pragma unroll
        for (int j = 0; j < 4; ++j) { o[j] = xv[m][n][j] + g[j] * acc[m][n][j]; ss += o[j] * o[j]; }
        *(f32x4*)(p.xbuf() + (size_t)row * 1024 + col) = o;
        if (l == 0) {
          const f32x4 gg = *(const f32x4*)(p.norm_g + 1024 + col), sc = *(const f32x4*)(p.mod() + (3 + ci) * 3072 + 1024 + col);
          u32x2 pk = {pk2(o[0] * gg[0] * (1.f + sc[0]), o[1] * gg[1] * (1.f + sc[1])), pk2(o[2] * gg[2] * (1.f + sc[2]), o[3] * gg[3] * (1.f + sc[3]))};
          *(u32x2*)(p.hbuf() + (size_t)row * 1024 + col) = pk;
        }
      }
      ss += shx(ss, 16, ln); ss += shx(ss, 32, ln);
      if (fq == 0) atomicAdd(p.ssq_x() + (l + 1) * NTOK + row, ss);
    }
  }
};

template <int MINE, int THEIRS>
DI void diff_finalize(f32x16 (&O)[4], float f, float sgn, const float* __restrict__ subln, float osc, char* smem, int w, int lane, int hh,
                      bf16_t* __restrict__ orow, const bf16_t* __restrict__ zrow, bool active) {
  float* ex = (float*)smem;
  float* sx = ex + 4 * 32 * 64;
  if (active) {
#pragma unroll
    for (int d = 0; d < 2; ++d)
#pragma unroll
      for (int i = 0; i < 16; ++i) ex[(w * 32 + d * 16 + i) * 64 + lane] = O[THEIRS + d][i] * f;
  }
  __syncthreads();
  if (!active) { __syncthreads(); return; }
  const float* pe = ex + (w ^ 1) * 32 * 64;
  float ss = 0.f;
#pragma unroll
  for (int d = 0; d < 2; ++d)
#pragma unroll
    for (int i = 0; i < 16; ++i) {
      const float mine = O[MINE + d][i] * f, theirs = pe[(d * 16 + i) * 64 + lane];
      const float o = (sgn == 0.f) ? (mine - theirs) : (theirs - mine);
      O[MINE + d][i] = o; ss += o * o;
    }
  ss += shx(ss, 32, lane);
  sx[w * 64 + lane] = ss;
  __syncthreads();
  ss += sx[(w ^ 1) * 64 + lane];
  const float rs = rsqrtf(ss * (1.f / 128.f) + EPS) * osc;
#pragma unroll
  for (int d = 0; d < 2; ++d) {
#pragma unroll
    for (int g = 0; g < 4; ++g) {
      const int d0 = (MINE + d) * 32 + g * 8 + hh * 4;
      const f32x4 sg = *(const f32x4*)(subln + d0);
      const u32x2 z = *(const u32x2*)(zrow + d0);
      u32x2 o = {pk2(O[MINE + d][4 * g] * rs * sg[0] * bflo(z[0]), O[MINE + d][4 * g + 1] * rs * sg[1] * bfhi(z[0])),
                 pk2(O[MINE + d][4 * g + 2] * rs * sg[2] * bflo(z[1]), O[MINE + d][4 * g + 3] * rs * sg[3] * bfhi(z[1]))};
      *(u32x2*)(orow + d0) = o;
    }
    __builtin_amdgcn_sched_barrier(0);
  }
}

template <int DQK, int DV, bool DIFF, bool SPLIT>
DI void attn_item(const bf16_t* __restrict__ Qp, int ldq, const bf16_t* __restrict__ Kp, const bf16_t* __restrict__ Vtp, int nkeys,
                  bf16_t* __restrict__ outp, const bf16_t* __restrict__ zsp, float lamf, const float* __restrict__ subln, float osc, char* smem, int tid,
                  int warm_n = 0, int warm_share = 0) {
  constexpr int NMAPK = DIFF ? 2 : 1;
  constexpr int KROW = (DQK + 8) * 2;
  constexpr int KMAPB = 64 * KROW;
  constexpr int VROW = 136;
  constexpr int NS = DQK / 16, NDB = DV / 32;
  constexpr int BUFB = NMAPK * KMAPB + DV * VROW;
  constexpr int NT = SPLIT ? 2 : 1;
  char* sK = smem;
  char* sV = smem + NMAPK * KMAPB;
  const int lane = tid & 63, w = tid >> 6, r = lane & 31, hh = lane >> 5;
  const int kh = SPLIT ? (w >> 1) : 0;
  const int qb = SPLIT ? (DIFF ? 0 : (w & 1)) : (DIFF ? (w >> 1) : w);
  const int am = DIFF ? (w & 1) : 0;
  bf16x8 qf[NS];
#pragma unroll
  for (int s = 0; s < NS; ++s) qf[s] = *(const bf16x8*)(Qp + (size_t)(qb * 32 + r) * ldq + am * 64 + s * 16 + hh * 8);
  f32x16 O[NDB];
  float mrun = -1e30f, lrun = 0.f;
#pragma unroll
  for (int db = 0; db < NDB; ++db)
#pragma unroll
    for (int i = 0; i < 16; ++i) O[db][i] = 0.f;
  const char* sKa = sK + am * KMAPB + r * KROW + hh * 16;
  const char* sVa = sV + r * VROW + hh * 8;
  const int nkt = nkeys >> 6, nit = SPLIT ? (nkt >> 1) : nkt;
  constexpr int KCH = 64 * DQK / 8;
  constexpr int NKC = (KCH + 255) / 256, NVC = DV * 8 / 256;
  u32x4 kreg[NT][NMAPK][NKC], vreg[NT][NVC];
#define ATT_GLOAD(J)                                                                               \
  {                                                                                                \
    _Pragma("unroll") for (int t = 0; t < NT; ++t) {                                               \
      const int tile = t * nit + (J);                                                              \
      _Pragma("unroll") for (int a = 0; a < NMAPK; ++a) {                                          \
        const bf16_t* kg = Kp + (size_t)a * nkeys * DQK + (size_t)tile * 64 * DQK;                  \
        _Pragma("unroll") for (int c = 0; c < NKC; ++c) {                                          \
          const int ch = c * 256 + tid;                                                            \
          if (KCH % 256 == 0 || ch < KCH) kreg[t][a][c] = *(const u32x4*)(kg + (size_t)ch * 8);     \
        }                                                                                          \
      }                                                                                            \
      const bf16_t* vg = Vtp + (size_t)tile * 64;                                                   \
      _Pragma("unroll") for (int c = 0; c < NVC; ++c) {                                            \
        const int ch = c * 256 + tid, d = ch >> 3, part = ch & 7;                                  \
        vreg[t][c] = *(const u32x4*)(vg + (size_t)d * nkeys + part * 8);                            \
      }                                                                                            \
    }                                                                                              \
    __builtin_amdgcn_sched_barrier(0);                                                             \
  }
#define ATT_SWRITE(BUF)                                                                            \
  {                                                                                                \
    _Pragma("unroll") for (int t = 0; t < NT; ++t) {                                               \
      char* bK = sK + (SPLIT ? t : (BUF)) * BUFB;                                                  \
      char* bV = sV + (SPLIT ? t : (BUF)) * BUFB;                                                  \
      _Pragma("unroll") for (int a = 0; a < NMAPK; ++a) _Pragma("unroll") for (int c = 0; c < NKC; ++c) { \
        const int ch = c * 256 + tid;                                                              \
        if (KCH % 256 == 0 || ch < KCH) {                                                          \
          const int key = ch / (DQK / 8), part = ch % (DQK / 8);                                   \
          *(u32x4*)(bK + a * KMAPB + key * KROW + part * 16) = kreg[t][a][c];                       \
        }                                                                                          \
      }                                                                                            \
      _Pragma("unroll") for (int c = 0; c < NVC; ++c) {                                            \
        const int ch = c * 256 + tid, d = ch >> 3, part = ch & 7;                                  \
        u32x2 lo = {vreg[t][c][0], vreg[t][c][1]}, hi = {vreg[t][c][2], vreg[t][c][3]};            \
        *(u32x2*)(bV + d * VROW + part * 16) = lo;                                                 \
        *(u32x2*)(bV + d * VROW + part * 16 + 8) = hi;                                             \
      }                                                                                            \
    }                                                                                              \
  }
  auto compute = [&](const char* sKb, const char* sVb) {
    f32x16 st[2];
#pragma unroll
    for (int kb = 0; kb < 2; ++kb) {
#pragma unroll
      for (int i = 0; i < 16; ++i) st[kb][i] = 0.f;
#pragma unroll
      for (int s = 0; s < NS; ++s) {
        const bf16x8 kf = *(const bf16x8*)(sKb + kb * 32 * KROW + s * 32);
        st[kb] = MFMA32(kf, qf[s], st[kb]);
      }
    }
    float mx = st[0][0];
#pragma unroll
    for (int i = 1; i < 16; ++i) mx = fmaxf(mx, st[0][i]);
#pragma unroll
    for (int i = 0; i < 16; ++i) mx = fmaxf(mx, st[1][i]);
    mx = fmaxf(mx, shx(mx, 32, lane));
    const float mnew = fmaxf(mrun, mx);
    const float alpha = __builtin_amdgcn_exp2f(mrun - mnew);
    mrun = mnew;
    float ls = 0.f;
#pragma unroll
    for (int kb = 0; kb < 2; ++kb)
#pragma unroll
      for (int i = 0; i < 16; ++i) { const float e = __builtin_amdgcn_exp2f(st[kb][i] - mnew); st[kb][i] = e; ls += e; }
    lrun = lrun * alpha + ls;
    if (__builtin_amdgcn_ballot_w64(alpha != 1.f) != 0) {
#pragma unroll
      for (int db = 0; db < NDB; ++db)
#pragma unroll
        for (int i = 0; i < 16; ++i) O[db][i] *= alpha;
    }
#pragma unroll
    for (int kb = 0; kb < 2; ++kb)
#pragma unroll
      for (int t2 = 0; t2 < 2; ++t2) {
        u32x4 pp;
#pragma unroll
        for (int j = 0; j < 4; ++j) pp[j] = pk2(st[kb][8 * t2 + 2 * j], st[kb][8 * t2 + 2 * j + 1]);
        const bf16x8 pf = __builtin_bit_cast(bf16x8, pp);
#pragma unroll
        for (int db = 0; db < NDB; ++db) {
          const char* vb = sVb + db * 32 * VROW + (kb * 32 + 16 * t2) * 2;
          const u32x2 lo = *(const u32x2*)vb, hi = *(const u32x2*)(vb + 16);
          const u32x4 vv = {lo[0], lo[1], hi[0], hi[1]};
          O[db] = MFMA32(__builtin_bit_cast(bf16x8, vv), pf, O[db]);
        }
        if constexpr (DIFF && SPLIT) __builtin_amdgcn_sched_barrier(0);
      }
  };
  ATT_GLOAD(0);
  unsigned w0 = 0u, w1 = 0u;
  if (warm_n > 0) {
    const int lk = (NMAPK * nkeys * DQK * 2 / 128) / warm_n, lv = (DV * nkeys * 2 / 128) / warm_n;
    if (tid < lk) w0 = *(const volatile unsigned*)((const char*)Kp + (size_t)(warm_share * lk + tid) * 128);
    if (tid < lv) w1 = *(const volatile unsigned*)((const char*)Vtp + (size_t)(warm_share * lv + tid) * 128);
  }
  if constexpr (!SPLIT) {
    __syncthreads();
    ATT_SWRITE(0);
    if (nit > 1) ATT_GLOAD(1);
    __syncthreads();
    for (int kt = 0; kt < nit; ++kt) {
      if (kt + 1 < nit) {
        ATT_SWRITE((kt + 1) & 1);
        if (kt + 2 < nit) ATT_GLOAD(kt + 2);
      }
      compute(sKa + (kt & 1) * BUFB, sVa + (kt & 1) * BUFB);
      __syncthreads();
    }
  } else {
    for (int j = 0; j < nit; ++j) {
      __syncthreads();
      ATT_SWRITE(0);
      __syncthreads();
      if (j + 1 < nit) ATT_GLOAD(j + 1);
      compute(sKa + kh * BUFB, sVa + kh * BUFB);
    }
    __syncthreads();
    float* mg = (float*)(smem + 36864);
    float* mlb = mg + 2 * NDB * 16 * 64;
    const int wl = w & 1;
    if (kh == 1) {
#pragma unroll
      for (int db = 0; db < NDB; ++db)
#pragma unroll
        for (int i = 0; i < 16; ++i) mg[((wl * NDB + db) * 16 + i) * 64 + lane] = O[db][i];
      mlb[(wl * 2 + 0) * 64 + lane] = mrun;
      mlb[(wl * 2 + 1) * 64 + lane] = lrun;
    }
    __syncthreads();
    if (kh == 0) {
      const float m1 = mlb[(wl * 2 + 0) * 64 + lane], l1 = mlb[(wl * 2 + 1) * 64 + lane];
      const float mn = fmaxf(mrun, m1);
      const float s0 = __builtin_amdgcn_exp2f(mrun - mn), s1 = __builtin_amdgcn_exp2f(m1 - mn);
      lrun = lrun * s0 + l1 * s1;
      mrun = mn;
#pragma unroll
      for (int db = 0; db < NDB; ++db)
#pragma unroll
        for (int i = 0; i < 16; ++i) O[db][i] = O[db][i] * s0 + mg[((wl * NDB + db) * 16 + i) * 64 + lane] * s1;
    }
  }
#undef ATT_GLOAD
#undef ATT_SWRITE
  const float inv = 1.f / (lrun + shx(lrun, 32, lane));
  const size_t ro = (size_t)(qb * 32 + r) * 1024;
  const bool active = (kh == 0);
  if constexpr (DIFF) {
    __syncthreads();
    if (am == 0) diff_finalize<0, 2>(O, inv, 0.f, subln, osc, smem, w, lane, hh, outp + ro, zsp + ro, active);
    else diff_finalize<2, 0>(O, inv * lamf, 1.f, subln, osc, smem, w, lane, hh, outp + ro, zsp + ro, active);
  } else {
    if (active) {
#pragma unroll
      for (int db = 0; db < NDB; ++db) {
#pragma unroll
        for (int g = 0; g < 4; ++g) {
          const int d0 = db * 32 + g * 8 + hh * 4;
          const u32x2 z = *(const u32x2*)(zsp + ro + d0);
          u32x2 o = {pk2(O[db][4 * g] * inv * bflo(z[0]), O[db][4 * g + 1] * inv * bfhi(z[0])), pk2(O[db][4 * g + 2] * inv * bflo(z[1]), O[db][4 * g + 3] * inv * bfhi(z[1]))};
          *(u32x2*)(outp + ro + d0) = o;
        }
        __builtin_amdgcn_sched_barrier(0);
      }
    }
  }
  if ((w0 ^ w1) == 0x7fc54321u && warm_n < 0) ((volatile unsigned*)smem)[0] = w0;
}

DI void conv_item(const Params& p, int l, int it, int tid) {
  const int ch = (tid & 31) * 8, rr = tid >> 5;
  float w0[8], w1[8], w2[8];
#pragma unroll
  for (int j = 0; j < 8; ++j) { w0[j] = p.conv_w[l * 768 + ch + j]; w1[j] = p.conv_w[l * 768 + 256 + ch + j]; w2[j] = p.conv_w[l * 768 + 512 + ch + j]; }
  for (int i = 0; i < 16; ++i) {
    const int row = it * 128 + i * 8 + rr;
    int t, len;
    if (row < NCTX) { t = row & 255; len = 256; } else { t = (row - NCTX) & 1023; len = 1024; }
    const bf16_t* base = p.convb() + (size_t)row * 768;
    const u32x4 zero = {0u, 0u, 0u, 0u};
    const u32x4 cbv = *(const u32x4*)(base + ch);
    const u32x4 c1 = *(const u32x4*)(base + 256 + ch), x1 = *(const u32x4*)(base + 512 + ch);
    const u32x4 c0 = t > 0 ? *(const u32x4*)(base - 768 + 256 + ch) : zero, x0 = t > 0 ? *(const u32x4*)(base - 768 + 512 + ch) : zero;
    const u32x4 c2 = t < len - 1 ? *(const u32x4*)(base + 768 + 256 + ch) : zero, x2 = t < len - 1 ? *(const u32x4*)(base + 768 + 512 + ch) : zero;
    const u32x4 zv = *(const u32x4*)(p.zs() + (size_t)row * 1024 + 256 + ch);
    u32x4 o;
#pragma unroll
    for (int q = 0; q < 4; ++q) {
      const float ylo = bflo(c0[q]) * bflo(x0[q]) * w0[2 * q] + bflo(c1[q]) * bflo(x1[q]) * w1[2 * q] + bflo(c2[q]) * bflo(x2[q]) * w2[2 * q];
      const float yhi = bfhi(c0[q]) * bfhi(x0[q]) * w0[2 * q + 1] + bfhi(c1[q]) * bfhi(x1[q]) * w1[2 * q + 1] + bfhi(c2[q]) * bfhi(x2[q]) * w2[2 * q + 1];
      o[q] = pk2(bflo(cbv[q]) * ylo * bflo(zv[q]), bfhi(cbv[q]) * yhi * bfhi(zv[q]));
    }
    *(u32x4*)(p.mix() + (size_t)row * 1024 + 256 + ch) = o;
  }
}

DI void phase_mix(const Params& p, int l, char* smem, int mask = 7) {
  const int lane = opaque_tid() & 63;
  const float* lm = p.lam + l * 256;
  const float s01 = wave_sum(lm[lane] * lm[64 + lane], lane), s23 = wave_sum(lm[128 + lane] * lm[192 + lane], lane);
  const float lam_init = (l == 0) ? 0.2f : 0.35550906759096934f;
  const float lamf = __int_as_float(__builtin_amdgcn_readfirstlane(__float_as_int(__expf(s01) - __expf(s23) + lam_init)));
  const float osc = 1.f - lam_init;
  const int bid = opaque_bid(), G = gridDim.x;
  for (int slot = 0;; ++slot) {
    int it;
    if (G == 512) {
      if (slot == 0) it = bid;
      else if (slot == 1) it = bid < 128 ? -1 : bid < 192 ? 704 + (bid - 128) : bid < 384 ? 512 + (bid - 192) : 768 + (bid - 384);
      else if (slot == 2) it = bid < 384 ? -1 : bid < 448 ? 896 + (bid - 384) : 960 + (bid - 448);
      else if (slot == 3) it = (bid >= 192 && bid < 208) ? 1024 + (bid - 192) : -1;
      else break;
      if (it < 0) continue;
    } else {
      it = slot * G + bid;
      if (it >= 1040) break;
    }
    int tid = threadIdx.x;
    asm volatile("" : "+v"(tid));
#if REP >= 40
    { const bool isdiff = it < 128 || (it >= 192 && it < 704), ismla = (it >= 128 && it < 192) || (it >= 704 && it < 960), islat = it < 192;
      if (mask == 1 && !isdiff) continue; if (mask == 2 && !ismla) continue; if (mask == 3 && !islat) continue; if (mask == 4 && !(isdiff && islat)) continue; }
#endif
    if (it < 128 || (it >= 192 && it < 704)) {
      int b, h, qt; size_t row0; const bf16_t *kp, *vp; int nk;
      if (it < 128) {
        const int x = it & 7; b = x >> 2; h = x & 3; qt = it >> 3; row0 = NCTX + b * 1024 + qt * 64; nk = 1280;
        kp = p.KdL() + (size_t)l * 1310720 + (size_t)((b * 4 + h) * 2) * 1280 * 64; vp = p.VdL() + (size_t)l * 1310720 + (size_t)((b * 4 + h) * 128) * 1280;
      } else {
        const int j = it - 192, combo = (j & 7) | ((j >> 5) << 3); b = combo >> 2; h = combo & 3; qt = (j >> 3) & 3; row0 = b * 256 + qt * 64; nk = 256;
        kp = p.KdC() + (size_t)((b * 4 + h) * 2) * 256 * 64; vp = p.VdC() + (size_t)((b * 4 + h) * 128) * 256;
      }
      attn_item<64, 128, true, false>(p.dq() + row0 * 512 + h * 128, 512, kp, vp, nk, p.mix() + row0 * 1024 + 512 + h * 128, p.zs() + row0 * 1024 + 512 + h * 128,
                                      lamf, p.subln + l * 128, osc, smem, tid, it < 128 ? 16 : 0, qt);
    } else if (it < 960) {
      int b, h, qt; size_t row0; const bf16_t *kp, *vp; int nk;
      if (it < 192) {
        const int j = it - 128, x = j & 7; b = x >> 2; h = x & 3; qt = j >> 3; row0 = NCTX + b * 1024 + qt * 128; nk = 1280;
        kp = p.KmL() + (size_t)l * 983040 + (size_t)(b * 4 + h) * 1280 * 96; vp = p.VmL() + (size_t)l * 655360 + (size_t)((b * 4 + h) * 64) * 1280;
      } else {
        const int j = it - 704, combo = (j & 7) | ((j >> 4) << 3); b = combo >> 2; h = combo & 3; qt = (j >> 3) & 1; row0 = b * 256 + qt * 128; nk = 256;
        kp = p.KmC() + (size_t)(b * 4 + h) * 256 * 96; vp = p.VmC() + (size_t)((b * 4 + h) * 64) * 256;
      }
      attn_item<96, 64, false, false>(p.qm() + row0 * 384 + h * 96, 384, kp, vp, nk, p.mix() + row0 * 1024 + h * 64, p.zs() + row0 * 1024 + h * 64, 0.f, nullptr, 1.f, smem, tid, it < 192 ? 8 : 0, qt);
    } else {
      conv_item(p, l, it - 960, tid);
    }
  }
}

DI void phase_inproj(const Params& p, int l, char* smem, bool atom = true, bool skip = false) {
  EpiIn epi{p, l, atom, skip};
  const int tid = opaque_tid(), bid = opaque_bid();
  const int xcd = bid & 7, nloc = (gridDim.x + 7 - xcd) >> 3;
  for (int j = bid >> 3; j < 300; j += nloc) {
    const int mt = xcd * 10 + j % 10, nt = j / 10;
    gemm_tile<4, 2>(p.hbuf(), 1024, p.WinT() + (size_t)l * NP * 1024, 1024, 1024, mt * 128, nt * 128, epi, smem, tid);
  }
}

DI void phase_upproj(const Params& p, int l, char* smem, bool fix = true) {
  const int tid = opaque_tid(), bid = opaque_bid();
  if (fix) {
    const float* g = p.kv_norm + l * 128;
    for (int i = bid * 256 + tid; i < NCTX * 32; i += gridDim.x * 256) {
      const int row = i >> 5, c = (i & 31) * 4, b = row >> 8, t = row & 255;
      const float f = rsqrtf(p.ssq_kv()[l * NTOK + row] * (1.f / 128.f) + EPS);
      float* d = p.out + OUT_CKV + (size_t)((b * 2 + l) * 256 + t) * 128 + c;
      f32x4 v = *(f32x4*)d;
      const f32x4 gg = *(const f32x4*)(g + c);
#pragma unroll
      for (int j = 0; j < 4; ++j) v[j] *= f * gg[j];
      *(f32x4*)d = v;
    }
  }
  EpiQ eq{p, l};
  EpiKV ek0{p, l, 0}, ek1{p, l, 1};
  for (int it = bid; it < 464; it += gridDim.x) {
    if (it < 192) {
      const int mt = it / 3, nt = it % 3;
      gemm_tile<5, 1>(p.cq(), 256, p.WuqT() + (size_t)l * 384 * 256, 256, 256, mt * 160, nt * 128, eq, smem, tid);
    } else if (it < 448) {
      const int j = it - 192, mt = j >> 2, nt = j & 3;
      gemm_tile<5, 1>(p.ckvraw(), 128, p.WukvTf() + (size_t)l * 512 * 128, 128, 128, mt * 160, nt * 128, ek0, smem, tid);
    } else {
      const int j = it - 448, mt = j >> 2, nt = j & 3;
      gemm_tile<4, 1>(p.cckv() + (size_t)l * 65536, 128, p.WukvT() + (size_t)l * 512 * 128, 128, 128, mt * 128, nt * 128, ek1, smem, tid);
    }
  }
}

DI void phase_outproj(const Params& p, int l, char* smem) {
  EpiOut epi{p, l};
  const int tid = opaque_tid(), bid = opaque_bid();
  const int xcd = bid & 7, nloc = (gridDim.x + 7 - xcd) >> 3;
  for (int j = bid >> 3; j < 64; j += nloc) {
    const int mt = xcd * 8 + (j & 7), nt = j >> 3;
    gemm_tile<5, 1>(p.mix(), 1024, p.WoutT() + (size_t)l * 1024 * 1024, 1024, 1024, mt * 160, nt * 128, epi, smem, tid);
  }
}

__global__ void __launch_bounds__(256, 2) fwd_megakernel(Params p) {
  __shared__ __attribute__((aligned(16))) char smem[73728];
  __shared__ __attribute__((aligned(16))) unsigned xb_words[4];
  cg::grid_group grid = cg::this_grid();
  if (p.ws == nullptr) grid.sync();
  if (threadIdx.x == 0) { xb_words[0] = 0u; xb_words[1] = 0u; xb_words[2] = 0u; xb_words[3] = 0u; }
  __syncthreads();
  const XcdBarrier xb = xcd_barrier_post(p.bar(), (volatile LAS unsigned*)xb_words);
#define GSYNC() xcd_barrier(xb)
  phase0(p, smem);
#if REP == 0
  GSYNC(); phase0(p, smem);
#endif
#pragma unroll
  for (int l = 0; l < 2; ++l) {
    GSYNC();
    if (l == 0) { phase_norm(p, 0); GSYNC(); }
#if REP == 2
    phase_inproj(p, l, smem, false); GSYNC();
#endif
#if REP == 7
    phase_inproj(p, l, smem, false, p.ws != nullptr); GSYNC();
#endif
    phase_inproj(p, l, smem);
    GSYNC();
#if REP == 3
    phase_upproj(p, l, smem, false); GSYNC();
#endif
    phase_upproj(p, l, smem);
    GSYNC();
#if REP == 4
    phase_mix(p, l, smem); GSYNC();
#endif
#if REP >= 40
    phase_mix(p, l, smem, REP - 40); GSYNC();
#endif
    phase_mix(p, l, smem);
    GSYNC();
#if REP == 5
    if (l == 0) { phase_outproj(p, l, smem); GSYNC(); }
#endif
    phase_outproj(p, l, smem);
  }
  GSYNC();
  phase_norm(p, 2);
#if REP == 6
  for (int i = 0; i < 10; ++i) GSYNC();
#endif
}

extern "C" void kernel_launch(void* const* d_in, const int* in_sizes, int n_in, void* d_out, int out_size, void* d_ws, size_t ws_size, hipStream_t stream) {
  static int grid_blocks = 0;
  if (!grid_blocks) {
    int dev = 0, cus = 0, per_cu = 0;
    hipGetDevice(&dev);
    hipDeviceGetAttribute(&cus, hipDeviceAttributeMultiprocessorCount, dev);
    hipOccupancyMaxActiveBlocksPerMultiprocessor(&per_cu, fwd_megakernel, 256, 0);
    if (per_cu > 2) per_cu = 2;
    if (per_cu < 1) per_cu = 1;
    grid_blocks = cus * per_cu;
  }
  Params p{};
  p.x_prompt = (const float*)d_in[0]; p.x_sample = (const float*)d_in[1]; p.c = (const float*)d_in[2];
  p.cache_ckv = (const float*)d_in[3]; p.cache_krope = (const float*)d_in[4]; p.cache_dk = (const float*)d_in[5]; p.cache_dv = (const float*)d_in[6];
  p.c_ctx = (const float*)d_in[7]; p.norm_g = (const float*)d_in[8]; p.ada_w = (const float*)d_in[9]; p.ada_b = (const float*)d_in[10];
  p.w_in = (const float*)d_in[11]; p.q_norm = (const float*)d_in[12]; p.w_uq = (const float*)d_in[13]; p.kv_norm = (const float*)d_in[14];
  p.w_ukv = (const float*)d_in[15]; p.conv_w = (const float*)d_in[16]; p.lam = (const float*)d_in[17]; p.subln = (const float*)d_in[18];
  p.w_out = (const float*)d_in[19]; p.final_norm = (const float*)d_in[20];
  p.out = (float*)d_out;
  p.ws = (char*)d_ws;
  if (ws_size < WS_TOTAL) fprintf(stderr, "workspace too small\n");
  hipMemsetAsync(d_ws, 0, OFF_WinT, stream);
  void* args[] = {&p};
  hipError_t e = hipLaunchCooperativeKernel((void*)fwd_megakernel, dim3(grid_blocks), dim3(256), args, 0, stream);
  if (e != hipSuccess) fprintf(stderr, "cooperative launch failed: %s (grid %d)\n", hipGetErrorString(e), grid_blocks);
}
```

```cpp
#include <hip/hip_runtime.h>
#include <hip/hip_cooperative_groups.h>
#include <cstdio>
namespace cg = cooperative_groups;

typedef unsigned short bf16_t;
typedef short bf16x8 __attribute__((ext_vector_type(8)));
typedef float f32x2 __attribute__((ext_vector_type(2)));
typedef float f32x4 __attribute__((ext_vector_type(4)));
typedef float f32x16 __attribute__((ext_vector_type(16)));
typedef unsigned u32x2 __attribute__((ext_vector_type(2)));
typedef unsigned u32x4 __attribute__((ext_vector_type(4)));
typedef __bf16 bf16x2_t __attribute__((ext_vector_type(2)));

#ifndef REP
#define REP -1
#endif
#define DI __device__ __forceinline__
#define MFMA16(a, b, c) __builtin_amdgcn_mfma_f32_16x16x32_bf16((a), (b), (c), 0, 0, 0)
#define MFMA32(a, b, c) __builtin_amdgcn_mfma_f32_32x32x16_bf16((a), (b), (c), 0, 0, 0)

#define XCD_BAR_WORDS 3456
constexpr int NCTX = 8192, NTOK = 10240, NP = 3840;
constexpr float EPS = 1e-6f;
constexpr float QSCALE_M = 0.14724444602590306f;
constexpr float QSCALE_D = 0.18033688011112042f;
constexpr size_t OUT_CKV = 10485760, OUT_KR = 12582912, OUT_DK = 13107200, OUT_DV = 21495808;

__constant__ float INV16[16] = {1.000000000e+00f, 5.623413324e-01f, 3.162277639e-01f, 1.778279394e-01f, 1.000000015e-01f, 5.623413250e-02f, 3.162277490e-02f, 1.778279431e-02f,
                                9.999999776e-03f, 5.623413250e-03f, 3.162277630e-03f, 1.778279431e-03f, 1.000000047e-03f, 5.623413017e-04f, 3.162277571e-04f, 1.778279402e-04f};
__constant__ float INV8[8] = {1.000000000e+00f, 3.162277639e-01f, 1.000000015e-01f, 3.162277490e-02f, 9.999999776e-03f, 3.162277630e-03f, 1.000000047e-03f, 3.162277571e-04f};

constexpr size_t al256(size_t x) { return (x + 255) & ~(size_t)255; }
constexpr size_t OFF_bar = 0;
constexpr size_t OFF_mod = OFF_bar + al256(XCD_BAR_WORDS * 4);
constexpr size_t OFF_WinT = OFF_mod + al256((size_t)2 * 3 * 3072 * 4);
constexpr size_t OFF_WoutT = OFF_WinT + al256((size_t)2 * NP * 1024 * 2);
constexpr size_t OFF_WuqT = OFF_WoutT + al256((size_t)2 * 1024 * 1024 * 2);
constexpr size_t OFF_WukvTf = OFF_WuqT + al256((size_t)2 * 384 * 256 * 2);
constexpr size_t OFF_WukvT = OFF_WukvTf + al256((size_t)2 * 512 * 128 * 2);
constexpr size_t OFF_ssq_q = OFF_WukvT + al256((size_t)2 * 512 * 128 * 2);
constexpr size_t OFF_ssq_kv = OFF_ssq_q + al256((size_t)2 * NTOK * 4);
constexpr size_t OFF_ssq_x = OFF_ssq_kv + al256((size_t)2 * NTOK * 4);
constexpr size_t OFF_bw = OFF_ssq_x + al256((size_t)3 * NTOK * 4);
constexpr size_t OFF_ropeD = OFF_bw + al256((size_t)2 * 3 * NP * 4);
constexpr size_t OFF_ropeM = OFF_ropeD + al256(2048 * 4);
constexpr size_t OFF_wq = OFF_ropeM + al256(1024 * 4);
constexpr size_t OFF_hbuf = OFF_wq + al256(256);
constexpr size_t OFF_cq = OFF_hbuf + al256((size_t)NTOK * 1024 * 2);
constexpr size_t OFF_ckvraw = OFF_cq + al256((size_t)NTOK * 256 * 2);
constexpr size_t OFF_cckv = OFF_ckvraw + al256((size_t)NTOK * 128 * 2);
constexpr size_t OFF_convb = OFF_cckv + al256((size_t)2 * 512 * 128 * 2);
constexpr size_t OFF_dq = OFF_convb + al256((size_t)NTOK * 768 * 2);
constexpr size_t OFF_zs = OFF_dq + al256((size_t)NTOK * 512 * 2);
constexpr size_t OFF_qm = OFF_zs + al256((size_t)NTOK * 1024 * 2);
constexpr size_t OFF_KmC = OFF_qm + al256((size_t)NTOK * 384 * 2);
constexpr size_t OFF_KmL = OFF_KmC + al256((size_t)32 * 4 * 256 * 96 * 2);
constexpr size_t OFF_VmC = OFF_KmL + al256((size_t)2 * 983040 * 2);
constexpr size_t OFF_VmL = OFF_VmC + al256((size_t)32 * 4 * 64 * 256 * 2);
constexpr size_t OFF_KdC = OFF_VmL + al256((size_t)2 * 655360 * 2);
constexpr size_t OFF_KdL = OFF_KdC + al256((size_t)32 * 4 * 2 * 256 * 64 * 2);
constexpr size_t OFF_VdC = OFF_KdL + al256((size_t)2 * 1310720 * 2);
constexpr size_t OFF_VdL = OFF_VdC + al256((size_t)32 * 4 * 128 * 256 * 2);
constexpr size_t OFF_mix = OFF_VdL + al256((size_t)2 * 1310720 * 2);
constexpr size_t OFF_xbuf = OFF_mix + al256((size_t)NTOK * 1024 * 2);
constexpr size_t WS_TOTAL = OFF_xbuf + al256((size_t)NTOK * 1024 * 4);

struct Params {
  const float *x_prompt, *x_sample, *c, *cache_ckv, *cache_krope, *cache_dk, *cache_dv, *c_ctx;
  const float *norm_g, *ada_w, *ada_b, *w_in, *q_norm, *w_uq, *kv_norm, *w_ukv, *conv_w, *lam, *subln, *w_out, *final_norm;
  float* out;
  char* ws;
  DI unsigned* bar() const { return (unsigned*)(ws + OFF_bar); }
  DI bf16_t* WinT() const { return (bf16_t*)(ws + OFF_WinT); }
  DI bf16_t* WoutT() const { return (bf16_t*)(ws + OFF_WoutT); }
  DI bf16_t* WuqT() const { return (bf16_t*)(ws + OFF_WuqT); }
  DI bf16_t* WukvTf() const { return (bf16_t*)(ws + OFF_WukvTf); }
  DI bf16_t* WukvT() const { return (bf16_t*)(ws + OFF_WukvT); }
  DI float* mod() const { return (float*)(ws + OFF_mod); }
  DI float* ssq_q() const { return (float*)(ws + OFF_ssq_q); }
  DI float* ssq_kv() const { return (float*)(ws + OFF_ssq_kv); }
  DI float* ssq_x() const { return (float*)(ws + OFF_ssq_x); }
  DI float* bw() const { return (float*)(ws + OFF_bw); }
  DI float* ropeD() const { return (float*)(ws + OFF_ropeD); }
  DI float* ropeM() const { return (float*)(ws + OFF_ropeM); }
  DI int* wq() const { return (int*)(ws + OFF_wq); }
  DI bf16_t* hbuf() const { return (bf16_t*)(ws + OFF_hbuf); }
  DI bf16_t* cq() const { return (bf16_t*)(ws + OFF_cq); }
  DI bf16_t* ckvraw() const { return (bf16_t*)(ws + OFF_ckvraw); }
  DI bf16_t* cckv() const { return (bf16_t*)(ws + OFF_cckv); }
  DI bf16_t* convb() const { return (bf16_t*)(ws + OFF_convb); }
  DI bf16_t* dq() const { return (bf16_t*)(ws + OFF_dq); }
  DI bf16_t* zs() const { return (bf16_t*)(ws + OFF_zs); }
  DI bf16_t* qm() const { return (bf16_t*)(ws + OFF_qm); }
  DI bf16_t* KmC() const { return (bf16_t*)(ws + OFF_KmC); }
  DI bf16_t* KmL() const { return (bf16_t*)(ws + OFF_KmL); }
  DI bf16_t* VmC() const { return (bf16_t*)(ws + OFF_VmC); }
  DI bf16_t* VmL() const { return (bf16_t*)(ws + OFF_VmL); }
  DI bf16_t* KdC() const { return (bf16_t*)(ws + OFF_KdC); }
  DI bf16_t* KdL() const { return (bf16_t*)(ws + OFF_KdL); }
  DI bf16_t* VdC() const { return (bf16_t*)(ws + OFF_VdC); }
  DI bf16_t* VdL() const { return (bf16_t*)(ws + OFF_VdL); }
  DI bf16_t* mix() const { return (bf16_t*)(ws + OFF_mix); }
  DI float* xbuf() const { return (float*)(ws + OFF_xbuf); }
};

DI unsigned pk2(float a, float b) {
  f32x2 v = {a, b};
  bf16x2_t r = __builtin_convertvector(v, bf16x2_t);
  return __builtin_bit_cast(unsigned, r);
}
DI float bflo(unsigned u) { return __uint_as_float(u << 16); }
DI float bfhi(unsigned u) { return __uint_as_float(u & 0xffff0000u); }
DI bf16_t f2bf(float a) { return (bf16_t)(pk2(a, 0.f) & 0xffffu); }
DI float shx(float v, int o, int lane) { return __int_as_float(__builtin_amdgcn_ds_bpermute((lane ^ o) << 2, __float_as_int(v))); }
DI float wave_sum(float v, int lane) {
#pragma unroll
  for (int o = 32; o >= 1; o >>= 1) v += shx(v, o, lane);
  return v;
}
DI int opaque_tid() { int t = threadIdx.x; asm volatile("" : "+v"(t)); return t; }
DI int opaque_bid() { int b = blockIdx.x; asm volatile("" : "+s"(b)); return b; }
DI int rope_perm(int P) { return (P & 7) | ((P & 8) << 1) | ((P & 16) >> 1); }


#define XB_TMO      128
#define XB_XCNT(j)  (256  + 64 * (j))
#define XB_XSUB(j)  (1280 + 64 * (j))
#define XB_XGEN(j)  (2304 + 64 * (j))
#define XB_TOP      3328
#define XB_TOPGEN   3392
#define XB_SPIN_CAP (1u << 18)
DI unsigned xb_ld(unsigned* p)              { return __hip_atomic_load(p, __ATOMIC_RELAXED, __HIP_MEMORY_SCOPE_AGENT); }
DI unsigned xb_add(unsigned* p, unsigned v) { return __hip_atomic_fetch_add(p, v, __ATOMIC_RELAXED, __HIP_MEMORY_SCOPE_AGENT); }
DI unsigned xb_xcc_id() { return (unsigned)__builtin_amdgcn_s_getreg((3 << 11) | 20) & 0xFu; }
#define XB_SPIN(cond, bar) do { unsigned _sp = 0; while (cond) { __builtin_amdgcn_s_sleep(1); \
    if ((++_sp & 255u) == 0u) { if (xb_ld(&(bar)[XB_TMO])) break; if (_sp > XB_SPIN_CAP) { atomicAdd(&(bar)[XB_TMO], 1u); break; } } } } while (0)
#define LAS __attribute__((address_space(3)))
struct XcdBarrier { unsigned* bar; unsigned x; volatile LAS unsigned* st; };
DI XcdBarrier xcd_barrier_post(unsigned* bar, volatile LAS unsigned* st) {
  XcdBarrier b; b.bar = bar; b.x = xb_xcc_id(); b.st = st;
  if (threadIdx.x == 0) (void)xb_add(&bar[XB_XCNT(b.x)], 1u);
  return b;
}
DI void xcd_barrier_complete(unsigned* bar, unsigned x, unsigned& nloc, unsigned& nx) {
  const unsigned G = gridDim.x * gridDim.y * gridDim.z;
  unsigned sum, cnt, mine, sp = 0u;
  for (;;) {
    sum = 0u; cnt = 0u; mine = 0u;
#pragma unroll
    for (unsigned j = 0; j < 16; ++j) { const unsigned c = xb_ld(&bar[XB_XCNT(j)]); sum += c; cnt += (c > 0u) ? 1u : 0u; mine = (j == x) ? c : mine; }
    if (sum == G) break;
    __builtin_amdgcn_s_sleep(1);
    if ((++sp & 255u) == 0u) { if (xb_ld(&bar[XB_TMO])) break; if (sp > XB_SPIN_CAP) { atomicAdd(&bar[XB_TMO], 1u); break; } }
  }
  nloc = mine > 0u ? mine : 1u; nx = cnt > 0u ? cnt : 1u;
}
DI void xcd_barrier(const XcdBarrier& b) {
  asm volatile("s_waitcnt vmcnt(0)" ::: "memory");
  __syncthreads();
  if (threadIdx.x == 0) {
    unsigned* bar = b.bar;
    __builtin_amdgcn_s_waitcnt(0);
    unsigned nloc = b.st[0], nx = b.st[1];
    if (nloc == 0u) { xcd_barrier_complete(bar, b.x, nloc, nx); b.st[0] = nloc; b.st[1] = nx; }
    const unsigned old = xb_add(&bar[XB_XSUB(b.x)], 1u);
    const unsigned gen = old / nloc;
    if (old + 1u == (gen + 1u) * nloc) {
      __builtin_amdgcn_fence(__ATOMIC_RELEASE, "agent");
      asm volatile("s_waitcnt vmcnt(0)" ::: "memory");
      const unsigned og = xb_add(&bar[XB_TOP], 1u);
      const unsigned tg = og / nx;
      if (og + 1u == (tg + 1u) * nx) xb_add(&bar[XB_TOPGEN], 1u);
      else XB_SPIN(xb_ld(&bar[XB_TOPGEN]) == tg, bar);
      __builtin_amdgcn_fence(__ATOMIC_ACQUIRE, "agent");
      xb_add(&bar[XB_XGEN(b.x)], 1u);
      asm volatile("s_waitcnt vmcnt(0)" ::: "memory");
    } else {
      XB_SPIN(xb_ld(&bar[XB_XGEN(b.x)]) == gen, bar);
      __builtin_amdgcn_fence(__ATOMIC_ACQUIRE, "agent");
      asm volatile("s_waitcnt vmcnt(0)" ::: "memory");
    }
  }
  __syncthreads();
}

struct ColMapIn { DI int operator()(int n) const { if (n < 384) return n; if (n < 3712) return n + 32; if (n < 3744) return 384 + rope_perm(n - 3712); return -1; } };
struct ColMapId { DI int operator()(int n) const { return n; } };
struct ColMapUq { DI int operator()(int n) const { int h = n / 96, c = n - h * 96; if (c >= 64) c = 64 + rope_perm(c - 64); return h * 96 + c; } };

template <class CM>
DI void tconv_tile(const float* __restrict__ src, int ldsrc, bf16_t* __restrict__ dst, int K, int n0, int k0, const float* __restrict__ kscale, CM cm, float* sm, int tid) {
  const int tq = tid & 15, ty = tid >> 4;
  const int sc = cm(n0 + tq * 4);
  f32x4 v[4];
#pragma unroll
  for (int i = 0; i < 4; ++i) {
    const int kk = ty + i * 16;
    v[i] = (f32x4){0.f, 0.f, 0.f, 0.f};
    if (sc >= 0) v[i] = *(const f32x4*)(src + (size_t)(k0 + kk) * ldsrc + sc);
  }
#pragma unroll
  for (int i = 0; i < 4; ++i) {
    const int kk = ty + i * 16;
    const float s = kscale ? kscale[k0 + kk] : 1.f;
#pragma unroll
    for (int j = 0; j < 4; ++j) sm[kk * 65 + tq * 4 + j] = v[i][j] * s;
  }
  __syncthreads();
  const int kc = tid & 7, nn = tid >> 3;
#pragma unroll
  for (int ps = 0; ps < 2; ++ps) {
    const int n = nn + ps * 32;
    u32x4 o;
#pragma unroll
    for (int i = 0; i < 4; ++i) o[i] = pk2(sm[(kc * 8 + 2 * i) * 65 + n], sm[(kc * 8 + 2 * i + 1) * 65 + n]);
    *(u32x4*)(dst + (size_t)(n0 + n) * K + k0 + kc * 8) = o;
  }
  __syncthreads();
}

DI float silu_f(float x) { return x * __builtin_amdgcn_rcpf(1.f + __expf(-x)); }

DI void mod_item(const Params& p, int it, float* sm, int tid) {
  const int l = it / 192, r = it % 192, cg = r >> 4, kc = r & 15;
  const int c4 = tid & 63, rg = tid >> 6;
  const int k0 = kc * 64 + rg * 16;
  const float* W = p.ada_w + (size_t)l * 1024 * 3072 + (size_t)k0 * 3072 + cg * 256 + c4 * 4;
  f32x4 w[16];
#pragma unroll
  for (int i = 0; i < 16; ++i) w[i] = *(const f32x4*)(W + (size_t)i * 3072);
  float a0[4] = {0, 0, 0, 0}, a1[4] = {0, 0, 0, 0}, a2[4] = {0, 0, 0, 0};
#pragma unroll
  for (int i = 0; i < 16; ++i) {
    const int k = k0 + i;
    const float s0 = silu_f(p.c_ctx[k]), s1 = silu_f(p.c[k]), s2 = silu_f(p.c[1024 + k]);
#pragma unroll
    for (int j = 0; j < 4; ++j) { a0[j] += s0 * w[i][j]; a1[j] += s1 * w[i][j]; a2[j] += s2 * w[i][j]; }
  }
#pragma unroll
  for (int j = 0; j < 4; ++j) {
    sm[(rg * 3 + 0) * 256 + c4 * 4 + j] = a0[j];
    sm[(rg * 3 + 1) * 256 + c4 * 4 + j] = a1[j];
    sm[(rg * 3 + 2) * 256 + c4 * 4 + j] = a2[j];
  }
  __syncthreads();
#pragma unroll
  for (int ci = 0; ci < 3; ++ci) {
    float s = sm[(0 * 3 + ci) * 256 + tid] + sm[(1 * 3 + ci) * 256 + tid] + sm[(2 * 3 + ci) * 256 + tid] + sm[(3 * 3 + ci) * 256 + tid];
    const int col = cg * 256 + tid;
    if (kc == 0) s += p.ada_b[l * 3072 + col];
    atomicAdd(p.mod() + (l * 3 + ci) * 3072 + col, s);
  }
  __syncthreads();
}

DI void sincos_d(float ang, float& c, float& s) {
  const double TWO_PI = 6.283185307179586476925286766559;
  double x = (double)ang;
  x = x - TWO_PI * rint(x / TWO_PI);
  const double x2 = x * x;
  double ts = 1.0, tc = 1.0;
#pragma unroll
  for (int k = 12; k >= 1; --k) {
    ts = 1.0 - ts * x2 / (double)((2 * k) * (2 * k + 1));
    tc = 1.0 - tc * x2 / (double)((2 * k - 1) * (2 * k));
  }
  s = (float)(x * ts);
  c = (float)tc;
}

struct TcDesc { const float* src; bf16_t* dst; const float* kscale; int ld, K, n0, k0, sc; };
DI void tc_decode(const Params& p, int it, int tid, TcDesc& d) {
  const int tq = tid & 15;
  if (it < 1920) {
    const int l = it / 960, r = it % 960;
    d.src = p.w_in + (size_t)l * 1024 * 3744; d.ld = 3744; d.dst = p.WinT() + (size_t)l * NP * 1024; d.K = 1024; d.n0 = (r % 60) * 64; d.k0 = (r / 60) * 64; d.kscale = nullptr;
    d.sc = ColMapIn()(d.n0 + tq * 4);
  } else if (it < 2432) {
    const int j = it - 1920, l = j / 256, r = j % 256;
    d.src = p.w_out + (size_t)l * 1024 * 1024; d.ld = 1024; d.dst = p.WoutT() + (size_t)l * 1024 * 1024; d.K = 1024; d.n0 = (r % 16) * 64; d.k0 = (r / 16) * 64; d.kscale = nullptr;
    d.sc = d.n0 + tq * 4;
  } else if (it < 2480) {
    const int j = it - 2432, l = j / 24, r = j % 24;
    d.src = p.w_uq + (size_t)l * 256 * 384; d.ld = 384; d.dst = p.WuqT() + (size_t)l * 384 * 256; d.K = 256; d.n0 = (r % 6) * 64; d.k0 = (r / 6) * 64; d.kscale = p.q_norm + l * 256;
    d.sc = ColMapUq()(d.n0 + tq * 4);
  } else {
    const int j = (it - 2480) & 31, l = j / 16, r = j % 16;
    const bool folded = it < 2512;
    d.src = p.w_ukv + (size_t)l * 128 * 512; d.ld = 512; d.dst = (folded ? p.WukvTf() : p.WukvT()) + (size_t)l * 512 * 128; d.K = 128; d.n0 = (r % 8) * 64; d.k0 = (r / 8) * 64;
    d.kscale = folded ? p.kv_norm + l * 128 : nullptr;
    d.sc = d.n0 + tq * 4;
  }
}
DI void tc_load(const TcDesc& d, int tid, f32x4 (&v)[4]) {
  const int ty = tid >> 4;
#pragma unroll
  for (int i = 0; i < 4; ++i) {
    v[i] = (f32x4){0.f, 0.f, 0.f, 0.f};
    if (d.sc >= 0) v[i] = *(const f32x4*)(d.src + (size_t)(d.k0 + ty + i * 16) * d.ld + d.sc);
  }
  __builtin_amdgcn_sched_barrier(0);
}
DI void tc_finish(const TcDesc& d, int tid, f32x4 (&v)[4], float* sm) {
  const int tq = tid & 15, ty = tid >> 4;
#pragma unroll
  for (int i = 0; i < 4; ++i) {
    const int kk = ty + i * 16;
    const float s = d.kscale ? d.kscale[d.k0 + kk] : 1.f;
#pragma unroll
    for (int j = 0; j < 4; ++j) sm[kk * 65 + tq * 4 + j] = v[i][j] * s;
  }
  __syncthreads();
  const int kc = tid & 7, nn = tid >> 3;
#pragma unroll
  for (int ps = 0; ps < 2; ++ps) {
    const int n = nn + ps * 32;
    u32x4 o;
#pragma unroll
    for (int i = 0; i < 4; ++i) o[i] = pk2(sm[(kc * 8 + 2 * i) * 65 + n], sm[(kc * 8 + 2 * i + 1) * 65 + n]);
    *(u32x4*)(d.dst + (size_t)(d.n0 + n) * d.K + d.k0 + kc * 8) = o;
  }
  __syncthreads();
}

DI void phase0(const Params& p, char* smem) {
  float* sm = (float*)smem;
  const int tid = opaque_tid(), bid = opaque_bid();
  const int G = gridDim.x;
  for (int it = bid; it < 384; it += G) mod_item(p, it, sm, tid);
  {
    TcDesc da, db;
    f32x4 va[4], vb[4];
    int it = bid;
    bool ha = it < 2544;
    if (ha) { tc_decode(p, it, tid, da); tc_load(da, tid, va); }
    while (ha) {
      const int itb = it + G;
      const bool hb = itb < 2544;
      if (hb) { tc_decode(p, itb, tid, db); tc_load(db, tid, vb); }
      tc_finish(da, tid, va, sm);
      if (!hb) break;
      it = itb + G;
      ha = it < 2544;
      if (ha) { tc_decode(p, it, tid, da); tc_load(da, tid, va); }
      tc_finish(db, tid, vb, sm);
    }
  }
  const int gstride = gridDim.x * 256, g0 = bid * 256 + tid;
  for (int i0 = g0; i0 < 524288; i0 += 4 * gstride) {
    float v[4];
#pragma unroll
    for (int u = 0; u < 4; ++u) {
      const int i = i0 + u * gstride;
      if (i < 524288) { const int cc = i & 511, t = (i >> 9) & 255, b = (i >> 17) & 1, l = i >> 18; v[u] = p.cache_dk[(size_t)((b * 2 + l) * 256 + t) * 512 + cc]; }
    }
#pragma unroll
    for (int u = 0; u < 4; ++u) {
      const int i = i0 + u * gstride;
      if (i < 524288) {
        const int cc = i & 511, t = (i >> 9) & 255, b = (i >> 17) & 1, l = i >> 18, h = cc >> 7, a = (cc >> 6) & 1, d = cc & 63;
        p.KdL()[(size_t)l * 1310720 + (size_t)(((b * 4 + h) * 2 + a) * 1280 + t) * 64 + d] = f2bf(v[u]);
      }
    }
  }
  for (int i0 = g0; i0 < 524288; i0 += 4 * gstride) {
    float v[4];
#pragma unroll
    for (int u = 0; u < 4; ++u) {
      const int j = i0 + u * gstride;
      if (j < 524288) { const int t = j & 255, e = (j >> 8) & 127, h = (j >> 15) & 3, b = (j >> 17) & 1, l = j >> 18; v[u] = p.cache_dv[(size_t)((b * 2 + l) * 256 + t) * 512 + h * 128 + e]; }
    }
#pragma unroll
    for (int u = 0; u < 4; ++u) {
      const int j = i0 + u * gstride;
      if (j < 524288) { const int t = j & 255, e = (j >> 8) & 127, h = (j >> 15) & 3, b = (j >> 17) & 1, l = j >> 18; p.VdL()[(size_t)l * 1310720 + (size_t)((b * 4 + h) * 128 + e) * 1280 + t] = f2bf(v[u]); }
    }
  }
  const int E2 = 131072, E3 = E2 + 131072, E4 = E3 + 1536, E5 = E4 + 40960 + 30720;
  for (int i = g0; i < E5; i += gstride) {
    if (i < E2) {
      const int j = i;
      const int r = j & 31, h = (j >> 5) & 3, t = (j >> 7) & 255, b = (j >> 15) & 1, l = j >> 16;
      p.KmL()[(size_t)l * 983040 + (size_t)((b * 4 + h) * 1280 + t) * 96 + 64 + r] = f2bf(p.cache_krope[(size_t)((b * 2 + l) * 256 + t) * 32 + r]);
    } else if (i < E3) {
      const int j = i - E2;
      const int cc = j & 127, t = (j >> 7) & 255, b = (j >> 15) & 1, l = j >> 16;
      p.cckv()[(size_t)l * 65536 + (b * 256 + t) * 128 + cc] = f2bf(p.cache_ckv[(size_t)((b * 2 + l) * 256 + t) * 128 + cc]);
    } else if (i < E4) {
      const int j = i - E3;
      float cs, sn;
      if (j < 1024) {
        const int pos = j >> 4, f = j & 15;
        sincos_d((float)pos * INV16[f], cs, sn);
        p.ropeD()[j] = cs; p.ropeD()[1024 + j] = sn;
      } else {
        const int jj = j - 1024, pos = jj >> 3, f = jj & 7;
        sincos_d((float)pos * INV8[f], cs, sn);
        p.ropeM()[jj] = cs; p.ropeM()[512 + jj] = sn;
      }
    } else {
      const int j = i - E4;
      if (j < 20480) p.ssq_q()[j] = 0.f; else if (j < 40960) p.ssq_kv()[j - 20480] = 0.f; else p.ssq_x()[j - 40960] = 0.f;
      if (j < 64) p.wq()[j] = 0;
    }
  }
}

DI void phase_norm(const Params& p, int l) {
  const int tid = opaque_tid(), bid = opaque_bid();
  const int lane = tid & 63;
  const int gw = bid * 4 + (tid >> 6), nw = gridDim.x * 4;
  if (l == 0) {
    for (int it = gw; it < 2 * NP; it += nw) {
      const int ll = it / NP, n = it % NP;
      const bf16_t* wrow = p.WinT() + ((size_t)ll * NP + n) * 1024 + lane * 16;
      const u32x4 w0 = *(const u32x4*)wrow, w1 = *(const u32x4*)(wrow + 8);
      float wv[16];
#pragma unroll
      for (int q = 0; q < 4; ++q) { wv[2 * q] = bflo(w0[q]); wv[2 * q + 1] = bfhi(w0[q]); wv[8 + 2 * q] = bflo(w1[q]); wv[8 + 2 * q + 1] = bfhi(w1[q]); }
#pragma unroll
      for (int ci = 0; ci < 3; ++ci) {
        const float* sh = p.mod() + (ll * 3 + ci) * 3072 + lane * 16;
        float s = 0.f;
#pragma unroll
        for (int q = 0; q < 4; ++q) { const f32x4 sv = *(const f32x4*)(sh + q * 4); s += sv[0] * wv[q * 4] + sv[1] * wv[q * 4 + 1] + sv[2] * wv[q * 4 + 2] + sv[3] * wv[q * 4 + 3]; }
        s = wave_sum(s, lane);
        if (lane == 0) p.bw()[(ll * 3 + ci) * NP + n] = s;
      }
    }
  }
  for (int row = gw; row < NTOK; row += nw) {
    const float* x = (l == 0) ? (row < NCTX ? p.x_prompt + (size_t)row * 1024 : p.x_sample + (size_t)(row - NCTX) * 1024) : p.xbuf() + (size_t)row * 1024;
    f32x4 v[4];
#pragma unroll
    for (int i = 0; i < 4; ++i) v[i] = *(const f32x4*)(x + i * 256 + lane * 4);
    if (l == 0) {
      float ss = 0.f;
#pragma unroll
      for (int i = 0; i < 4; ++i) ss += v[i][0] * v[i][0] + v[i][1] * v[i][1] + v[i][2] * v[i][2] + v[i][3] * v[i][3];
      ss = wave_sum(ss, lane);
      if (lane == 0) p.ssq_x()[row] = ss;
      const int ci = row < NCTX ? 0 : 1 + ((row - NCTX) >> 10);
      const float* md = p.mod() + ci * 3072;
#pragma unroll
      for (int i = 0; i < 4; ++i) {
        const int k = i * 256 + lane * 4;
        const f32x4 gg = *(const f32x4*)(p.norm_g + k), sc = *(const f32x4*)(md + 1024 + k);
        float o[4];
#pragma unroll
        for (int j = 0; j < 4; ++j) o[j] = v[i][j] * gg[j] * (1.f + sc[j]);
        u32x2 pk = {pk2(o[0], o[1]), pk2(o[2], o[3])};
        *(u32x2*)(p.hbuf() + (size_t)row * 1024 + k) = pk;
      }
    } else {
      const float rstd = rsqrtf(p.ssq_x()[2 * NTOK + row] * (1.f / 1024.f) + EPS);
#pragma unroll
      for (int i = 0; i < 4; ++i) {
        const int k = i * 256 + lane * 4;
        const f32x4 gg = *(const f32x4*)(p.final_norm + k);
        f32x4 o;
#pragma unroll
        for (int j = 0; j < 4; ++j) o[j] = v[i][j] * rstd * gg[j];
        *(f32x4*)(p.out + (size_t)row * 1024 + k) = o;
      }
    }
  }
}

template <int MB, int DEPTH, class Epi>
DI void gemm_tile(const bf16_t* __restrict__ A, int lda, const bf16_t* __restrict__ Bt, int ldb, int K, int row0, int col0, const Epi& epi, char* smem, int tid) {
  constexpr int ABYTES = MB * 32 * 128, STAGE = ABYTES + 16384;
  const int lane = tid & 63, w = tid >> 6, wr = w >> 1, wc = w & 1, fr = lane & 15, fq = lane >> 4;
  const int lrow = tid >> 3, lc8 = tid & 7, lch = lc8 >> 2, lrr = lrow & 15;
  const char* Ab = (const char*)(A + (size_t)row0 * lda);
  const char* Bb = (const char*)(Bt + (size_t)col0 * ldb);
  const unsigned voa = (unsigned)(lrow * lda + lc8 * 8) * 2u, vob = (unsigned)(lrow * ldb + lc8 * 8) * 2u;
  const int wbase = ((lrow >> 4) * 2 + lch) * 1024 + ((((lrr ^ lch) * 64) + (lc8 & 3) * 16) ^ ((lrr >> 3) << 5));
  const int rlo = (fr * 64 + fq * 16) ^ ((fr >> 3) << 5);
  u32x4 ra[DEPTH][MB], rb[DEPTH][4];
  f32x4 acc[MB][4];
#pragma unroll
  for (int m = 0; m < MB; ++m)
#pragma unroll
    for (int n = 0; n < 4; ++n) acc[m][n] = (f32x4){0.f, 0.f, 0.f, 0.f};
  const int nk = K >> 6;
#define GLOAD(S, K0)                                                                               \
  {                                                                                                \
    _Pragma("unroll") for (int ps = 0; ps < MB; ++ps) ra[S][ps] = *(const u32x4*)(Ab + ((size_t)ps * 64 * lda + (K0) * 2) + voa); \
    _Pragma("unroll") for (int ps = 0; ps < 4; ++ps) rb[S][ps] = *(const u32x4*)(Bb + ((size_t)ps * 64 * ldb + (K0) * 2) + vob);  \
    __builtin_amdgcn_sched_barrier(0);                                                             \
  }
#define SSTORE(S, BUF)                                                                             \
  {                                                                                                \
    char* sw = smem + (BUF) * STAGE + wbase;                                                       \
    _Pragma("unroll") for (int ps = 0; ps < MB; ++ps) *(u32x4*)(sw + ps * 4096) = ra[S][ps];        \
    _Pragma("unroll") for (int ps = 0; ps < 4; ++ps) *(u32x4*)(sw + ABYTES + ps * 4096) = rb[S][ps]; \
  }
#define COMPUTE(BUF)                                                                               \
  {                                                                                                \
    const char* sa = smem + (BUF) * STAGE;                                                         \
    const char* sb = sa + ABYTES;                                                                  \
    _Pragma("unroll") for (int kk = 0; kk < 2; ++kk) {                                             \
      bf16x8 af[MB], bfr[4];                                                                       \
      const int ro = kk * 1024 + (rlo ^ (kk * 64));                                                \
      _Pragma("unroll") for (int m = 0; m < MB; ++m) af[m] = *(const bf16x8*)(sa + (wr * MB + m) * 2048 + ro); \
      _Pragma("unroll") for (int n = 0; n < 4; ++n) bfr[n] = *(const bf16x8*)(sb + (wc * 4 + n) * 2048 + ro);  \
      __builtin_amdgcn_s_setprio(1);                                                               \
      _Pragma("unroll") for (int m = 0; m < MB; ++m) _Pragma("unroll") for (int n = 0; n < 4; ++n) acc[m][n] = MFMA16(bfr[n], af[m], acc[m][n]); \
      __builtin_amdgcn_s_setprio(0);                                                               \
    }                                                                                              \
  }
  if constexpr (DEPTH == 2) {
    GLOAD(0, 0);
    GLOAD(1, 64);
    SSTORE(0, 0);
    __syncthreads();
    for (int kt = 0; kt < nk; kt += 2) {
      if (kt + 2 < nk) GLOAD(0, (kt + 2) * 64);
      COMPUTE(0);
      SSTORE(1, 1);
      __syncthreads();
      if (kt + 3 < nk) GLOAD(1, (kt + 3) * 64);
      COMPUTE(1);
      if (kt + 2 < nk) SSTORE(0, 0);
      __syncthreads();
    }
  } else {
    GLOAD(0, 0);
    SSTORE(0, 0);
    __syncthreads();
    for (int kt = 0; kt < nk; kt += 2) {
      GLOAD(0, (kt + 1) * 64);
      COMPUTE(0);
      SSTORE(0, 1);
      __syncthreads();
      if (kt + 2 < nk) GLOAD(0, (kt + 2) * 64);
      COMPUTE(1);
      if (kt + 2 < nk) SSTORE(0, 0);
      __syncthreads();
    }
  }
#undef GLOAD
#undef SSTORE
#undef COMPUTE
  epi.template tile<MB>(row0 + wr * MB * 16 + fr, col0 + wc * 64, fq, acc);
}

DI void st_bf4(bf16_t* dst, const f32x4& v) {
  u32x2 o = {pk2(v[0], v[1]), pk2(v[2], v[3])};
  *(u32x2*)dst = o;
}

DI void rot4(f32x4& x0, f32x4& x1, const float* tab, int toff, int idx) {
  const f32x4 cs = *(const f32x4*)(tab + idx), sn = *(const f32x4*)(tab + toff + idx);
#pragma unroll
  for (int j = 0; j < 4; ++j) {
    const float a = x0[j], b = x1[j];
    x0[j] = a * cs[j] - b * sn[j];
    x1[j] = b * cs[j] + a * sn[j];
  }
}

struct EpiIn {
  const Params& p; int l; bool atom; bool skip;
  template <int MB> DI void tile(int rbase, int cb, int fq, f32x4 (&acc)[MB][4]) const {
    const float* bwp = p.bw() + (l * 3 + (rbase < NCTX ? 0 : 1 + ((rbase - NCTX) >> 10))) * NP + cb + fq * 4;
    f32x4 bb[4];
    float rs[MB];
#pragma unroll
    for (int n = 0; n < 4; ++n) bb[n] = *(const f32x4*)(bwp + n * 16);
#pragma unroll
    for (int m = 0; m < MB; ++m) rs[m] = p.ssq_x()[l * NTOK + rbase + m * 16];
#pragma unroll
    for (int m = 0; m < MB; ++m) {
      const float r = rsqrtf(rs[m] * (1.f / 1024.f) + EPS);
#pragma unroll
      for (int n = 0; n < 4; ++n)
#pragma unroll
        for (int j = 0; j < 4; ++j) acc[m][n][j] = acc[m][n][j] * r + bb[n][j];
      (*this)(rbase + m * 16, cb, fq, acc[m]);
    }
  }
  DI void operator()(int row, int cb, int fq, f32x4 (&v)[4]) const {
    if (skip) return;
    const bool ctx = row < NCTX;
    int b, t;
    if (ctx) { b = row >> 8; t = row & 255; } else { b = (row - NCTX) >> 10; t = (row - NCTX) & 1023; }
    const int pr = t >> 6, pc = t & 63;
    const int c4 = fq * 4;
    if (cb < 384) {
      float ss = 0.f;
#pragma unroll
      for (int n = 0; n < 4; ++n) ss += v[n][0] * v[n][0] + v[n][1] * v[n][1] + v[n][2] * v[n][2] + v[n][3] * v[n][3];
      { const int ln = fq * 16 + (row & 15); ss += shx(ss, 16, ln); ss += shx(ss, 32, ln); }
      if (cb < 256) {
        if (fq == 0 && atom) atomicAdd(p.ssq_q() + l * NTOK + row, ss);
#pragma unroll
        for (int n = 0; n < 4; ++n) st_bf4(p.cq() + (size_t)row * 256 + cb + n * 16 + c4, v[n]);
      } else {
        if (fq == 0 && atom) atomicAdd(p.ssq_kv() + l * NTOK + row, ss);
        const int c = cb - 256;
#pragma unroll
        for (int n = 0; n < 4; ++n) {
          st_bf4(p.ckvraw() + (size_t)row * 128 + c + n * 16 + c4, v[n]);
          if (ctx) *(f32x4*)(p.out + OUT_CKV + (size_t)((b * 2 + l) * 256 + t) * 128 + c + n * 16 + c4) = v[n];
        }
      }
    } else if (cb < 1152) {
      const int c = cb - 384;
#pragma unroll
      for (int n = 0; n < 4; ++n) st_bf4(p.convb() + (size_t)row * 768 + c + n * 16 + c4, v[n]);
    } else if (cb < 1664) {
      const int c = cb - 1152;
      if (!ctx) { rot4(v[0], v[1], p.ropeD(), 1024, pr * 16 + c4); rot4(v[2], v[3], p.ropeD(), 1024, pc * 16 + c4); }
#pragma unroll
      for (int n = 0; n < 4; ++n) { v[n] *= QSCALE_D; st_bf4(p.dq() + (size_t)row * 512 + c + n * 16 + c4, v[n]); }
    } else if (cb < 2176) {
      const int c = cb - 1664, h = c >> 7, a = (c >> 6) & 1;
      if (ctx) {
#pragma unroll
        for (int n = 0; n < 4; ++n) {
          *(f32x4*)(p.out + OUT_DK + (size_t)((b * 2 + l) * 256 + t) * 512 + c + n * 16 + c4) = v[n];
          st_bf4(p.KdC() + (size_t)(((b * 4 + h) * 2 + a) * 256 + t) * 64 + n * 16 + c4, v[n]);
        }
      } else {
        rot4(v[0], v[1], p.ropeD(), 1024, pr * 16 + c4); rot4(v[2], v[3], p.ropeD(), 1024, pc * 16 + c4);
#pragma unroll
        for (int n = 0; n < 4; ++n) st_bf4(p.KdL() + (size_t)l * 1310720 + (size_t)(((b * 4 + h) * 2 + a) * 1280 + 256 + t) * 64 + n * 16 + c4, v[n]);
      }
    } else if (cb < 2688) {
      const int c = cb - 2176, h = c >> 7, e0 = (c & 127) + c4;
      if (ctx) {
#pragma unroll
        for (int n = 0; n < 4; ++n) {
          *(f32x4*)(p.out + OUT_DV + (size_t)((b * 2 + l) * 256 + t) * 512 + c + n * 16 + c4) = v[n];
#pragma unroll
          for (int j = 0; j < 4; ++j) p.VdC()[(size_t)((b * 4 + h) * 128 + e0 + n * 16 + j) * 256 + t] = f2bf(v[n][j]);
        }
      } else {
#pragma unroll
        for (int n = 0; n < 4; ++n)
#pragma unroll
          for (int j = 0; j < 4; ++j) p.VdL()[(size_t)l * 1310720 + (size_t)((b * 4 + h) * 128 + e0 + n * 16 + j) * 1280 + 256 + t] = f2bf(v[n][j]);
      }
    } else if (cb < 3712) {
      const int c = cb - 2688;
#pragma unroll
      for (int n = 0; n < 4; ++n) {
        f32x4 s;
#pragma unroll
        for (int j = 0; j < 4; ++j) s[j] = silu_f(v[n][j]);
        st_bf4(p.zs() + (size_t)row * 1024 + c + n * 16 + c4, s);
      }
    } else if (cb == 3712) {
      const int o0 = (fq < 2) ? c4 : c4 + 8;
      if (ctx) {
        float* so = p.out + OUT_KR + (size_t)((b * 2 + l) * 256 + t) * 32 + o0;
        *(f32x4*)so = v[0];
        *(f32x4*)(so + 8) = v[1];
#pragma unroll
        for (int h = 0; h < 4; ++h) {
          bf16_t* d = p.KmC() + (size_t)((b * 4 + h) * 256 + t) * 96 + 64 + o0;
          st_bf4(d, v[0]); st_bf4(d + 8, v[1]);
        }
      } else {
        if (fq < 2) rot4(v[0], v[1], p.ropeM(), 512, pr * 8 + c4); else rot4(v[0], v[1], p.ropeM(), 512, pc * 8 + c4 - 8);
#pragma unroll
        for (int h = 0; h < 4; ++h) {
          bf16_t* d = p.KmL() + (size_t)l * 983040 + (size_t)((b * 4 + h) * 1280 + 256 + t) * 96 + 64 + o0;
          st_bf4(d, v[0]); st_bf4(d + 8, v[1]);
        }
      }
    }
  }
};

struct EpiQ {
  const Params& p; int l;
  template <int MB> DI void tile(int rbase, int cb, int fq, f32x4 (&acc)[MB][4]) const {
#pragma unroll
    for (int m = 0; m < MB; ++m) (*this)(rbase + m * 16, cb, fq, acc[m]);
  }
  DI void operator()(int row, int cb, int fq, f32x4 (&v)[4]) const {
    const bool ctx = row < NCTX;
    const int t = (row - NCTX) & 1023, pr = t >> 6, pc = t & 63, c4 = fq * 4;
    const float f = rsqrtf(p.ssq_q()[l * NTOK + row] * (1.f / 256.f) + EPS) * QSCALE_M;
#pragma unroll
    for (int g = 0; g < 2; ++g) {
      const int cs = cb + 32 * g;
      v[2 * g] *= f; v[2 * g + 1] *= f;
      if (cs % 96 == 64) {
        const int o0 = (fq < 2) ? c4 : c4 + 8;
        if (!ctx) { if (fq < 2) rot4(v[2 * g], v[2 * g + 1], p.ropeM(), 512, pr * 8 + c4); else rot4(v[2 * g], v[2 * g + 1], p.ropeM(), 512, pc * 8 + c4 - 8); }
        bf16_t* d = p.qm() + (size_t)row * 384 + cs + o0;
        st_bf4(d, v[2 * g]); st_bf4(d + 8, v[2 * g + 1]);
      } else {
        bf16_t* d = p.qm() + (size_t)row * 384 + cs + c4;
        st_bf4(d, v[2 * g]); st_bf4(d + 16, v[2 * g + 1]);
      }
    }
  }
};

struct EpiKV {
  const Params& p; int l; int mode;
  template <int MB> DI void tile(int rbase, int cb, int fq, f32x4 (&acc)[MB][4]) const {
#pragma unroll
    for (int m = 0; m < MB; ++m) (*this)(rbase + m * 16, cb, fq, acc[m]);
  }
  DI void operator()(int row, int cb, int fq, f32x4 (&v)[4]) const {
    const int h = cb >> 7, c4 = fq * 4;
    const bool isV = (cb & 64) != 0;
    float f = 1.f;
    bf16_t *kd, *vd; int vstride;
    if (mode == 0) {
      f = rsqrtf(p.ssq_kv()[l * NTOK + row] * (1.f / 128.f) + EPS);
      if (row < NCTX) {
        const int b = row >> 8, t = row & 255;
        kd = p.KmC() + (size_t)((b * 4 + h) * 256 + t) * 96; vd = p.VmC() + (size_t)((b * 4 + h) * 64) * 256 + t; vstride = 256;
      } else {
        const int b = (row - NCTX) >> 10, t = (row - NCTX) & 1023;
        kd = p.KmL() + (size_t)l * 983040 + (size_t)((b * 4 + h) * 1280 + 256 + t) * 96; vd = p.VmL() + (size_t)l * 655360 + (size_t)((b * 4 + h) * 64) * 1280 + 256 + t; vstride = 1280;
      }
    } else {
      const int b = row >> 8, t = row & 255;
      kd = p.KmL() + (size_t)l * 983040 + (size_t)((b * 4 + h) * 1280 + t) * 96; vd = p.VmL() + (size_t)l * 655360 + (size_t)((b * 4 + h) * 64) * 1280 + t; vstride = 1280;
    }
#pragma unroll
    for (int n = 0; n < 4; ++n) {
      v[n] *= f;
      if (!isV) st_bf4(kd + n * 16 + c4, v[n]);
      else {
#pragma unroll
        for (int j = 0; j < 4; ++j) vd[(size_t)(n * 16 + c4 + j) * vstride] = f2bf(v[n][j]);
      }
    }
  }
};

struct EpiOut {
  const Params& p; int l;
  template <int MB> DI void tile(int rbase, int cb, int fq, f32x4 (&acc)[MB][4]) const {
    const float* gate0 = p.mod() + (l * 3) * 3072 + 2048 + cb + fq * 4;
    f32x4 xv[MB][4];
#pragma unroll
    for (int m = 0; m < MB; ++m) {
      const int row = rbase + m * 16;
      const float* xo = (l == 0) ? (row < NCTX ? p.x_prompt + (size_t)row * 1024 : p.x_sample + (size_t)(row - NCTX) * 1024) : p.xbuf() + (size_t)row * 1024;
#pragma unroll
      for (int n = 0; n < 4; ++n) xv[m][n] = *(const f32x4*)(xo + cb + n * 16 + fq * 4);
    }
    __builtin_amdgcn_sched_barrier(0);
    const int ln = fq * 16 + (rbase & 15);
#pragma unroll
    for (int m = 0; m < MB; ++m) {
      const int row = rbase + m * 16;
      const int ci = row < NCTX ? 0 : 1 + ((row - NCTX) >> 10);
      float ss = 0.f;
#pragma unroll
      for (int n = 0; n < 4; ++n) {
        const int col = cb + n * 16 + fq * 4;
        const f32x4 g = *(const f32x4*)(gate0 + ci * 3072 + n * 16);
        f32x4 o;
#pragma unroll
        for (int j = 0; j < 4; ++j) { o[j] = xv[m][n][j] + g[j] * acc[m][n][j]; ss += o[j] * o[j]; }
        *(f32x4*)(p.xbuf() + (size_t)row * 1024 + col) = o;
        if (l == 0) {
          const f32x4 gg = *(const f32x4*)(p.norm_g + 1024 + col), sc = *(const f32x4*)(p.mod() + (3 + ci) * 3072 + 1024 + col);
          u32x2 pk = {pk2(o[0] * gg[0] * (1.f + sc[0]), o[1] * gg[1] * (1.f + sc[1])), pk2(o[2] * gg[2] * (1.f + sc[2]), o[3] * gg[3] * (1.f + sc[3]))};
          *(u32x2*)(p.hbuf() + (size_t)row * 1024 + col) = pk;
        }
      }
      ss += shx(ss, 16, ln); ss += shx(ss, 32, ln);
      if (fq == 0) atomicAdd(p.ssq_x() + (l + 1) * NTOK + row, ss);
    }
  }
};

template <int MINE, int THEIRS>
DI void diff_finalize(f32x16 (&O)[4], float f, float sgn, const float* __restrict__ subln, float osc, char* smem, int w, int lane, int hh,
                      bf16_t* __restrict__ orow, const bf16_t* __restrict__ zrow, bool active) {
  float* ex = (float*)smem;
  float* sx = ex + 4 * 32 * 64;
  if (active) {
#pragma unroll
    for (int d = 0; d < 2; ++d)
#pragma unroll
      for (int i = 0; i < 16; ++i) ex[(w * 32 + d * 16 + i) * 64 + lane] = O[THEIRS + d][i] * f;
  }
  __syncthreads();
  if (!active) { __syncthreads(); return; }
  const float* pe = ex + (w ^ 1) * 32 * 64;
  float ss = 0.f;
#pragma unroll
  for (int d = 0; d < 2; ++d)
#pragma unroll
    for (int i = 0; i < 16; ++i) {
      const float mine = O[MINE + d][i] * f, theirs = pe[(d * 16 + i) * 64 + lane];
      const float o = (sgn == 0.f) ? (mine - theirs) : (theirs - mine);
      O[MINE + d][i] = o; ss += o * o;
    }
  ss += shx(ss, 32, lane);
  sx[w * 64 + lane] = ss;
  __syncthreads();
  ss += sx[(w ^ 1) * 64 + lane];
  const float rs = rsqrtf(ss * (1.f / 128.f) + EPS) * osc;
#pragma unroll
  for (int d = 0; d < 2; ++d) {
#pragma unroll
    for (int g = 0; g < 4; ++g) {
      const int d0 = (MINE + d) * 32 + g * 8 + hh * 4;
      const f32x4 sg = *(const f32x4*)(subln + d0);
      const u32x2 z = *(const u32x2*)(zrow + d0);
      u32x2 o = {pk2(O[MINE + d][4 * g] * rs * sg[0] * bflo(z[0]), O[MINE + d][4 * g + 1] * rs * sg[1] * bfhi(z[0])),
                 pk2(O[MINE + d][4 * g + 2] * rs * sg[2] * bflo(z[1]), O[MINE + d][4 * g + 3] * rs * sg[3] * bfhi(z[1]))};
      *(u32x2*)(orow + d0) = o;
    }
    __builtin_amdgcn_sched_barrier(0);
  }
}

template <int DQK, int DV, bool DIFF, bool SPLIT>
DI void attn_item(const bf16_t* __restrict__ Qp, int ldq, const bf16_t* __restrict__ Kp, const bf16_t* __restrict__ Vtp, int nkeys,
                  bf16_t* __restrict__ outp, const bf16_t* __restrict__ zsp, float lamf, const float* __restrict__ subln, float osc, char* smem, int tid,
                  int warm_n = 0, int warm_share = 0) {
  constexpr int NMAPK = DIFF ? 2 : 1;
  constexpr int KROW = (DQK + 8) * 2;
  constexpr int KMAPB = 64 * KROW;
  constexpr int VROW = 136;
  constexpr int NS = DQK / 16, NDB = DV / 32;
  constexpr int BUFB = NMAPK * KMAPB + DV * VROW;
  constexpr int NT = SPLIT ? 2 : 1;
  char* sK = smem;
  char* sV = smem + NMAPK * KMAPB;
  const int lane = tid & 63, w = tid >> 6, r = lane & 31, hh = lane >> 5;
  const int kh = SPLIT ? (w >> 1) : 0;
  const int qb = SPLIT ? (DIFF ? 0 : (w & 1)) : (DIFF ? (w >> 1) : w);
  const int am = DIFF ? (w & 1) : 0;
  bf16x8 qf[NS];
#pragma unroll
  for (int s = 0; s < NS; ++s) qf[s] = *(const bf16x8*)(Qp + (size_t)(qb * 32 + r) * ldq + am * 64 + s * 16 + hh * 8);
  f32x16 O[NDB];
  float mrun = -1e30f, lrun = 0.f;
#pragma unroll
  for (int db = 0; db < NDB; ++db)
#pragma unroll
    for (int i = 0; i < 16; ++i) O[db][i] = 0.f;
  const char* sKa = sK + am * KMAPB + r * KROW + hh * 16;
  const char* sVa = sV + r * VROW + hh * 8;
  const int nkt = nkeys >> 6, nit = SPLIT ? (nkt >> 1) : nkt;
  constexpr int KCH = 64 * DQK / 8;
  constexpr int NKC = (KCH + 255) / 256, NVC = DV * 8 / 256;
  u32x4 kreg[NT][NMAPK][NKC], vreg[NT][NVC];
#define ATT_GLOAD(J)                                                                               \
  {                                                                                                \
    _Pragma("unroll") for (int t = 0; t < NT; ++t) {                                               \
      const int tile = t * nit + (J);                                                              \
      _Pragma("unroll") for (int a = 0; a < NMAPK; ++a) {                                          \
        const bf16_t* kg = Kp + (size_t)a * nkeys * DQK + (size_t)tile * 64 * DQK;                  \
        _Pragma("unroll") for (int c = 0; c < NKC; ++c) {                                          \
          const int ch = c * 256 + tid;                                                            \
          if (KCH % 256 == 0 || ch < KCH) kreg[t][a][c] = *(const u32x4*)(kg + (size_t)ch * 8);     \
        }                                                                                          \
      }                                                                                            \
      const bf16_t* vg = Vtp + (size_t)tile * 64;                                                   \
      _Pragma("unroll") for (int c = 0; c < NVC; ++c) {                                            \
        const int ch = c * 256 + tid, d = ch >> 3, part = ch & 7;                                  \
        vreg[t][c] = *(const u32x4*)(vg + (size_t)d * nkeys + part * 8);                            \
      }                                                                                            \
    }                                                                                              \
    __builtin_amdgcn_sched_barrier(0);                                                             \
  }
#define ATT_SWRITE(BUF)                                                                            \
  {                                                                                                \
    _Pragma("unroll") for (int t = 0; t < NT; ++t) {                                               \
      char* bK = sK + (SPLIT ? t : (BUF)) * BUFB;                                                  \
      char* bV = sV + (SPLIT ? t : (BUF)) * BUFB;                                                  \
      _Pragma("unroll") for (int a = 0; a < NMAPK; ++a) _Pragma("unroll") for (int c = 0; c < NKC; ++c) { \
        const int ch = c * 256 + tid;                                                              \
        if (KCH % 256 == 0 || ch < KCH) {                                                          \
          const int key = ch / (DQK / 8), part = ch % (DQK / 8);                                   \
          *(u32x4*)(bK + a * KMAPB + key * KROW + part * 16) = kreg[t][a][c];                       \
        }                                                                                          \
      }                                                                                            \
      _Pragma("unroll") for (int c = 0; c < NVC; ++c) {                                            \
        const int ch = c * 256 + tid, d = ch >> 3, part = ch & 7;                                  \
        u32x2 lo = {vreg[t][c][0], vreg[t][c][1]}, hi = {vreg[t][c][2], vreg[t][c][3]};            \
        *(u32x2*)(bV + d * VROW + part * 16) = lo;                                                 \
        *(u32x2*)(bV + d * VROW + part * 16 + 8) = hi;                                             \
      }                                                                                            \
    }                                                                                              \
  }
  auto compute = [&](const char* sKb, const char* sVb) {
    f32x16 st[2];
#pragma unroll
    for (int kb = 0; kb < 2; ++kb) {
#pragma unroll
      for (int i = 0; i < 16; ++i) st[kb][i] = 0.f;
#pragma unroll
      for (int s = 0; s < NS; ++s) {
        const bf16x8 kf = *(const bf16x8*)(sKb + kb * 32 * KROW + s * 32);
        st[kb] = MFMA32(kf, qf[s], st[kb]);
      }
    }
    float mx = st[0][0];
#pragma unroll
    for (int i = 1; i < 16; ++i) mx = fmaxf(mx, st[0][i]);
#pragma unroll
    for (int i = 0; i < 16; ++i) mx = fmaxf(mx, st[1][i]);
    mx = fmaxf(mx, shx(mx, 32, lane));
    const float mnew = fmaxf(mrun, mx);
    const float alpha = __builtin_amdgcn_exp2f(mrun - mnew);
    mrun = mnew;
    float ls = 0.f;
#pragma unroll
    for (int kb = 0; kb < 2; ++kb)
#pragma unroll
      for (int i = 0; i < 16; ++i) { const float e = __builtin_amdgcn_exp2f(st[kb][i] - mnew); st[kb][i] = e; ls += e; }
    lrun = lrun * alpha + ls;
    if (__builtin_amdgcn_ballot_w64(alpha != 1.f) != 0) {
#pragma unroll
      for (int db = 0; db < NDB; ++db)
#pragma unroll
        for (int i = 0; i < 16; ++i) O[db][i] *= alpha;
    }
#pragma unroll
    for (int kb = 0; kb < 2; ++kb)
#pragma unroll
      for (int t2 = 0; t2 < 2; ++t2) {
        u32x4 pp;
#pragma unroll
        for (int j = 0; j < 4; ++j) pp[j] = pk2(st[kb][8 * t2 + 2 * j], st[kb][8 * t2 + 2 * j + 1]);
        const bf16x8 pf = __builtin_bit_cast(bf16x8, pp);
#pragma unroll
        for (int db = 0; db < NDB; ++db) {
          const char* vb = sVb + db * 32 * VROW + (kb * 32 + 16 * t2) * 2;
          const u32x2 lo = *(const u32x2*)vb, hi = *(const u32x2*)(vb + 16);
          const u32x4 vv = {lo[0], lo[1], hi[0], hi[1]};
          O[db] = MFMA32(__builtin_bit_cast(bf16x8, vv), pf, O[db]);
        }
        if constexpr (DIFF && SPLIT) __builtin_amdgcn_sched_barrier(0);
      }
  };
  ATT_GLOAD(0);
  unsigned w0 = 0u, w1 = 0u;
  if (warm_n > 0) {
    const int lk = (NMAPK * nkeys * DQK * 2 / 128) / warm_n, lv = (DV * nkeys * 2 / 128) / warm_n;
    if (tid < lk) w0 = *(const volatile unsigned*)((const char*)Kp + (size_t)(warm_share * lk + tid) * 128);
    if (tid < lv) w1 = *(const volatile unsigned*)((const char*)Vtp + (size_t)(warm_share * lv + tid) * 128);
  }
  if constexpr (!SPLIT) {
    __syncthreads();
    ATT_SWRITE(0);
    if (nit > 1) ATT_GLOAD(1);
    __syncthreads();
    for (int kt = 0; kt < nit; ++kt) {
      if (kt + 1 < nit) {
        ATT_SWRITE((kt + 1) & 1);
        if (kt + 2 < nit) ATT_GLOAD(kt + 2);
      }
      compute(sKa + (kt & 1) * BUFB, sVa + (kt & 1) * BUFB);
      __syncthreads();
    }
  } else {
    for (int j = 0; j < nit; ++j) {
      __syncthreads();
      ATT_SWRITE(0);
      __syncthreads();
      if (j + 1 < nit) ATT_GLOAD(j + 1);
      compute(sKa + kh * BUFB, sVa + kh * BUFB);
    }
    __syncthreads();
    float* mg = (float*)(smem + 36864);
    float* mlb = mg + 2 * NDB * 16 * 64;
    const int wl = w & 1;
    if (kh == 1) {
#pragma unroll
      for (int db = 0; db < NDB; ++db)
#pragma unroll
        for (int i = 0; i < 16; ++i) mg[((wl * NDB + db) * 16 + i) * 64 + lane] = O[db][i];
      mlb[(wl * 2 + 0) * 64 + lane] = mrun;
      mlb[(wl * 2 + 1) * 64 + lane] = lrun;
    }
    __syncthreads();
    if (kh == 0) {
      const float m1 = mlb[(wl * 2 + 0) * 64 + lane], l1 = mlb[(wl * 2 + 1) * 64 + lane];
      const float mn = fmaxf(mrun, m1);
      const float s0 = __builtin_amdgcn_exp2f(mrun - mn), s1 = __builtin_amdgcn_exp2f(m1 - mn);
      lrun = lrun * s0 + l1 * s1;
      mrun = mn;
#pragma unroll
      for (int db = 0; db < NDB; ++db)
#pragma unroll
        for (int i = 0; i < 16; ++i) O[db][i] = O[db][i] * s0 + mg[((wl * NDB + db) * 16 + i) * 64 + lane] * s1;
    }
  }
#undef ATT_GLOAD
#undef ATT_SWRITE
  const float inv = 1.f / (lrun + shx(lrun, 32, lane));
  const size_t ro = (size_t)(qb * 32 + r) * 1024;
  const bool active = (kh == 0);
  if constexpr (DIFF) {
    __syncthreads();
    if (am == 0) diff_finalize<0, 2>(O, inv, 0.f, subln, osc, smem, w, lane, hh, outp + ro, zsp + ro, active);
    else diff_finalize<2, 0>(O, inv * lamf, 1.f, subln, osc, smem, w, lane, hh, outp + ro, zsp + ro, active);
  } else {
    if (active) {
#pragma unroll
      for (int db = 0; db < NDB; ++db) {
#pragma unroll
        for (int g = 0; g < 4; ++g) {
          const int d0 = db * 32 + g * 8 + hh * 4;
          const u32x2 z = *(const u32x2*)(zsp + ro + d0);
          u32x2 o = {pk2(O[db][4 * g] * inv * bflo(z[0]), O[db][4 * g + 1] * inv * bfhi(z[0])), pk2(O[db][4 * g + 2] * inv * bflo(z[1]), O[db][4 * g + 3] * inv * bfhi(z[1]))};
          *(u32x2*)(outp + ro + d0) = o;
        }
        __builtin_amdgcn_sched_barrier(0);
      }
    }
  }
  if ((w0 ^ w1) == 0x7fc54321u && warm_n < 0) ((volatile unsigned*)smem)[0] = w0;
}

DI void conv_item(const Params& p, int l, int it, int tid) {
  const int ch = (tid & 31) * 8, rr = tid >> 5;
  float w0[8], w1[8], w2[8];
#pragma unroll
  for (int j = 0; j < 8; ++j) { w0[j] = p.conv_w[l * 768 + ch + j]; w1[j] = p.conv_w[l * 768 + 256 + ch + j]; w2[j] = p.conv_w[l * 768 + 512 + ch + j]; }
  for (int i = 0; i < 16; ++i) {
    const int row = it * 128 + i * 8 + rr;
    int t, len;
    if (row < NCTX) { t = row & 255; len = 256; } else { t = (row - NCTX) & 1023; len = 1024; }
    const bf16_t* base = p.convb() + (size_t)row * 768;
    const u32x4 zero = {0u, 0u, 0u, 0u};
    const u32x4 cbv = *(const u32x4*)(base + ch);
    const u32x4 c1 = *(const u32x4*)(base + 256 + ch), x1 = *(const u32x4*)(base + 512 + ch);
    const u32x4 c0 = t > 0 ? *(const u32x4*)(base - 768 + 256 + ch) : zero, x0 = t > 0 ? *(const u32x4*)(base - 768 + 512 + ch) : zero;
    const u32x4 c2 = t < len - 1 ? *(const u32x4*)(base + 768 + 256 + ch) : zero, x2 = t < len - 1 ? *(const u32x4*)(base + 768 + 512 + ch) : zero;
    const u32x4 zv = *(const u32x4*)(p.zs() + (size_t)row * 1024 + 256 + ch);
    u32x4 o;
#pragma unroll
    for (int q = 0; q < 4; ++q) {
      const float ylo = bflo(c0[q]) * bflo(x0[q]) * w0[2 * q] + bflo(c1[q]) * bflo(x1[q]) * w1[2 * q] + bflo(c2[q]) * bflo(x2[q]) * w2[2 * q];
      const float yhi = bfhi(c0[q]) * bfhi(x0[q]) * w0[2 * q + 1] + bfhi(c1[q]) * bfhi(x1[q]) * w1[2 * q + 1] + bfhi(c2[q]) * bfhi(x2[q]) * w2[2 * q + 1];
      o[q] = pk2(bflo(cbv[q]) * ylo * bflo(zv[q]), bfhi(cbv[q]) * yhi * bfhi(zv[q]));
    }
    *(u32x4*)(p.mix() + (size_t)row * 1024 + 256 + ch) = o;
  }
}

DI void phase_mix(const Params& p, int l, char* smem, int mask = 7) {
  const int lane = opaque_tid() & 63;
  const float* lm = p.lam + l * 256;
  const float s01 = wave_sum(lm[lane] * lm[64 + lane], lane), s23 = wave_sum(lm[128 + lane] * lm[192 + lane], lane);
  const float lam_init = (l == 0) ? 0.2f : 0.35550906759096934f;
  const float lamf = __int_as_float(__builtin_amdgcn_readfirstlane(__float_as_int(__expf(s01) - __expf(s23) + lam_init)));
  const float osc = 1.f - lam_init;
  const int bid = opaque_bid(), G = gridDim.x;
  for (int slot = 0;; ++slot) {
    int it;
    if (G == 512) {
      if (slot == 0) it = bid;
      else if (slot == 1) it = bid < 128 ? -1 : bid < 192 ? 704 + (bid - 128) : bid < 384 ? 512 + (bid - 192) : 768 + (bid - 384);
      else if (slot == 2) it = bid < 384 ? -1 : bid < 448 ? 896 + (bid - 384) : 960 + (bid - 448);
      else if (slot == 3) it = (bid >= 192 && bid < 208) ? 1024 + (bid - 192) : -1;
      else break;
      if (it < 0) continue;
    } else {
      it = slot * G + bid;
      if (it >= 1040) break;
    }
    int tid = threadIdx.x;
    asm volatile("" : "+v"(tid));
#if REP >= 40
    { const bool isdiff = it < 128 || (it >= 192 && it < 704), ismla = (it >= 128 && it < 192) || (it >= 704 && it < 960), islat = it < 192;
      if (mask == 1 && !isdiff) continue; if (mask == 2 && !ismla) continue; if (mask == 3 && !islat) continue; if (mask == 4 && !(isdiff && islat)) continue; }
#endif
    if (it < 128 || (it >= 192 && it < 704)) {
      int b, h, qt; size_t row0; const bf16_t *kp, *vp; int nk;
      if (it < 128) {
        const int x = it & 7; b = x >> 2; h = x & 3; qt = it >> 3; row0 = NCTX + b * 1024 + qt * 64; nk = 1280;
        kp = p.KdL() + (size_t)l * 1310720 + (size_t)((b * 4 + h) * 2) * 1280 * 64; vp = p.VdL() + (size_t)l * 1310720 + (size_t)((b * 4 + h) * 128) * 1280;
      } else {
        const int j = it - 192, combo = (j & 7) | ((j >> 5) << 3); b = combo >> 2; h = combo & 3; qt = (j >> 3) & 3; row0 = b * 256 + qt * 64; nk = 256;
        kp = p.KdC() + (size_t)((b * 4 + h) * 2) * 256 * 64; vp = p.VdC() + (size_t)((b * 4 + h) * 128) * 256;
      }
      attn_item<64, 128, true, false>(p.dq() + row0 * 512 + h * 128, 512, kp, vp, nk, p.mix() + row0 * 1024 + 512 + h * 128, p.zs() + row0 * 1024 + 512 + h * 128,
                                      lamf, p.subln + l * 128, osc, smem, tid, it < 128 ? 16 : 0, qt);
    } else if (it < 960) {
      int b, h, qt; size_t row0; const bf16_t *kp, *vp; int nk;
      if (it < 192) {
        const int j = it - 128, x = j & 7; b = x >> 2; h = x & 3; qt = j >> 3; row0 = NCTX + b * 1024 + qt * 128; nk = 1280;
        kp = p.KmL() + (size_t)l * 983040 + (size_t)(b * 4 + h) * 1280 * 96; vp = p.VmL() + (size_t)l * 655360 + (size_t)((b * 4 + h) * 64) * 1280;
      } else {
        const int j = it - 704, combo = (j & 7) | ((j >> 4) << 3); b = combo >> 2; h = combo & 3; qt = (j >> 3) & 1; row0 = b * 256 + qt * 128; nk = 256;
        kp = p.KmC() + (size_t)(b * 4 + h) * 256 * 96; vp = p.VmC() + (size_t)((b * 4 + h) * 64) * 256;
      }
      attn_item<96, 64, false, false>(p.qm() + row0 * 384 + h * 96, 384, kp, vp, nk, p.mix() + row0 * 1024 + h * 64, p.zs() + row0 * 1024 + h * 64, 0.f, nullptr, 1.f, smem, tid, it < 192 ? 8 : 0, qt);
    } else {
      conv_item(p, l, it - 960, tid);
    }
  }
}

DI void phase_inproj(const Params& p, int l, char* smem, bool atom = true, bool skip = false) {
  EpiIn epi{p, l, atom, skip};
  const int tid = opaque_tid(), bid = opaque_bid();
  const int xcd = bid & 7, nloc = (gridDim.x + 7 - xcd) >> 3;
  for (int j = bid >> 3; j < 300; j += nloc) {
    const int mt = xcd * 10 + j % 10, nt = j / 10;
    gemm_tile<4, 2>(p.hbuf(), 1024, p.WinT() + (size_t)l * NP * 1024, 1024, 1024, mt * 128, nt * 128, epi, smem, tid);
  }
}

DI void phase_upproj(const Params& p, int l, char* smem, bool fix = true) {
  const int tid = opaque_tid(), bid = opaque_bid();
  if (fix) {
    const float* g = p.kv_norm + l * 128;
    for (int i = bid * 256 + tid; i < NCTX * 32; i += gridDim.x * 256) {
      const int row = i >> 5, c = (i & 31) * 4, b = row >> 8, t = row & 255;
      const float f = rsqrtf(p.ssq_kv()[l * NTOK + row] * (1.f / 128.f) + EPS);
      float* d = p.out + OUT_CKV + (size_t)((b * 2 + l) * 256 + t) * 128 + c;
      f32x4 v = *(f32x4*)d;
      const f32x4 gg = *(const f32x4*)(g + c);
#pragma unroll
      for (int j = 0; j < 4; ++j) v[j] *= f * gg[j];
      *(f32x4*)d = v;
    }
  }
  EpiQ eq{p, l};
  EpiKV ek0{p, l, 0}, ek1{p, l, 1};
  for (int it = bid; it < 464; it += gridDim.x) {
    if (it < 192) {
      const int mt = it / 3, nt = it % 3;
      gemm_tile<5, 1>(p.cq(), 256, p.WuqT() + (size_t)l * 384 * 256, 256, 256, mt * 160, nt * 128, eq, smem, tid);
    } else if (it < 448) {
      const int j = it - 192, mt = j >> 2, nt = j & 3;
      gemm_tile<5, 1>(p.ckvraw(), 128, p.WukvTf() + (size_t)l * 512 * 128, 128, 128, mt * 160, nt * 128, ek0, smem, tid);
    } else {
      const int j = it - 448, mt = j >> 2, nt = j & 3;
      gemm_tile<4, 1>(p.cckv() + (size_t)l * 65536, 128, p.WukvT() + (size_t)l * 512 * 128, 128, 128, mt * 128, nt * 128, ek1, smem, tid);
    }
  }
}

DI void phase_outproj(const Params& p, int l, char* smem) {
  EpiOut epi{p, l};
  const int tid = opaque_tid(), bid = opaque_bid();
  const int xcd = bid & 7, nloc = (gridDim.x + 7 - xcd) >> 3;
  for (int j = bid >> 3; j < 64; j += nloc) {
    const int mt = xcd * 8 + (j & 7), nt = j >> 3;
    gemm_tile<5, 1>(p.mix(), 1024, p.WoutT() + (size_t)l * 1024 * 1024, 1024, 1024, mt * 160, nt * 128, epi, smem, tid);
  }
}

__global__ void __launch_bounds__(256, 2) fwd_megakernel(Params p) {
  __shared__ __attribute__((aligned(16))) char smem[73728];
  __shared__ __attribute__((aligned(16))) unsigned xb_words[4];
  cg::grid_group grid = cg::this_grid();
  if (p.ws == nullptr) grid.sync();
  if (threadIdx.x == 0) { xb_words[0] = 0u; xb_words[1] = 0u; xb_words[2] = 0u; xb_words[3] = 0u; }
  __syncthreads();
  const XcdBarrier xb = xcd_barrier_post(p.bar(), (volatile LAS unsigned*)xb_words);
#define GSYNC() xcd_barrier(xb)
  phase0(p, smem);
#if REP == 0
  GSYNC(); phase0(p, smem);
#endif
#pragma unroll
  for (int l = 0; l < 2; ++l) {
    GSYNC();
    if (l == 0) { phase_norm(p, 0); GSYNC(); }
#if REP == 2
    phase_inproj(p, l, smem, false); GSYNC();
#endif
#if REP == 7
    phase_inproj(p, l, smem, false, p.ws != nullptr); GSYNC();
#endif
    phase_inproj(p, l, smem);
    GSYNC();
#if REP == 3
    phase_upproj(p, l, smem, false); GSYNC();
#endif
    phase_upproj(p, l, smem);
    GSYNC();
#if REP == 4
    phase_mix(p, l, smem); GSYNC();
#endif
#if REP >= 40
    phase_mix(p, l, smem, REP - 40); GSYNC();
#endif
    phase_mix(p, l, smem);
    GSYNC();
#if REP == 5
    if (l == 0) { phase_outproj(p, l, smem); GSYNC(); }
#endif
    phase_outproj(p, l, smem);
  }
  GSYNC();
  phase_norm(p, 2);
#if REP == 6
  for (int i = 0; i < 10; ++i) GSYNC();
#endif
}

extern "C" void kernel_launch(void* const* d_in, const int* in_sizes, int n_in, void* d_out, int out_size, void* d_ws, size_t ws_size, hipStream_t stream) {
  static int grid_blocks = 0;
  if (!grid_blocks) {
    int dev = 0, cus = 0, per_cu = 0;
    hipGetDevice(&dev);
    hipDeviceGetAttribute(&cus, hipDeviceAttributeMultiprocessorCount, dev);
    hipOccupancyMaxActiveBlocksPerMultiprocessor(&per_cu, fwd_megakernel, 256, 0);
    if (per_cu > 2) per_cu = 2;
    if (per_cu < 1) per_cu = 1;
    grid_blocks = cus * per_cu;
  }
  Params p{};
  p.x_prompt = (const float*)d_in[0]; p.x_sample = (const float*)d_in[1]; p.c = (const float*)d_in[2];
  p.cache_ckv = (const float*)d_in[3]; p.cache_krope = (const float*)d_in[4]; p.cache_dk = (const float*)d_in[5]; p.cache_dv = (const float*)d_in[6];
  p.c_ctx = (const float*)d_in[7]; p.norm_g = (const float*)d_in[8]; p.ada_w = (const float*)d_in[9]; p.ada_b = (const float*)d_in[10];
  p.w_in = (const float*)d_in[11]; p.q_norm = (const float*)d_in[12]; p.w_uq = (const float*)d_in[13]; p.kv_norm = (const float*)d_in[14];
  p.w_ukv = (const float*)d_in[15]; p.conv_w = (const float*)d_in[16]; p.lam = (const float*)d_in[17]; p.subln = (const float*)d_in[18];
  p.w_out = (const float*)d_in[19]; p.final_norm = (const float*)d_in[20];
  p.out = (float*)d_out;
  p.ws = (char*)d_ws;
  if (ws_size < WS_TOTAL) fprintf(stderr, "workspace too small\n");
  hipMemsetAsync(d_ws, 0, OFF_WinT, stream);
  void* args[] = {&p};
  hipError_t e = hipLaunchCooperativeKernel((void*)fwd_megakernel, dim3(grid_blocks), dim3(256), args, 0, stream);
  if (e != hipSuccess) fprintf(stderr, "cooperative launch failed: %s (grid %d)\n", hipGetErrorString(e), grid_blocks);
}
```

```cpp
#include <hip/hip_runtime.h>
#include <hip/hip_cooperative_groups.h>
#include <cstdio>
namespace cg = cooperative_groups;

typedef unsigned short bf16_t;
typedef short bf16x8 __attribute__((ext_vector_type(8)));
typedef float f32x2 __attribute__((ext_vector_type(2)));
typedef float f32x4 __attribute__((ext_vector_type(4)));
typedef float f32x16 __attribute__((ext_vector_type(16)));
typedef unsigned u32x2 __attribute__((ext_vector_type(2)));
typedef unsigned u32x4 __attribute__((ext_vector_type(4)));
typedef __bf16 bf16x2_t __attribute__((ext_vector_type(2)));

#ifndef REP
#define REP -1
#endif
#define DI __device__ __forceinline__
#define MFMA16(a, b, c) __builtin_amdgcn_mfma_f32_16x16x32_bf16((a), (b), (c), 0, 0, 0)
#define MFMA32(a, b, c) __builtin_amdgcn_mfma_f32_32x32x16_bf16((a), (b), (c), 0, 0, 0)

#define XCD_BAR_WORDS 3456
constexpr int NCTX = 8192, NTOK = 10240, NP = 3840;
constexpr float EPS = 1e-6f;
constexpr float QSCALE_M = 0.14724444602590306f;
constexpr float QSCALE_D = 0.18033688011112042f;
constexpr size_t OUT_CKV = 10485760, OUT_KR = 12582912, OUT_DK = 13107200, OUT_DV = 21495808;

__constant__ float INV16[16] = {1.000000000e+00f, 5.623413324e-01f, 3.162277639e-01f, 1.778279394e-01f, 1.000000015e-01f, 5.623413250e-02f, 3.162277490e-02f, 1.778279431e-02f,
                                9.999999776e-03f, 5.623413250e-03f, 3.162277630e-03f, 1.778279431e-03f, 1.000000047e-03f, 5.623413017e-04f, 3.162277571e-04f, 1.778279402e-04f};
__constant__ float INV8[8] = {1.000000000e+00f, 3.162277639e-01f, 1.000000015e-01f, 3.162277490e-02f, 9.999999776e-03f, 3.162277630e-03f, 1.000000047e-03f, 3.162277571e-04f};

constexpr size_t al256(size_t x) { return (x + 255) & ~(size_t)255; }
constexpr size_t OFF_bar = 0;
constexpr size_t OFF_mod = OFF_bar + al256(XCD_BAR_WORDS * 4);
constexpr size_t OFF_WinT = OFF_mod + al256((size_t)2 * 3 * 3072 * 4);
constexpr size_t OFF_WoutT = OFF_WinT + al256((size_t)2 * NP * 1024 * 2);
constexpr size_t OFF_WuqT = OFF_WoutT + al256((size_t)2 * 1024 * 1024 * 2);
constexpr size_t OFF_WukvTf = OFF_WuqT + al256((size_t)2 * 384 * 256 * 2);
constexpr size_t OFF_WukvT = OFF_WukvTf + al256((size_t)2 * 512 * 128 * 2);
constexpr size_t OFF_ssq_q = OFF_WukvT + al256((size_t)2 * 512 * 128 * 2);
constexpr size_t OFF_ssq_kv = OFF_ssq_q + al256((size_t)2 * NTOK * 4);
constexpr size_t OFF_ssq_x = OFF_ssq_kv + al256((size_t)2 * NTOK * 4);
constexpr size_t OFF_bw = OFF_ssq_x + al256((size_t)3 * NTOK * 4);
constexpr size_t OFF_ropeD = OFF_bw + al256((size_t)2 * 3 * NP * 4);
constexpr size_t OFF_ropeM = OFF_ropeD + al256(2048 * 4);
constexpr size_t OFF_wq = OFF_ropeM + al256(1024 * 4);
constexpr size_t OFF_hbuf = OFF_wq + al256(256);
constexpr size_t OFF_cq = OFF_hbuf + al256((size_t)NTOK * 1024 * 2);
constexpr size_t OFF_ckvraw = OFF_cq + al256((size_t)NTOK * 256 * 2);
constexpr size_t OFF_cckv = OFF_ckvraw + al256((size_t)NTOK * 128 * 2);
constexpr size_t OFF_convb = OFF_cckv + al256((size_t)2 * 512 * 128 * 2);
constexpr size_t OFF_dq = OFF_convb + al256((size_t)NTOK * 768 * 2);
constexpr size_t OFF_zs = OFF_dq + al256((size_t)NTOK * 512 * 2);
constexpr size_t OFF_qm = OFF_zs + al256((size_t)NTOK * 1024 * 2);
constexpr size_t OFF_KmC = OFF_qm + al256((size_t)NTOK * 384 * 2);
constexpr size_t OFF_KmL = OFF_KmC + al256((size_t)32 * 4 * 256 * 96 * 2);
constexpr size_t OFF_VmC = OFF_KmL + al256((size_t)2 * 983040 * 2);
constexpr size_t OFF_VmL = OFF_VmC + al256((size_t)32 * 4 * 64 * 256 * 2);
constexpr size_t OFF_KdC = OFF_VmL + al256((size_t)2 * 655360 * 2);
constexpr size_t OFF_KdL = OFF_KdC + al256((size_t)32 * 4 * 2 * 256 * 64 * 2);
constexpr size_t OFF_VdC = OFF_KdL + al256((size_t)2 * 1310720 * 2);
constexpr size_t OFF_VdL = OFF_VdC + al256((size_t)32 * 4 * 128 * 256 * 2);
constexpr size_t OFF_mix = OFF_VdL + al256((size_t)2 * 1310720 * 2);
constexpr size_t OFF_xbuf = OFF_mix + al256((size_t)NTOK * 1024 * 2);
constexpr size_t WS_TOTAL = OFF_xbuf + al256((size_t)NTOK * 1024 * 4);

struct Params {
  const float *x_prompt, *x_sample, *c, *cache_ckv, *cache_krope, *cache_dk, *cache_dv, *c_ctx;
  const float *norm_g, *ada_w, *ada_b, *w_in, *q_norm, *w_uq, *kv_norm, *w_ukv, *conv_w, *lam, *subln, *w_out, *final_norm;
  float* out;
  char* ws;
  DI unsigned* bar() const { return (unsigned*)(ws + OFF_bar); }
  DI bf16_t* WinT() const { return (bf16_t*)(ws + OFF_WinT); }
  DI bf16_t* WoutT() const { return (bf16_t*)(ws + OFF_WoutT); }
  DI bf16_t* WuqT() const { return (bf16_t*)(ws + OFF_WuqT); }
  DI bf16_t* WukvTf() const { return (bf16_t*)(ws + OFF_WukvTf); }
  DI bf16_t* WukvT() const { return (bf16_t*)(ws + OFF_WukvT); }
  DI float* mod() const { return (float*)(ws + OFF_mod); }
  DI float* ssq_q() const { return (float*)(ws + OFF_ssq_q); }
  DI float* ssq_kv() const { return (float*)(ws + OFF_ssq_kv); }
  DI float* ssq_x() const { return (float*)(ws + OFF_ssq_x); }
  DI float* bw() const { return (float*)(ws + OFF_bw); }
  DI float* ropeD() const { return (float*)(ws + OFF_ropeD); }
  DI float* ropeM() const { return (float*)(ws + OFF_ropeM); }
  DI int* wq() const { return (int*)(ws + OFF_wq); }
  DI bf16_t* hbuf() const { return (bf16_t*)(ws + OFF_hbuf); }
  DI bf16_t* cq() const { return (bf16_t*)(ws + OFF_cq); }
  DI bf16_t* ckvraw() const { return (bf16_t*)(ws + OFF_ckvraw); }
  DI bf16_t* cckv() const { return (bf16_t*)(ws + OFF_cckv); }
  DI bf16_t* convb() const { return (bf16_t*)(ws + OFF_convb); }
  DI bf16_t* dq() const { return (bf16_t*)(ws + OFF_dq); }
  DI bf16_t* zs() const { return (bf16_t*)(ws + OFF_zs); }
  DI bf16_t* qm() const { return (bf16_t*)(ws + OFF_qm); }
  DI bf16_t* KmC() const { return (bf16_t*)(ws + OFF_KmC); }
  DI bf16_t* KmL() const { return (bf16_t*)(ws + OFF_KmL); }
  DI bf16_t* VmC() const { return (bf16_t*)(ws + OFF_VmC); }
  DI bf16_t* VmL() const { return (bf16_t*)(ws + OFF_VmL); }
  DI bf16_t* KdC() const { return (bf16_t*)(ws + OFF_KdC); }
  DI bf16_t* KdL() const { return (bf16_t*)(ws + OFF_KdL); }
  DI bf16_t* VdC() const { return (bf16_t*)(ws + OFF_VdC); }
  DI bf16_t* VdL() const { return (bf16_t*)(ws + OFF_VdL); }
  DI bf16_t* mix() const { return (bf16_t*)(ws + OFF_mix); }
  DI float* xbuf() const { return (float*)(ws + OFF_xbuf); }
};

DI unsigned pk2(float a, float b) {
  f32x2 v = {a, b};
  bf16x2_t r = __builtin_convertvector(v, bf16x2_t);
  return __builtin_bit_cast(unsigned, r);
}
DI float bflo(unsigned u) { return __uint_as_float(u << 16); }
DI float bfhi(unsigned u) { return __uint_as_float(u & 0xffff0000u); }
DI bf16_t f2bf(float a) { return (bf16_t)(pk2(a, 0.f) & 0xffffu); }
DI float shx(float v, int o, int lane) { return __int_as_float(__builtin_amdgcn_ds_bpermute((lane ^ o) << 2, __float_as_int(v))); }
DI float wave_sum(float v, int lane) {
#pragma unroll
  for (int o = 32; o >= 1; o >>= 1) v += shx(v, o, lane);
  return v;
}
DI int opaque_tid() { int t = threadIdx.x; asm volatile("" : "+v"(t)); return t; }
DI int opaque_bid() { int b = blockIdx.x; asm volatile("" : "+s"(b)); return b; }
DI int rope_perm(int P) { return (P & 7) | ((P & 8) << 1) | ((P & 16) >> 1); }


#define XB_TMO      128
#define XB_XCNT(j)  (256  + 64 * (j))
#define XB_XSUB(j)  (1280 + 64 * (j))
#define XB_XGEN(j)  (2304 + 64 * (j))
#define XB_TOP      3328
#define XB_TOPGEN   3392
#define XB_SPIN_CAP (1u << 18)
DI unsigned xb_ld(unsigned* p)              { return __hip_atomic_load(p, __ATOMIC_RELAXED, __HIP_MEMORY_SCOPE_AGENT); }
DI unsigned xb_add(unsigned* p, unsigned v) { return __hip_atomic_fetch_add(p, v, __ATOMIC_RELAXED, __HIP_MEMORY_SCOPE_AGENT); }
DI unsigned xb_xcc_id() { return (unsigned)__builtin_amdgcn_s_getreg((3 << 11) | 20) & 0xFu; }
#define XB_SPIN(cond, bar) do { unsigned _sp = 0; while (cond) { __builtin_amdgcn_s_sleep(1); \
    if ((++_sp & 255u) == 0u) { if (xb_ld(&(bar)[XB_TMO])) break; if (_sp > XB_SPIN_CAP) { atomicAdd(&(bar)[XB_TMO], 1u); break; } } } } while (0)
#define LAS __attribute__((address_space(3)))
struct XcdBarrier { unsigned* bar; unsigned x; volatile LAS unsigned* st; };
DI XcdBarrier xcd_barrier_post(unsigned* bar, volatile LAS unsigned* st) {
  XcdBarrier b; b.bar = bar; b.x = xb_xcc_id(); b.st = st;
  if (threadIdx.x == 0) (void)xb_add(&bar[XB_XCNT(b.x)], 1u);
  return b;
}
DI void xcd_barrier_complete(unsigned* bar, unsigned x, unsigned& nloc, unsigned& nx) {
  const unsigned G = gridDim.x * gridDim.y * gridDim.z;
  unsigned sum, cnt, mine, sp = 0u;
  for (;;) {
    sum = 0u; cnt = 0u; mine = 0u;
#pragma unroll
    for (unsigned j = 0; j < 16; ++j) { const unsigned c = xb_ld(&bar[XB_XCNT(j)]); sum += c; cnt += (c > 0u) ? 1u : 0u; mine = (j == x) ? c : mine; }
    if (sum == G) break;
    __builtin_amdgcn_s_sleep(1);
    if ((++sp & 255u) == 0u) { if (xb_ld(&bar[XB_TMO])) break; if (sp > XB_SPIN_CAP) { atomicAdd(&bar[XB_TMO], 1u); break; } }
  }
  nloc = mine > 0u ? mine : 1u; nx = cnt > 0u ? cnt : 1u;
}
DI void xcd_barrier(const XcdBarrier& b) {
  asm volatile("s_waitcnt vmcnt(0)" ::: "memory");
  __syncthreads();
  if (threadIdx.x == 0) {
    unsigned* bar = b.bar;
    __builtin_amdgcn_s_waitcnt(0);
    unsigned nloc = b.st[0], nx = b.st[1];
    if (nloc == 0u) { xcd_barrier_complete(bar, b.x, nloc, nx); b.st[0] = nloc; b.st[1] = nx; }
    const unsigned old = xb_add(&bar[XB_XSUB(b.x)], 1u);
    const unsigned gen = old / nloc;
    if (old + 1u == (gen + 1u) * nloc) {
      __builtin_amdgcn_fence(__ATOMIC_RELEASE, "agent");
      asm volatile("s_waitcnt vmcnt(0)" ::: "memory");
      const unsigned og = xb_add(&bar[XB_TOP], 1u);
      const unsigned tg = og / nx;
      if (og + 1u == (tg + 1u) * nx) xb_add(&bar[XB_TOPGEN], 1u);
      else XB_SPIN(xb_ld(&bar[XB_TOPGEN]) == tg, bar);
      __builtin_amdgcn_fence(__ATOMIC_ACQUIRE, "agent");
      xb_add(&bar[XB_XGEN(b.x)], 1u);
      asm volatile("s_waitcnt vmcnt(0)" ::: "memory");
    } else {
      XB_SPIN(xb_ld(&bar[XB_XGEN(b.x)]) == gen, bar);
      __builtin_amdgcn_fence(__ATOMIC_ACQUIRE, "agent");
      asm volatile("s_waitcnt vmcnt(0)" ::: "memory");
    }
  }
  __syncthreads();
}

struct ColMapIn { DI int operator()(int n) const { if (n < 384) return n; if (n < 3712) return n + 32; if (n < 3744) return 384 + rope_perm(n - 3712); return -1; } };
struct ColMapId { DI int operator()(int n) const { return n; } };
struct ColMapUq { DI int operator()(int n) const { int h = n / 96, c = n - h * 96; if (c >= 64) c = 64 + rope_perm(c - 64); return h * 96 + c; } };

template <class CM>
DI void tconv_tile(const float* __restrict__ src, int ldsrc, bf16_t* __restrict__ dst, int K, int n0, int k0, const float* __restrict__ kscale, CM cm, float* sm, int tid) {
  const int tq = tid & 15, ty = tid >> 4;
  const int sc = cm(n0 + tq * 4);
  f32x4 v[4];
#pragma unroll
  for (int i = 0; i < 4; ++i) {
    const int kk = ty + i * 16;
    v[i] = (f32x4){0.f, 0.f, 0.f, 0.f};
    if (sc >= 0) v[i] = *(const f32x4*)(src + (size_t)(k0 + kk) * ldsrc + sc);
  }
#pragma unroll
  for (int i = 0; i < 4; ++i) {
    const int kk = ty + i * 16;
    const float s = kscale ? kscale[k0 + kk] : 1.f;
#pragma unroll
    for (int j = 0; j < 4; ++j) sm[kk * 65 + tq * 4 + j] = v[i][j] * s;
  }
  __syncthreads();
  const int kc = tid & 7, nn = tid >> 3;
#pragma unroll
  for (int ps = 0; ps < 2; ++ps) {
    const int n = nn + ps * 32;
    u32x4 o;
#pragma unroll
    for (int i = 0; i < 4; ++i) o[i] = pk2(sm[(kc * 8 + 2 * i) * 65 + n], sm[(kc * 8 + 2 * i + 1) * 65 + n]);
    *(u32x4*)(dst + (size_t)(n0 + n) * K + k0 + kc * 8) = o;
  }
  __syncthreads();
}

DI float silu_f(float x) { return x * __builtin_amdgcn_rcpf(1.f + __expf(-x)); }

DI void mod_item(const Params& p, int it, float* sm, int tid) {
  const int l = it / 192, r = it % 192, cg = r >> 4, kc = r & 15;
  const int c4 = tid & 63, rg = tid >> 6;
  const int k0 = kc * 64 + rg * 16;
  const float* W = p.ada_w + (size_t)l * 1024 * 3072 + (size_t)k0 * 3072 + cg * 256 + c4 * 4;
  f32x4 w[16];
#pragma unroll
  for (int i = 0; i < 16; ++i) w[i] = *(const f32x4*)(W + (size_t)i * 3072);
  float a0[4] = {0, 0, 0, 0}, a1[4] = {0, 0, 0, 0}, a2[4] = {0, 0, 0, 0};
#pragma unroll
  for (int i = 0; i < 16; ++i) {
    const int k = k0 + i;
    const float s0 = silu_f(p.c_ctx[k]), s1 = silu_f(p.c[k]), s2 = silu_f(p.c[1024 + k]);
#pragma unroll
    for (int j = 0; j < 4; ++j) { a0[j] += s0 * w[i][j]; a1[j] += s1 * w[i][j]; a2[j] += s2 * w[i][j]; }
  }
#pragma unroll
  for (int j = 0; j < 4; ++j) {
    sm[(rg * 3 + 0) * 256 + c4 * 4 + j] = a0[j];
    sm[(rg * 3 + 1) * 256 + c4 * 4 + j] = a1[j];
    sm[(rg * 3 + 2) * 256 + c4 * 4 + j] = a2[j];
  }
  __syncthreads();
#pragma unroll
  for (int ci = 0; ci < 3; ++ci) {
    float s = sm[(0 * 3 + ci) * 256 + tid] + sm[(1 * 3 + ci) * 256 + tid] + sm[(2 * 3 + ci) * 256 + tid] + sm[(3 * 3 + ci) * 256 + tid];
    const int col = cg * 256 + tid;
    if (kc == 0) s += p.ada_b[l * 3072 + col];
    atomicAdd(p.mod() + (l * 3 + ci) * 3072 + col, s);
  }
  __syncthreads();
}

DI void sincos_d(float ang, float& c, float& s) {
  const double TWO_PI = 6.283185307179586476925286766559;
  double x = (double)ang;
  x = x - TWO_PI * rint(x / TWO_PI);
  const double x2 = x * x;
  double ts = 1.0, tc = 1.0;
#pragma unroll
  for (int k = 12; k >= 1; --k) {
    ts = 1.0 - ts * x2 / (double)((2 * k) * (2 * k + 1));
    tc = 1.0 - tc * x2 / (double)((2 * k - 1) * (2 * k));
  }
  s = (float)(x * ts);
  c = (float)tc;
}

struct TcDesc { const float* src; bf16_t* dst; const float* kscale; int ld, K, n0, k0, sc; };
DI void tc_decode(const Params& p, int it, int tid, TcDesc& d) {
  const int tq = tid & 15;
  if (it < 1920) {
    const int l = it / 960, r = it % 960;
    d.src = p.w_in + (size_t)l * 1024 * 3744; d.ld = 3744; d.dst = p.WinT() + (size_t)l * NP * 1024; d.K = 1024; d.n0 = (r % 60) * 64; d.k0 = (r / 60) * 64; d.kscale = nullptr;
    d.sc = ColMapIn()(d.n0 + tq * 4);
  } else if (it < 2432) {
    const int j = it - 1920, l = j / 256, r = j % 256;
    d.src = p.w_out + (size_t)l * 1024 * 1024; d.ld = 1024; d.dst = p.WoutT() + (size_t)l * 1024 * 1024; d.K = 1024; d.n0 = (r % 16) * 64; d.k0 = (r / 16) * 64; d.kscale = nullptr;
    d.sc = d.n0 + tq * 4;
  } else if (it < 2480) {
    const int j = it - 2432, l = j / 24, r = j % 24;
    d.src = p.w_uq + (size_t)l * 256 * 384; d.ld = 384; d.dst = p.WuqT() + (size_t)l * 384 * 256; d.K = 256; d.n0 = (r % 6) * 64; d.k0 = (r / 6) * 64; d.kscale = p.q_norm + l * 256;
    d.sc = ColMapUq()(d.n0 + tq * 4);
  } else {
    const int j = (it - 2480) & 31, l = j / 16, r = j % 16;
    const bool folded = it < 2512;
    d.src = p.w_ukv + (size_t)l * 128 * 512; d.ld = 512; d.dst = (folded ? p.WukvTf() : p.WukvT()) + (size_t)l * 512 * 128; d.K = 128; d.n0 = (r % 8) * 64; d.k0 = (r / 8) * 64;
    d.kscale = folded ? p.kv_norm + l * 128 : nullptr;
    d.sc = d.n0 + tq * 4;
  }
}
DI void tc_load(const TcDesc& d, int tid, f32x4 (&v)[4]) {
  const int ty = tid >> 4;
#pragma unroll
  for (int i = 0; i < 4; ++i) {
    v[i] = (f32x4){0.f, 0.f, 0.f, 0.f};
    if (d.sc >= 0) v[i] = *(const f32x4*)(d.src + (size_t)(d.k0 + ty + i * 16) * d.ld + d.sc);
  }
  __builtin_amdgcn_sched_barrier(0);
}
DI void tc_finish(const TcDesc& d, int tid, f32x4 (&v)[4], float* sm) {
  const int tq = tid & 15, ty = tid >> 4;
#pragma unroll
  for (int i = 0; i < 4; ++i) {
    const int kk = ty + i * 16;
    const float s = d.kscale ? d.kscale[d.k0 + kk] : 1.f;
#pragma unroll
    for (int j = 0; j < 4; ++j) sm[kk * 65 + tq * 4 + j] = v[i][j] * s;
  }
  __syncthreads();
  const int kc = tid & 7, nn = tid >> 3;
#pragma unroll
  for (int ps = 0; ps < 2; ++ps) {
    const int n = nn + ps * 32;
    u32x4 o;
#pragma unroll
    for (int i = 0; i < 4; ++i) o[i] = pk2(sm[(kc * 8 + 2 * i) * 65 + n], sm[(kc * 8 + 2 * i + 1) * 65 + n]);
    *(u32x4*)(d.dst + (size_t)(d.n0 + n) * d.K + d.k0 + kc * 8) = o;
  }
  __syncthreads();
}

DI void phase0(const Params& p, char* smem) {
  float* sm = (float*)smem;
  const int tid = opaque_tid(), bid = opaque_bid();
  const int G = gridDim.x;
  for (int it = bid; it < 384; it += G) mod_item(p, it, sm, tid);
  {
    TcDesc da, db;
    f32x4 va[4], vb[4];
    int it = bid;
    bool ha = it < 2544;
    if (ha) { tc_decode(p, it, tid, da); tc_load(da, tid, va); }
    while (ha) {
      const int itb = it + G;
      const bool hb = itb < 2544;
      if (hb) { tc_decode(p, itb, tid, db); tc_load(db, tid, vb); }
      tc_finish(da, tid, va, sm);
      if (!hb) break;
      it = itb + G;
      ha = it < 2544;
      if (ha) { tc_decode(p, it, tid, da); tc_load(da, tid, va); }
      tc_finish(db, tid, vb, sm);
    }
  }
  const int gstride = gridDim.x * 256, g0 = bid * 256 + tid;
  for (int i0 = g0; i0 < 524288; i0 += 4 * gstride) {
    float v[4];
#pragma unroll
    for (int u = 0; u < 4; ++u) {
      const int i = i0 + u * gstride;
      if (i < 524288) { const int cc = i & 511, t = (i >> 9) & 255, b = (i >> 17) & 1, l = i >> 18; v[u] = p.cache_dk[(size_t)((b * 2 + l) * 256 + t) * 512 + cc]; }
    }
#pragma unroll
    for (int u = 0; u < 4; ++u) {
      const int i = i0 + u * gstride;
      if (i < 524288) {
        const int cc = i & 511, t = (i >> 9) & 255, b = (i >> 17) & 1, l = i >> 18, h = cc >> 7, a = (cc >> 6) & 1, d = cc & 63;
        p.KdL()[(size_t)l * 1310720 + (size_t)(((b * 4 + h) * 2 + a) * 1280 + t) * 64 + d] = f2bf(v[u]);
      }
    }
  }
  for (int i0 = g0; i0 < 524288; i0 += 4 * gstride) {
    float v[4];
#pragma unroll
    for (int u = 0; u < 4; ++u) {
      const int j = i0 + u * gstride;
      if (j < 524288) { const int t = j & 255, e = (j >> 8) & 127, h = (j >> 15) & 3, b = (j >> 17) & 1, l = j >> 18; v[u] = p.cache_dv[(size_t)((b * 2 + l) * 256 + t) * 512 + h * 128 + e]; }
    }
#pragma unroll
    for (int u = 0; u < 4; ++u) {
      const int j = i0 + u * gstride;
      if (j < 524288) { const int t = j & 255, e = (j >> 8) & 127, h = (j >> 15) & 3, b = (j >> 17) & 1, l = j >> 18; p.VdL()[(size_t)l * 1310720 + (size_t)((b * 4 + h) * 128 + e) * 1280 + t] = f2bf(v[u]); }
    }
  }
  const int E2 = 131072, E3 = E2 + 131072, E4 = E3 + 1536, E5 = E4 + 40960 + 30720;
  for (int i = g0; i < E5; i += gstride) {
    if (i < E2) {
      const int j = i;
      const int r = j & 31, h = (j >> 5) & 3, t = (j >> 7) & 255, b = (j >> 15) & 1, l = j >> 16;
      p.KmL()[(size_t)l * 983040 + (size_t)((b * 4 + h) * 1280 + t) * 96 + 64 + r] = f2bf(p.cache_krope[(size_t)((b * 2 + l) * 256 + t) * 32 + r]);
    } else if (i < E3) {
      const int j = i - E2;
      const int cc = j & 127, t = (j >> 7) & 255, b = (j >> 15) & 1, l = j >> 16;
      p.cckv()[(size_t)l * 65536 + (b * 256 + t) * 128 + cc] = f2bf(p.cache_ckv[(size_t)((b * 2 + l) * 256 + t) * 128 + cc]);
    } else if (i < E4) {
      const int j = i - E3;
      float cs, sn;
      if (j < 1024) {
        const int pos = j >> 4, f = j & 15;
        sincos_d((float)pos * INV16[f], cs, sn);
        p.ropeD()[j] = cs; p.ropeD()[1024 + j] = sn;
      } else {
        const int jj = j - 1024, pos = jj >> 3, f = jj & 7;
        sincos_d((float)pos * INV8[f], cs, sn);
        p.ropeM()[jj] = cs; p.ropeM()[512 + jj] = sn;
      }
    } else {
      const int j = i - E4;
      if (j < 20480) p.ssq_q()[j] = 0.f; else if (j < 40960) p.ssq_kv()[j - 20480] = 0.f; else p.ssq_x()[j - 40960] = 0.f;
      if (j < 64) p.wq()[j] = 0;
    }
  }
}

DI void phase_norm(const Params& p, int l) {
  const int tid = opaque_tid(), bid = opaque_bid();
  const int lane = tid & 63;
  const int gw = bid * 4 + (tid >> 6), nw = gridDim.x * 4;
  if (l == 0) {
    for (int it = gw; it < 2 * NP; it += nw) {
      const int ll = it / NP, n = it % NP;
      const bf16_t* wrow = p.WinT() + ((size_t)ll * NP + n) * 1024 + lane * 16;
      const u32x4 w0 = *(const u32x4*)wrow, w1 = *(const u32x4*)(wrow + 8);
      float wv[16];
#pragma unroll
      for (int q = 0; q < 4; ++q) { wv[2 * q] = bflo(w0[q]); wv[2 * q + 1] = bfhi(w0[q]); wv[8 + 2 * q] = bflo(w1[q]); wv[8 + 2 * q + 1] = bfhi(w1[q]); }
#pragma unroll
      for (int ci = 0; ci < 3; ++ci) {
        const float* sh = p.mod() + (ll * 3 + ci) * 3072 + lane * 16;
        float s = 0.f;
#pragma unroll
        for (int q = 0; q < 4; ++q) { const f32x4 sv = *(const f32x4*)(sh + q * 4); s += sv[0] * wv[q * 4] + sv[1] * wv[q * 4 + 1] + sv[2] * wv[q * 4 + 2] + sv[3] * wv[q * 4 + 3]; }
        s = wave_sum(s, lane);
        if (lane == 0) p.bw()[(ll * 3 + ci) * NP + n] = s;
      }
    }
  }
  for (int row = gw; row < NTOK; row += nw) {
    const float* x = (l == 0) ? (row < NCTX ? p.x_prompt + (size_t)row * 1024 : p.x_sample + (size_t)(row - NCTX) * 1024) : p.xbuf() + (size_t)row * 1024;
    f32x4 v[4];
#pragma unroll
    for (int i = 0; i < 4; ++i) v[i] = *(const f32x4*)(x + i * 256 + lane * 4);
    if (l == 0) {
      float ss = 0.f;
#pragma unroll
      for (int i = 0; i < 4; ++i) ss += v[i][0] * v[i][0] + v[i][1] * v[i][1] + v[i][2] * v[i][2] + v[i][3] * v[i][3];
      ss = wave_sum(ss, lane);
      if (lane == 0) p.ssq_x()[row] = ss;
      const int ci = row < NCTX ? 0 : 1 + ((row - NCTX) >> 10);
      const float* md = p.mod() + ci * 3072;
#pragma unroll
      for (int i = 0; i < 4; ++i) {
        const int k = i * 256 + lane * 4;
        const f32x4 gg = *(const f32x4*)(p.norm_g + k), sc = *(const f32x4*)(md + 1024 + k);
        float o[4];
#pragma unroll
        for (int j = 0; j < 4; ++j) o[j] = v[i][j] * gg[j] * (1.f + sc[j]);
        u32x2 pk = {pk2(o[0], o[1]), pk2(o[2], o[3])};
        *(u32x2*)(p.hbuf() + (size_t)row * 1024 + k) = pk;
      }
    } else {
      const float rstd = rsqrtf(p.ssq_x()[2 * NTOK + row] * (1.f / 1024.f) + EPS);
#pragma unroll
      for (int i = 0; i < 4; ++i) {
        const int k = i * 256 + lane * 4;
        const f32x4 gg = *(const f32x4*)(p.final_norm + k);
        f32x4 o;
#pragma unroll
        for (int j = 0; j < 4; ++j) o[j] = v[i][j] * rstd * gg[j];
        __builtin_nontemporal_store(o, (f32x4*)(p.out + (size_t)row * 1024 + k));
      }
    }
  }
}

template <int MB, int DEPTH, class Epi>
DI void gemm_tile(const bf16_t* __restrict__ A, int lda, const bf16_t* __restrict__ Bt, int ldb, int K, int row0, int col0, const Epi& epi, char* smem, int tid) {
  constexpr int ABYTES = MB * 32 * 128, STAGE = ABYTES + 16384;
  const int lane = tid & 63, w = tid >> 6, wr = w >> 1, wc = w & 1, fr = lane & 15, fq = lane >> 4;
  const int lrow = tid >> 3, lc8 = tid & 7, lch = lc8 >> 2, lrr = lrow & 15;
  const char* Ab = (const char*)(A + (size_t)row0 * lda);
  const char* Bb = (const char*)(Bt + (size_t)col0 * ldb);
  const unsigned voa = (unsigned)(lrow * lda + lc8 * 8) * 2u, vob = (unsigned)(lrow * ldb + lc8 * 8) * 2u;
  const int wbase = ((lrow >> 4) * 2 + lch) * 1024 + ((((lrr ^ lch) * 64) + (lc8 & 3) * 16) ^ ((lrr >> 3) << 5));
  const int rlo = (fr * 64 + fq * 16) ^ ((fr >> 3) << 5);
  u32x4 ra[DEPTH][MB], rb[DEPTH][4];
  f32x4 acc[MB][4];
#pragma unroll
  for (int m = 0; m < MB; ++m)
#pragma unroll
    for (int n = 0; n < 4; ++n) acc[m][n] = (f32x4){0.f, 0.f, 0.f, 0.f};
  const int nk = K >> 6;
#define GLOAD(S, K0)                                                                               \
  {                                                                                                \
    _Pragma("unroll") for (int ps = 0; ps < MB; ++ps) ra[S][ps] = *(const u32x4*)(Ab + ((size_t)ps * 64 * lda + (K0) * 2) + voa); \
    _Pragma("unroll") for (int ps = 0; ps < 4; ++ps) rb[S][ps] = *(const u32x4*)(Bb + ((size_t)ps * 64 * ldb + (K0) * 2) + vob);  \
    __builtin_amdgcn_sched_barrier(0);                                                             \
  }
#define SSTORE(S, BUF)                                                                             \
  {                                                                                                \
    char* sw = smem + (BUF) * STAGE + wbase;                                                       \
    _Pragma("unroll") for (int ps = 0; ps < MB; ++ps) *(u32x4*)(sw + ps * 4096) = ra[S][ps];        \
    _Pragma("unroll") for (int ps = 0; ps < 4; ++ps) *(u32x4*)(sw + ABYTES + ps * 4096) = rb[S][ps]; \
  }
#define COMPUTE(BUF)                                                                               \
  {                                                                                                \
    const char* sa = smem + (BUF) * STAGE;                                                         \
    const char* sb = sa + ABYTES;                                                                  \
    _Pragma("unroll") for (int kk = 0; kk < 2; ++kk) {                                             \
      bf16x8 af[MB], bfr[4];                                                                       \
      const int ro = kk * 1024 + (rlo ^ (kk * 64));                                                \
      _Pragma("unroll") for (int m = 0; m < MB; ++m) af[m] = *(const bf16x8*)(sa + (wr * MB + m) * 2048 + ro); \
      _Pragma("unroll") for (int n = 0; n < 4; ++n) bfr[n] = *(const bf16x8*)(sb + (wc * 4 + n) * 2048 + ro);  \
      __builtin_amdgcn_s_setprio(1);                                                               \
      _Pragma("unroll") for (int m = 0; m < MB; ++m) _Pragma("unroll") for (int n = 0; n < 4; ++n) acc[m][n] = MFMA16(bfr[n], af[m], acc[m][n]); \
      __builtin_amdgcn_s_setprio(0);                                                               \
    }                                                                                              \
  }
  if constexpr (DEPTH == 2) {
    GLOAD(0, 0);
    GLOAD(1, 64);
    SSTORE(0, 0);
    __syncthreads();
    for (int kt = 0; kt < nk; kt += 2) {
      if (kt + 2 < nk) GLOAD(0, (kt + 2) * 64);
      COMPUTE(0);
      SSTORE(1, 1);
      __syncthreads();
      if (kt + 3 < nk) GLOAD(1, (kt + 3) * 64);
      COMPUTE(1);
      if (kt + 2 < nk) SSTORE(0, 0);
      __syncthreads();
    }
  } else {
    GLOAD(0, 0);
    SSTORE(0, 0);
    __syncthreads();
    for (int kt = 0; kt < nk; kt += 2) {
      GLOAD(0, (kt + 1) * 64);
      COMPUTE(0);
      SSTORE(0, 1);
      __syncthreads();
      if (kt + 2 < nk) GLOAD(0, (kt + 2) * 64);
      COMPUTE(1);
      if (kt + 2 < nk) SSTORE(0, 0);
      __syncthreads();
    }
  }
#undef GLOAD
#undef SSTORE
#undef COMPUTE
  epi.template tile<MB>(row0 + wr * MB * 16 + fr, col0 + wc * 64, fq, acc);
}

DI void st_bf4(bf16_t* dst, const f32x4& v) {
  u32x2 o = {pk2(v[0], v[1]), pk2(v[2], v[3])};
  *(u32x2*)dst = o;
}

DI void rot4(f32x4& x0, f32x4& x1, const float* tab, int toff, int idx) {
  const f32x4 cs = *(const f32x4*)(tab + idx), sn = *(const f32x4*)(tab + toff + idx);
#pragma unroll
  for (int j = 0; j < 4; ++j) {
    const float a = x0[j], b = x1[j];
    x0[j] = a * cs[j] - b * sn[j];
    x1[j] = b * cs[j] + a * sn[j];
  }
}

struct EpiIn {
  const Params& p; int l; bool atom; bool skip;
  template <int MB> DI void tile(int rbase, int cb, int fq, f32x4 (&acc)[MB][4]) const {
    const float* bwp = p.bw() + (l * 3 + (rbase < NCTX ? 0 : 1 + ((rbase - NCTX) >> 10))) * NP + cb + fq * 4;
    f32x4 bb[4];
    float rs[MB];
#pragma unroll
    for (int n = 0; n < 4; ++n) bb[n] = *(const f32x4*)(bwp + n * 16);
#pragma unroll
    for (int m = 0; m < MB; ++m) rs[m] = p.ssq_x()[l * NTOK + rbase + m * 16];
#pragma unroll
    for (int m = 0; m < MB; ++m) {
      const float r = rsqrtf(rs[m] * (1.f / 1024.f) + EPS);
#pragma unroll
      for (int n = 0; n < 4; ++n)
#pragma unroll
        for (int j = 0; j < 4; ++j) acc[m][n][j] = acc[m][n][j] * r + bb[n][j];
      (*this)(rbase + m * 16, cb, fq, acc[m]);
    }
  }
  DI void operator()(int row, int cb, int fq, f32x4 (&v)[4]) const {
    if (skip) return;
    const bool ctx = row < NCTX;
    int b, t;
    if (ctx) { b = row >> 8; t = row & 255; } else { b = (row - NCTX) >> 10; t = (row - NCTX) & 1023; }
    const int pr = t >> 6, pc = t & 63;
    const int c4 = fq * 4;
    if (cb < 384) {
      float ss = 0.f;
#pragma unroll
      for (int n = 0; n < 4; ++n) ss += v[n][0] * v[n][0] + v[n][1] * v[n][1] + v[n][2] * v[n][2] + v[n][3] * v[n][3];
      { const int ln = fq * 16 + (row & 15); ss += shx(ss, 16, ln); ss += shx(ss, 32, ln); }
      if (cb < 256) {
        if (fq == 0 && atom) atomicAdd(p.ssq_q() + l * NTOK + row, ss);
#pragma unroll
        for (int n = 0; n < 4; ++n) st_bf4(p.cq() + (size_t)row * 256 + cb + n * 16 + c4, v[n]);
      } else {
        if (fq == 0 && atom) atomicAdd(p.ssq_kv() + l * NTOK + row, ss);
        const int c = cb - 256;
#pragma unroll
        for (int n = 0; n < 4; ++n) {
          st_bf4(p.ckvraw() + (size_t)row * 128 + c + n * 16 + c4, v[n]);
          if (ctx) *(f32x4*)(p.out + OUT_CKV + (size_t)((b * 2 + l) * 256 + t) * 128 + c + n * 16 + c4) = v[n];
        }
      }
    } else if (cb < 1152) {
      const int c = cb - 384;
#pragma unroll
      for (int n = 0; n < 4; ++n) st_bf4(p.convb() + (size_t)row * 768 + c + n * 16 + c4, v[n]);
    } else if (cb < 1664) {
      const int c = cb - 1152;
      if (!ctx) { rot4(v[0], v[1], p.ropeD(), 1024, pr * 16 + c4); rot4(v[2], v[3], p.ropeD(), 1024, pc * 16 + c4); }
#pragma unroll
      for (int n = 0; n < 4; ++n) { v[n] *= QSCALE_D; st_bf4(p.dq() + (size_t)row * 512 + c + n * 16 + c4, v[n]); }
    } else if (cb < 2176) {
      const int c = cb - 1664, h = c >> 7, a = (c >> 6) & 1;
      if (ctx) {
#pragma unroll
        for (int n = 0; n < 4; ++n) {
          __builtin_nontemporal_store(v[n], (f32x4*)(p.out + OUT_DK + (size_t)((b * 2 + l) * 256 + t) * 512 + c + n * 16 + c4));
          st_bf4(p.KdC() + (size_t)(((b * 4 + h) * 2 + a) * 256 + t) * 64 + n * 16 + c4, v[n]);
        }
      } else {
        rot4(v[0], v[1], p.ropeD(), 1024, pr * 16 + c4); rot4(v[2], v[3], p.ropeD(), 1024, pc * 16 + c4);
#pragma unroll
        for (int n = 0; n < 4; ++n) st_bf4(p.KdL() + (size_t)l * 1310720 + (size_t)(((b * 4 + h) * 2 + a) * 1280 + 256 + t) * 64 + n * 16 + c4, v[n]);
      }
    } else if (cb < 2688) {
      const int c = cb - 2176, h = c >> 7, e0 = (c & 127) + c4;
      if (ctx) {
#pragma unroll
        for (int n = 0; n < 4; ++n) {
          __builtin_nontemporal_store(v[n], (f32x4*)(p.out + OUT_DV + (size_t)((b * 2 + l) * 256 + t) * 512 + c + n * 16 + c4));
#pragma unroll
          for (int j = 0; j < 4; ++j) p.VdC()[(size_t)((b * 4 + h) * 128 + e0 + n * 16 + j) * 256 + t] = f2bf(v[n][j]);
        }
      } else {
#pragma unroll
        for (int n = 0; n < 4; ++n)
#pragma unroll
          for (int j = 0; j < 4; ++j) p.VdL()[(size_t)l * 1310720 + (size_t)((b * 4 + h) * 128 + e0 + n * 16 + j) * 1280 + 256 + t] = f2bf(v[n][j]);
      }
    } else if (cb < 3712) {
      const int c = cb - 2688;
#pragma unroll
      for (int n = 0; n < 4; ++n) {
        f32x4 s;
#pragma unroll
        for (int j = 0; j < 4; ++j) s[j] = silu_f(v[n][j]);
        st_bf4(p.zs() + (size_t)row * 1024 + c + n * 16 + c4, s);
      }
    } else if (cb == 3712) {
      const int o0 = (fq < 2) ? c4 : c4 + 8;
      if (ctx) {
        float* so = p.out + OUT_KR + (size_t)((b * 2 + l) * 256 + t) * 32 + o0;
        __builtin_nontemporal_store(v[0], (f32x4*)so);
        __builtin_nontemporal_store(v[1], (f32x4*)(so + 8));
#pragma unroll
        for (int h = 0; h < 4; ++h) {
          bf16_t* d = p.KmC() + (size_t)((b * 4 + h) * 256 + t) * 96 + 64 + o0;
          st_bf4(d, v[0]); st_bf4(d + 8, v[1]);
        }
      } else {
        if (fq < 2) rot4(v[0], v[1], p.ropeM(), 512, pr * 8 + c4); else rot4(v[0], v[1], p.ropeM(), 512, pc * 8 + c4 - 8);
#pragma unroll
        for (int h = 0; h < 4; ++h) {
          bf16_t* d = p.KmL() + (size_t)l * 983040 + (size_t)((b * 4 + h) * 1280 + 256 + t) * 96 + 64 + o0;
          st_bf4(d, v[0]); st_bf4(d + 8, v[1]);
        }
      }
    }
  }
};

struct EpiQ {
  const Params& p; int l;
  template <int MB> DI void tile(int rbase, int cb, int fq, f32x4 (&acc)[MB][4]) const {
#pragma unroll
    for (int m = 0; m < MB; ++m) (*this)(rbase + m * 16, cb, fq, acc[m]);
  }
  DI void operator()(int row, int cb, int fq, f32x4 (&v)[4]) const {
    const bool ctx = row < NCTX;
    const int t = (row - NCTX) & 1023, pr = t >> 6, pc = t & 63, c4 = fq * 4;
    const float f = rsqrtf(p.ssq_q()[l * NTOK + row] * (1.f / 256.f) + EPS) * QSCALE_M;
#pragma unroll
    for (int g = 0; g < 2; ++g) {
      const int cs = cb + 32 * g;
      v[2 * g] *= f; v[2 * g + 1] *= f;
      if (cs % 96 == 64) {
        const int o0 = (fq < 2) ? c4 : c4 + 8;
        if (!ctx) { if (fq < 2) rot4(v[2 * g], v[2 * g + 1], p.ropeM(), 512, pr * 8 + c4); else rot4(v[2 * g], v[2 * g + 1], p.ropeM(), 512, pc * 8 + c4 - 8); }
        bf16_t* d = p.qm() + (size_t)row * 384 + cs + o0;
        st_bf4(d, v[2 * g]); st_bf4(d + 8, v[2 * g + 1]);
      } else {
        bf16_t* d = p.qm() + (size_t)row * 384 + cs + c4;
        st_bf4(d, v[2 * g]); st_bf4(d + 16, v[2 * g + 1]);
      }
    }
  }
};

struct EpiKV {
  const Params& p; int l; int mode;
  template <int MB> DI void tile(int rbase, int cb, int fq, f32x4 (&acc)[MB][4]) const {
#pragma unroll
    for (int m = 0; m < MB; ++m) (*this)(rbase + m * 16, cb, fq, acc[m]);
  }
  DI void operator()(int row, int cb, int fq, f32x4 (&v)[4]) const {
    const int h = cb >> 7, c4 = fq * 4;
    const bool isV = (cb & 64) != 0;
    float f = 1.f;
    bf16_t *kd, *vd; int vstride;
    if (mode == 0) {
      f = rsqrtf(p.ssq_kv()[l * NTOK + row] * (1.f / 128.f) + EPS);
      if (row < NCTX) {
        const int b = row >> 8, t = row & 255;
        kd = p.KmC() + (size_t)((b * 4 + h) * 256 + t) * 96; vd = p.VmC() + (size_t)((b * 4 + h) * 64) * 256 + t; vstride = 256;
      } else {
        const int b = (row - NCTX) >> 10, t = (row - NCTX) & 1023;
        kd = p.KmL() + (size_t)l * 983040 + (size_t)((b * 4 + h) * 1280 + 256 + t) * 96; vd = p.VmL() + (size_t)l * 655360 + (size_t)((b * 4 + h) * 64) * 1280 + 256 + t; vstride = 1280;
      }
    } else {
      const int b = row >> 8, t = row & 255;
      kd = p.KmL() + (size_t)l * 983040 + (size_t)((b * 4 + h) * 1280 + t) * 96; vd = p.VmL() + (size_t)l * 655360 + (size_t)((b * 4 + h) * 64) * 1280 + t; vstride = 1280;
    }
#pragma unroll
    for (int n = 0; n < 4; ++n) {
      v[n] *= f;
      if (!isV) st_bf4(kd + n * 16 + c4, v[n]);
      else {
#pragma unroll
        for (int j = 0; j < 4; ++j) vd[(size_t)(n * 16 + c4 + j) * vstride] = f2bf(v[n][j]);
      }
    }
  }
};

struct EpiOut {
  const Params& p; int l;
  template <int MB> DI void tile(int rbase, int cb, int fq, f32x4 (&acc)[MB][4]) const {
    const float* gate0 = p.mod() + (l * 3) * 3072 + 2048 + cb + fq * 4;
    f32x4 xv[MB][4];
#pragma unroll
    for (int m = 0; m < MB; ++m) {
      const int row = rbase + m * 16;
      const float* xo = (l == 0) ? (row < NCTX ? p.x_prompt + (size_t)row * 1024 : p.x_sample + (size_t)(row - NCTX) * 1024) : p.xbuf() + (size_t)row * 1024;
#pragma unroll
      for (int n = 0; n < 4; ++n) xv[m][n] = *(const f32x4*)(xo + cb + n * 16 + fq * 4);
    }
    __builtin_amdgcn_sched_barrier(0);
    const int ln = fq * 16 + (rbase & 15);
#pragma unroll
    for (int m = 0; m < MB; ++m) {
      const int row = rbase + m * 16;
      const int ci = row < NCTX ? 0 : 1 + ((row - NCTX) >> 10);
      float ss = 0.f;
#pragma unroll
      for (int n = 0; n < 4; ++n) {
        const int col = cb + n * 16 + fq * 4;
        const f32x4 g = *(const f32x4*)(gate0 + ci * 3072 + n * 16);
        f32x4 o;
#pragma unroll
        for (int j = 0; j < 4; ++j) { o[j] = xv[m][n][j] + g[j] * acc[m][n][j]; ss += o[j] * o[j]; }
        *(f32x4*)(p.xbuf() + (size_t)row * 1024 + col) = o;
        if (l == 0) {
          const f32x4 gg = *(const f32x4*)(p.norm_g + 1024 + col), sc = *(const f32x4*)(p.mod() + (3 + ci) * 3072 + 1024 + col);
          u32x2 pk = {pk2(o[0] * gg[0] * (1.f + sc[0]), o[1] * gg[1] * (1.f + sc[1])), pk2(o[2] * gg[2] * (1.f + sc[2]), o[3] * gg[3] * (1.f + sc[3]))};
          *(u32x2*)(p.hbuf() + (size_t)row * 1024 + col) = pk;
        }
      }
      ss += shx(ss, 16, ln); ss += shx(ss, 32, ln);
      if (fq == 0) atomicAdd(p.ssq_x() + (l + 1) * NTOK + row, ss);
    }
  }
};

template <int MINE, int THEIRS>
DI void diff_finalize(f32x16 (&O)[4], float f, float sgn, const float* __restrict__ subln, float osc, char* smem, int w, int lane, int hh,
                      bf16_t* __restrict__ orow, const bf16_t* __restrict__ zrow, bool active) {
  float* ex = (float*)smem;
  float* sx = ex + 4 * 32 * 64;
  if (active) {
#pragma unroll
    for (int d = 0; d < 2; ++d)
#pragma unroll
      for (int i = 0; i < 16; ++i) ex[(w * 32 + d * 16 + i) * 64 + lane] = O[THEIRS + d][i] * f;
  }
  __syncthreads();
  if (!active) { __syncthreads(); return; }
  const float* pe = ex + (w ^ 1) * 32 * 64;
  float ss = 0.f;
#pragma unroll
  for (int d = 0; d < 2; ++d)
#pragma unroll
    for (int i = 0; i < 16; ++i) {
      const float mine = O[MINE + d][i] * f, theirs = pe[(d * 16 + i) * 64 + lane];
      const float o = (sgn == 0.f) ? (mine - theirs) : (theirs - mine);
      O[MINE + d][i] = o; ss += o * o;
    }
  ss += shx(ss, 32, lane);
  sx[w * 64 + lane] = ss;
  __syncthreads();
  ss += sx[(w ^ 1) * 64 + lane];
  const float rs = rsqrtf(ss * (1.f / 128.f) + EPS) * osc;
#pragma unroll
  for (int d = 0; d < 2; ++d) {
#pragma unroll
    for (int g = 0; g < 4; ++g) {
      const int d0 = (MINE + d) * 32 + g * 8 + hh * 4;
      const f32x4 sg = *(const f32x4*)(subln + d0);
      const u32x2 z = *(const u32x2*)(zrow + d0);
      u32x2 o = {pk2(O[MINE + d][4 * g] * rs * sg[0] * bflo(z[0]), O[MINE + d][4 * g + 1] * rs * sg[1] * bfhi(z[0])),
                 pk2(O[MINE + d][4 * g + 2] * rs * sg[2] * bflo(z[1]), O[MINE + d][4 * g + 3] * rs * sg[3] * bfhi(z[1]))};
      *(u32x2*)(orow + d0) = o;
    }
    __builtin_amdgcn_sched_barrier(0);
  }
}

template <int DQK, int DV, bool DIFF, bool SPLIT>
DI void attn_item(const bf16_t* __restrict__ Qp, int ldq, const bf16_t* __restrict__ Kp, const bf16_t* __restrict__ Vtp, int nkeys,
                  bf16_t* __restrict__ outp, const bf16_t* __restrict__ zsp, float lamf, const float* __restrict__ subln, float osc, char* smem, int tid,
                  int warm_n = 0, int warm_share = 0) {
  constexpr int NMAPK = DIFF ? 2 : 1;
  constexpr int KROW = (DQK + 8) * 2;
  constexpr int KMAPB = 64 * KROW;
  constexpr int VROW = 136;
  constexpr int NS = DQK / 16, NDB = DV / 32;
  constexpr int BUFB = NMAPK * KMAPB + DV * VROW;
  constexpr int NT = SPLIT ? 2 : 1;
  char* sK = smem;
  char* sV = smem + NMAPK * KMAPB;
  const int lane = tid & 63, w = tid >> 6, r = lane & 31, hh = lane >> 5;
  const int kh = SPLIT ? (w >> 1) : 0;
  const int qb = SPLIT ? (DIFF ? 0 : (w & 1)) : (DIFF ? (w >> 1) : w);
  const int am = DIFF ? (w & 1) : 0;
  bf16x8 qf[NS];
#pragma unroll
  for (int s = 0; s < NS; ++s) qf[s] = *(const bf16x8*)(Qp + (size_t)(qb * 32 + r) * ldq + am * 64 + s * 16 + hh * 8);
  f32x16 O[NDB];
  float mrun = -1e30f, lrun = 0.f;
#pragma unroll
  for (int db = 0; db < NDB; ++db)
#pragma unroll
    for (int i = 0; i < 16; ++i) O[db][i] = 0.f;
  const char* sKa = sK + am * KMAPB + r * KROW + hh * 16;
  const char* sVa = sV + r * VROW + hh * 8;
  const int nkt = nkeys >> 6, nit = SPLIT ? (nkt >> 1) : nkt;
  constexpr int KCH = 64 * DQK / 8;
  constexpr int NKC = (KCH + 255) / 256, NVC = DV * 8 / 256;
  u32x4 kreg[NT][NMAPK][NKC], vreg[NT][NVC];
#define ATT_GLOAD(J)                                                                               \
  {                                                                                                \
    _Pragma("unroll") for (int t = 0; t < NT; ++t) {                                               \
      const int tile = t * nit + (J);                                                              \
      _Pragma("unroll") for (int a = 0; a < NMAPK; ++a) {                                          \
        const bf16_t* kg = Kp + (size_t)a * nkeys * DQK + (size_t)tile * 64 * DQK;                  \
        _Pragma("unroll") for (int c = 0; c < NKC; ++c) {                                          \
          const int ch = c * 256 + tid;                                                            \
          if (KCH % 256 == 0 || ch < KCH) kreg[t][a][c] = *(const u32x4*)(kg + (size_t)ch * 8);     \
        }                                                                                          \
      }                                                                                            \
      const bf16_t* vg = Vtp + (size_t)tile * 64;                                                   \
      _Pragma("unroll") for (int c = 0; c < NVC; ++c) {                                            \
        const int ch = c * 256 + tid, d = ch >> 3, part = ch & 7;                                  \
        vreg[t][c] = *(const u32x4*)(vg + (size_t)d * nkeys + part * 8);                            \
      }                                                                                            \
    }                                                                                              \
    __builtin_amdgcn_sched_barrier(0);                                                             \
  }
#define ATT_SWRITE(BUF)                                                                            \
  {                                                                                                \
    _Pragma("unroll") for (int t = 0; t < NT; ++t) {                                               \
      char* bK = sK + (SPLIT ? t : (BUF)) * BUFB;                                                  \
      char* bV = sV + (SPLIT ? t : (BUF)) * BUFB;                                                  \
      _Pragma("unroll") for (int a = 0; a < NMAPK; ++a) _Pragma("unroll") for (int c = 0; c < NKC; ++c) { \
        const int ch = c * 256 + tid;                                                              \
        if (KCH % 256 == 0 || ch < KCH) {                                                          \
          const int key = ch / (DQK / 8), part = ch % (DQK / 8);                                   \
          *(u32x4*)(bK + a * KMAPB + key * KROW + part * 16) = kreg[t][a][c];                       \
        }                                                                                          \
      }                                                                                            \
      _Pragma("unroll") for (int c = 0; c < NVC; ++c) {                                            \
        const int ch = c * 256 + tid, d = ch >> 3, part = ch & 7;                                  \
        u32x2 lo = {vreg[t][c][0], vreg[t][c][1]}, hi = {vreg[t][c][2], vreg[t][c][3]};            \
        *(u32x2*)(bV + d * VROW + part * 16) = lo;                                                 \
        *(u32x2*)(bV + d * VROW + part * 16 + 8) = hi;                                             \
      }                                                                                            \
    }                                                                                              \
  }
  auto compute = [&](const char* sKb, const char* sVb) {
    f32x16 st[2];
#pragma unroll
    for (int kb = 0; kb < 2; ++kb) {
#pragma unroll
      for (int i = 0; i < 16; ++i) st[kb][i] = 0.f;
#pragma unroll
      for (int s = 0; s < NS; ++s) {
        const bf16x8 kf = *(const bf16x8*)(sKb + kb * 32 * KROW + s * 32);
        st[kb] = MFMA32(kf, qf[s], st[kb]);
      }
    }
    float mx = st[0][0];
#pragma unroll
    for (int i = 1; i < 16; ++i) mx = fmaxf(mx, st[0][i]);
#pragma unroll
    for (int i = 0; i < 16; ++i) mx = fmaxf(mx, st[1][i]);
    mx = fmaxf(mx, shx(mx, 32, lane));
    const float mnew = fmaxf(mrun, mx);
    const float alpha = __builtin_amdgcn_exp2f(mrun - mnew);
    mrun = mnew;
    float ls = 0.f;
#pragma unroll
    for (int kb = 0; kb < 2; ++kb)
#pragma unroll
      for (int i = 0; i < 16; ++i) { const float e = __builtin_amdgcn_exp2f(st[kb][i] - mnew); st[kb][i] = e; ls += e; }
    lrun = lrun * alpha + ls;
    if (__builtin_amdgcn_ballot_w64(alpha != 1.f) != 0) {
#pragma unroll
      for (int db = 0; db < NDB; ++db)
#pragma unroll
        for (int i = 0; i < 16; ++i) O[db][i] *= alpha;
    }
#pragma unroll
    for (int kb = 0; kb < 2; ++kb)
#pragma unroll
      for (int t2 = 0; t2 < 2; ++t2) {
        u32x4 pp;
#pragma unroll
        for (int j = 0; j < 4; ++j) pp[j] = pk2(st[kb][8 * t2 + 2 * j], st[kb][8 * t2 + 2 * j + 1]);
        const bf16x8 pf = __builtin_bit_cast(bf16x8, pp);
#pragma unroll
        for (int db = 0; db < NDB; ++db) {
          const char* vb = sVb + db * 32 * VROW + (kb * 32 + 16 * t2) * 2;
          const u32x2 lo = *(const u32x2*)vb, hi = *(const u32x2*)(vb + 16);
          const u32x4 vv = {lo[0], lo[1], hi[0], hi[1]};
          O[db] = MFMA32(__builtin_bit_cast(bf16x8, vv), pf, O[db]);
        }
        if constexpr (DIFF && SPLIT) __builtin_amdgcn_sched_barrier(0);
      }
  };
  ATT_GLOAD(0);
  unsigned w0 = 0u, w1 = 0u;
  if (warm_n > 0) {
    const int lk = (NMAPK * nkeys * DQK * 2 / 128) / warm_n, lv = (DV * nkeys * 2 / 128) / warm_n;
    if (tid < lk) w0 = *(const volatile unsigned*)((const char*)Kp + (size_t)(warm_share * lk + tid) * 128);
    if (tid < lv) w1 = *(const volatile unsigned*)((const char*)Vtp + (size_t)(warm_share * lv + tid) * 128);
  }
  if constexpr (!SPLIT) {
    __syncthreads();
    ATT_SWRITE(0);
    if (nit > 1) ATT_GLOAD(1);
    __syncthreads();
    for (int kt = 0; kt < nit; ++kt) {
      if (kt + 1 < nit) {
        ATT_SWRITE((kt + 1) & 1);
        if (kt + 2 < nit) ATT_GLOAD(kt + 2);
      }
      compute(sKa + (kt & 1) * BUFB, sVa + (kt & 1) * BUFB);
      __syncthreads();
    }
  } else {
    for (int j = 0; j < nit; ++j) {
      __syncthreads();
      ATT_SWRITE(0);
      __syncthreads();
      if (j + 1 < nit) ATT_GLOAD(j + 1);
      compute(sKa + kh * BUFB, sVa + kh * BUFB);
    }
    __syncthreads();
    float* mg = (float*)(smem + 36864);
    float* mlb = mg + 2 * NDB * 16 * 64;
    const int wl = w & 1;
    if (kh == 1) {
#pragma unroll
      for (int db = 0; db < NDB; ++db)
#pragma unroll
        for (int i = 0; i < 16; ++i) mg[((wl * NDB + db) * 16 + i) * 64 + lane] = O[db][i];
      mlb[(wl * 2 + 0) * 64 + lane] = mrun;
      mlb[(wl * 2 + 1) * 64 + lane] = lrun;
    }
    __syncthreads();
    if (kh == 0) {
      const float m1 = mlb[(wl * 2 + 0) * 64 + lane], l1 = mlb[(wl * 2 + 1) * 64 + lane];
      const float mn = fmaxf(mrun, m1);
      const float s0 = __builtin_amdgcn_exp2f(mrun - mn), s1 = __builtin_amdgcn_exp2f(m1 - mn);
      lrun = lrun * s0 + l1 * s1;
      mrun = mn;
#pragma unroll
      for (int db = 0; db < NDB; ++db)
#pragma unroll
        for (int i = 0; i < 16; ++i) O[db][i] = O[db][i] * s0 + mg[((wl * NDB + db) * 16 + i) * 64 + lane] * s1;
    }
  }
#undef ATT_GLOAD
#undef ATT_SWRITE
  const float inv = 1.f / (lrun + shx(lrun, 32, lane));
  const size_t ro = (size_t)(qb * 32 + r) * 1024;
  const bool active = (kh == 0);
  if constexpr (DIFF) {
    __syncthreads();
    if (am == 0) diff_finalize<0, 2>(O, inv, 0.f, subln, osc, smem, w, lane, hh, outp + ro, zsp + ro, active);
    else diff_finalize<2, 0>(O, inv * lamf, 1.f, subln, osc, smem, w, lane, hh, outp + ro, zsp + ro, active);
  } else {
    if (active) {
#pragma unroll
      for (int db = 0; db < NDB; ++db) {
#pragma unroll
        for (int g = 0; g < 4; ++g) {
          const int d0 = db * 32 + g * 8 + hh * 4;
          const u32x2 z = *(const u32x2*)(zsp + ro + d0);
          u32x2 o = {pk2(O[db][4 * g] * inv * bflo(z[0]), O[db][4 * g + 1] * inv * bfhi(z[0])), pk2(O[db][4 * g + 2] * inv * bflo(z[1]), O[db][4 * g + 3] * inv * bfhi(z[1]))};
          *(u32x2*)(outp + ro + d0) = o;
        }
        __builtin_amdgcn_sched_barrier(0);
      }
    }
  }
  if ((w0 ^ w1) == 0x7fc54321u && warm_n < 0) ((volatile unsigned*)smem)[0] = w0;
}

DI void conv_item(const Params& p, int l, int it, int tid) {
  const int ch = (tid & 31) * 8, rr = tid >> 5;
  float w0[8], w1[8], w2[8];
#pragma unroll
  for (int j = 0; j < 8; ++j) { w0[j] = p.conv_w[l * 768 + ch + j]; w1[j] = p.conv_w[l * 768 + 256 + ch + j]; w2[j] = p.conv_w[l * 768 + 512 + ch + j]; }
  for (int i = 0; i < 16; ++i) {
    const int row = it * 128 + i * 8 + rr;
    int t, len;
    if (row < NCTX) { t = row & 255; len = 256; } else { t = (row - NCTX) & 1023; len = 1024; }
    const bf16_t* base = p.convb() + (size_t)row * 768;
    const u32x4 zero = {0u, 0u, 0u, 0u};
    const u32x4 cbv = *(const u32x4*)(base + ch);
    const u32x4 c1 = *(const u32x4*)(base + 256 + ch), x1 = *(const u32x4*)(base + 512 + ch);
    const u32x4 c0 = t > 0 ? *(const u32x4*)(base - 768 + 256 + ch) : zero, x0 = t > 0 ? *(const u32x4*)(base - 768 + 512 + ch) : zero;
    const u32x4 c2 = t < len - 1 ? *(const u32x4*)(base + 768 + 256 + ch) : zero, x2 = t < len - 1 ? *(const u32x4*)(base + 768 + 512 + ch) : zero;
    const u32x4 zv = *(const u32x4*)(p.zs() + (size_t)row * 1024 + 256 + ch);
    u32x4 o;
#pragma unroll
    for (int q = 0; q < 4; ++q) {
      const float ylo = bflo(c0[q]) * bflo(x0[q]) * w0[2 * q] + bflo(c1[q]) * bflo(x1[q]) * w1[2 * q] + bflo(c2[q]) * bflo(x2[q]) * w2[2 * q];
      const float yhi = bfhi(c0[q]) * bfhi(x0[q]) * w0[2 * q + 1] + bfhi(c1[q]) * bfhi(x1[q]) * w1[2 * q + 1] + bfhi(c2[q]) * bfhi(x2[q]) * w2[2 * q + 1];
      o[q] = pk2(bflo(cbv[q]) * ylo * bflo(zv[q]), bfhi(cbv[q]) * yhi * bfhi(zv[q]));
    }
    *(u32x4*)(p.mix() + (size_t)row * 1024 + 256 + ch) = o;
  }
}

DI void phase_mix(const Params& p, int l, char* smem, int mask = 7) {
  const int lane = opaque_tid() & 63;
  const float* lm = p.lam + l * 256;
  const float s01 = wave_sum(lm[lane] * lm[64 + lane], lane), s23 = wave_sum(lm[128 + lane] * lm[192 + lane], lane);
  const float lam_init = (l == 0) ? 0.2f : 0.35550906759096934f;
  const float lamf = __int_as_float(__builtin_amdgcn_readfirstlane(__float_as_int(__expf(s01) - __expf(s23) + lam_init)));
  const float osc = 1.f - lam_init;
  const int bid = opaque_bid(), G = gridDim.x;
  for (int slot = 0;; ++slot) {
    int it;
    if (G == 512) {
      if (slot == 0) it = bid;
      else if (slot == 1) it = bid < 128 ? -1 : bid < 192 ? 704 + (bid - 128) : bid < 384 ? 512 + (bid - 192) : 768 + (bid - 384);
      else if (slot == 2) it = bid < 384 ? -1 : bid < 448 ? 896 + (bid - 384) : 960 + (bid - 448);
      else if (slot == 3) it = (bid >= 192 && bid < 208) ? 1024 + (bid - 192) : -1;
      else break;
      if (it < 0) continue;
    } else {
      it = slot * G + bid;
      if (it >= 1040) break;
    }
    int tid = threadIdx.x;
    asm volatile("" : "+v"(tid));
#if REP >= 40
    { const bool isdiff = it < 128 || (it >= 192 && it < 704), ismla = (it >= 128 && it < 192) || (it >= 704 && it < 960), islat = it < 192;
      if (mask == 1 && !isdiff) continue; if (mask == 2 && !ismla) continue; if (mask == 3 && !islat) continue; if (mask == 4 && !(isdiff && islat)) continue; }
#endif
    if (it < 128 || (it >= 192 && it < 704)) {
      int b, h, qt; size_t row0; const bf16_t *kp, *vp; int nk;
      if (it < 128) {
        const int x = it & 7; b = x >> 2; h = x & 3; qt = it >> 3; row0 = NCTX + b * 1024 + qt * 64; nk = 1280;
        kp = p.KdL() + (size_t)l * 1310720 + (size_t)((b * 4 + h) * 2) * 1280 * 64; vp = p.VdL() + (size_t)l * 1310720 + (size_t)((b * 4 + h) * 128) * 1280;
      } else {
        const int j = it - 192, combo = (j & 7) | ((j >> 5) << 3); b = combo >> 2; h = combo & 3; qt = (j >> 3) & 3; row0 = b * 256 + qt * 64; nk = 256;
        kp = p.KdC() + (size_t)((b * 4 + h) * 2) * 256 * 64; vp = p.VdC() + (size_t)((b * 4 + h) * 128) * 256;
      }
      attn_item<64, 128, true, false>(p.dq() + row0 * 512 + h * 128, 512, kp, vp, nk, p.mix() + row0 * 1024 + 512 + h * 128, p.zs() + row0 * 1024 + 512 + h * 128,
                                      lamf, p.subln + l * 128, osc, smem, tid, it < 128 ? 16 : 0, qt);
    } else if (it < 960) {
      int b, h, qt; size_t row0; const bf16_t *kp, *vp; int nk;
      if (it < 192) {
        const int j = it - 128, x = j & 7; b = x >> 2; h = x & 3; qt = j >> 3; row0 = NCTX + b * 1024 + qt * 128; nk = 1280;
        kp = p.KmL() + (size_t)l * 983040 + (size_t)(b * 4 + h) * 1280 * 96; vp = p.VmL() + (size_t)l * 655360 + (size_t)((b * 4 + h) * 64) * 1280;
      } else {
        const int j = it - 704, combo = (j & 7) | ((j >> 4) << 3); b = combo >> 2; h = combo & 3; qt = (j >> 3) & 1; row0 = b * 256 + qt * 128; nk = 256;
        kp = p.KmC() + (size_t)(b * 4 + h) * 256 * 96; vp = p.VmC() + (size_t)((b * 4 + h) * 64) * 256;
      }
      attn_item<96, 64, false, false>(p.qm() + row0 * 384 + h * 96, 384, kp, vp, nk, p.mix() + row0 * 1024 + h * 64, p.zs() + row0 * 1024 + h * 64, 0.f, nullptr, 1.f, smem, tid, it < 192 ? 8 : 0, qt);
    } else {
      conv_item(p, l, it - 960, tid);
    }
  }
}

DI void phase_inproj(const Params& p, int l, char* smem, bool atom = true, bool skip = false) {
  EpiIn epi{p, l, atom, skip};
  const int tid = opaque_tid(), bid = opaque_bid();
  const int xcd = bid & 7, nloc = (gridDim.x + 7 - xcd) >> 3;
  for (int j = bid >> 3; j < 300; j += nloc) {
    const int mt = xcd * 10 + j % 10, nt = j / 10;
    gemm_tile<4, 2>(p.hbuf(), 1024, p.WinT() + (size_t)l * NP * 1024, 1024, 1024, mt * 128, nt * 128, epi, smem, tid);
  }
}

DI void phase_upproj(const Params& p, int l, char* smem, bool fix = true) {
  const int tid = opaque_tid(), bid = opaque_bid();
  if (fix) {
    const float* g = p.kv_norm + l * 128;
    for (int i = bid * 256 + tid; i < NCTX * 32; i += gridDim.x * 256) {
      const int row = i >> 5, c = (i & 31) * 4, b = row >> 8, t = row & 255;
      const float f = rsqrtf(p.ssq_kv()[l * NTOK + row] * (1.f / 128.f) + EPS);
      float* d = p.out + OUT_CKV + (size_t)((b * 2 + l) * 256 + t) * 128 + c;
      f32x4 v = *(f32x4*)d;
      const f32x4 gg = *(const f32x4*)(g + c);
#pragma unroll
      for (int j = 0; j < 4; ++j) v[j] *= f * gg[j];
      *(f32x4*)d = v;
    }
  }
  EpiQ eq{p, l};
  EpiKV ek0{p, l, 0}, ek1{p, l, 1};
  for (int it = bid; it < 464; it += gridDim.x) {
    if (it < 192) {
      const int mt = it / 3, nt = it % 3;
      gemm_tile<5, 1>(p.cq(), 256, p.WuqT() + (size_t)l * 384 * 256, 256, 256, mt * 160, nt * 128, eq, smem, tid);
    } else if (it < 448) {
      const int j = it - 192, mt = j >> 2, nt = j & 3;
      gemm_tile<5, 1>(p.ckvraw(), 128, p.WukvTf() + (size_t)l * 512 * 128, 128, 128, mt * 160, nt * 128, ek0, smem, tid);
    } else {
      const int j = it - 448, mt = j >> 2, nt = j & 3;
      gemm_tile<4, 1>(p.cckv() + (size_t)l * 65536, 128, p.WukvT() + (size_t)l * 512 * 128, 128, 128, mt * 128, nt * 128, ek1, smem, tid);
    }
  }
}

DI void phase_outproj(const Params& p, int l, char* smem) {
  EpiOut epi{p, l};
  const int tid = opaque_tid(), bid = opaque_bid();
  const int xcd = bid & 7, nloc = (gridDim.x + 7 - xcd) >> 3;
  for (int j = bid >> 3; j < 64; j += nloc) {
    const int mt = xcd * 8 + (j & 7), nt = j >> 3;
    gemm_tile<5, 1>(p.mix(), 1024, p.WoutT() + (size_t)l * 1024 * 1024, 1024, 1024, mt * 160, nt * 128, epi, smem, tid);
  }
}

__global__ void __launch_bounds__(256, 2) fwd_megakernel(Params p) {
  __shared__ __attribute__((aligned(16))) char smem[73728];
  __shared__ __attribute__((aligned(16))) unsigned xb_words[4];
  cg::grid_group grid = cg::this_grid();
  if (p.ws == nullptr) grid.sync();
  if (threadIdx.x == 0) { xb_words[0] = 0u; xb_words[1] = 0u; xb_words[2] = 0u; xb_words[3] = 0u; }
  __syncthreads();
  const XcdBarrier xb = xcd_barrier_post(p.bar(), (volatile LAS unsigned*)xb_words);
#define GSYNC() xcd_barrier(xb)
  phase0(p, smem);
#if REP == 0
  GSYNC(); phase0(p, smem);
#endif
#pragma unroll
  for (int l = 0; l < 2; ++l) {
    GSYNC();
    if (l == 0) { phase_norm(p, 0); GSYNC(); }
#if REP == 2
    phase_inproj(p, l, smem, false); GSYNC();
#endif
#if REP == 7
    phase_inproj(p, l, smem, false, p.ws != nullptr); GSYNC();
#endif
    phase_inproj(p, l, smem);
    GSYNC();
#if REP == 3
    phase_upproj(p, l, smem, false); GSYNC();
#endif
    phase_upproj(p, l, smem);
    GSYNC();
#if REP == 4
    phase_mix(p, l, smem); GSYNC();
#endif
#if REP >= 40
    phase_mix(p, l, smem, REP - 40); GSYNC();
#endif
    phase_mix(p, l, smem);
    GSYNC();
#if REP == 5
    if (l == 0) { phase_outproj(p, l, smem); GSYNC(); }
#endif
    phase_outproj(p, l, smem);
  }
  GSYNC();
  phase_norm(p, 2);
#if REP == 6
  for (int i = 0; i < 10; ++i) GSYNC();
#endif
}

extern "C" void kernel_launch(void* const* d_in, const int* in_sizes, int n_in, void* d_out, int out_size, void* d_ws, size_t ws_size, hipStream_t stream) {
  static int grid_blocks = 0;
  if (!grid_blocks) {
    int dev = 0, cus = 0, per_cu = 0;
    hipGetDevice(&dev);
    hipDeviceGetAttribute(&cus, hipDeviceAttributeMultiprocessorCount, dev);
    hipOccupancyMaxActiveBlocksPerMultiprocessor(&per_cu, fwd_megakernel, 256, 0);
    if (per_cu > 2) per_cu = 2;
    if (per_cu < 1) per_cu = 1;
    grid_blocks = cus * per_cu;
  }
  Params p{};
  p.x_prompt = (const float*)d_in[0]; p.x_sample = (const float*)d_in[1]; p.c = (const float*)d_in[2];
  p.cache_ckv = (const float*)d_in[3]; p.cache_krope = (const float*)d_in[4]; p.cache_dk = (const float*)d_in[5]; p.cache_dv = (const float*)d_in[6];
  p.c_ctx = (const float*)d_in[7]; p.norm_g = (const float*)d_in[8]; p.ada_w = (const float*)d_in[9]; p.ada_b = (const float*)d_in[10];
  p.w_in = (const float*)d_in[11]; p.q_norm = (const float*)d_in[12]; p.w_uq = (const float*)d_in[13]; p.kv_norm = (const float*)d_in[14];
  p.w_ukv = (const float*)d_in[15]; p.conv_w = (const float*)d_in[16]; p.lam = (const float*)d_in[17]; p.subln = (const float*)d_in[18];
  p.w_out = (const float*)d_in[19]; p.final_norm = (const float*)d_in[20];
  p.out = (float*)d_out;
  p.ws = (char*)d_ws;
  if (ws_size < WS_TOTAL) fprintf(stderr, "workspace too small\n");
  hipMemsetAsync(d_ws, 0, OFF_WinT, stream);
  void* args[] = {&p};
  hipError_t e = hipLaunchCooperativeKernel((void*)fwd_megakernel, dim3(grid_blocks), dim3(256), args, 0, stream);
  if (e != hipSuccess) fprintf(stderr, "cooperative launch failed: %s (grid %d)\n", hipGetErrorString(e), grid_blocks);
}
```

```cpp
#include <hip/hip_runtime.h>
#include <hip/hip_cooperative_groups.h>
#include <cstdio>
namespace cg = cooperative_groups;

typedef unsigned short bf16_t;
typedef short bf16x8 __attribute__((ext_vector_type(8)));
typedef float f32x2 __attribute__((ext_vector_type(2)));
typedef float f32x4 __attribute__((ext_vector_type(4)));
typedef float f32x16 __attribute__((ext_vector_type(16)));
typedef unsigned u32x2 __attribute__((ext_vector_type(2)));
typedef unsigned u32x4 __attribute__((ext_vector_type(4)));
typedef __bf16 bf16x2_t __attribute__((ext_vector_type(2)));

#ifndef REP
#define REP -1
#endif
#define DI __device__ __forceinline__
#define MFMA16(a, b, c) __builtin_amdgcn_mfma_f32_16x16x32_bf16((a), (b), (c), 0, 0, 0)
#define MFMA32(a, b, c) __builtin_amdgcn_mfma_f32_32x32x16_bf16((a), (b), (c), 0, 0, 0)

#define XCD_BAR_WORDS 3456
constexpr int NCTX = 8192, NTOK = 10240, NP = 3840;
constexpr float EPS = 1e-6f;
constexpr float QSCALE_M = 0.14724444602590306f;
constexpr float QSCALE_D = 0.18033688011112042f;
constexpr size_t OUT_CKV = 10485760, OUT_KR = 12582912, OUT_DK = 13107200, OUT_DV = 21495808;

__constant__ float INV16[16] = {1.000000000e+00f, 5.623413324e-01f, 3.162277639e-01f, 1.778279394e-01f, 1.000000015e-01f, 5.623413250e-02f, 3.162277490e-02f, 1.778279431e-02f,
                                9.999999776e-03f, 5.623413250e-03f, 3.162277630e-03f, 1.778279431e-03f, 1.000000047e-03f, 5.623413017e-04f, 3.162277571e-04f, 1.778279402e-04f};
__constant__ float INV8[8] = {1.000000000e+00f, 3.162277639e-01f, 1.000000015e-01f, 3.162277490e-02f, 9.999999776e-03f, 3.162277630e-03f, 1.000000047e-03f, 3.162277571e-04f};

constexpr size_t al256(size_t x) { return (x + 255) & ~(size_t)255; }
constexpr size_t OFF_bar = 0;
constexpr size_t OFF_mod = OFF_bar + al256(XCD_BAR_WORDS * 4);
constexpr size_t OFF_WinT = OFF_mod + al256((size_t)2 * 3 * 3072 * 4);
constexpr size_t OFF_WoutT = OFF_WinT + al256((size_t)2 * NP * 1024 * 2);
constexpr size_t OFF_WuqT = OFF_WoutT + al256((size_t)2 * 1024 * 1024 * 2);
constexpr size_t OFF_WukvTf = OFF_WuqT + al256((size_t)2 * 384 * 256 * 2);
constexpr size_t OFF_WukvT = OFF_WukvTf + al256((size_t)2 * 512 * 128 * 2);
constexpr size_t OFF_ssq_q = OFF_WukvT + al256((size_t)2 * 512 * 128 * 2);
constexpr size_t OFF_ssq_kv = OFF_ssq_q + al256((size_t)2 * NTOK * 4);
constexpr size_t OFF_ssq_x = OFF_ssq_kv + al256((size_t)2 * NTOK * 4);
constexpr size_t OFF_bw = OFF_ssq_x + al256((size_t)3 * NTOK * 4);
constexpr size_t OFF_ropeD = OFF_bw + al256((size_t)2 * 3 * NP * 4);
constexpr size_t OFF_ropeM = OFF_ropeD + al256(2048 * 4);
constexpr size_t OFF_wq = OFF_ropeM + al256(1024 * 4);
constexpr size_t OFF_hbuf = OFF_wq + al256(256);
constexpr size_t OFF_cq = OFF_hbuf + al256((size_t)NTOK * 1024 * 2);
constexpr size_t OFF_ckvraw = OFF_cq + al256((size_t)NTOK * 256 * 2);
constexpr size_t OFF_cckv = OFF_ckvraw + al256((size_t)NTOK * 128 * 2);
constexpr size_t OFF_convb = OFF_cckv + al256((size_t)2 * 512 * 128 * 2);
constexpr size_t OFF_dq = OFF_convb + al256((size_t)NTOK * 768 * 2);
constexpr size_t OFF_zs = OFF_dq + al256((size_t)NTOK * 512 * 2);
constexpr size_t OFF_qm = OFF_zs + al256((size_t)NTOK * 1024 * 2);
constexpr size_t OFF_KmC = OFF_qm + al256((size_t)NTOK * 384 * 2);
constexpr size_t OFF_KmL = OFF_KmC + al256((size_t)32 * 4 * 256 * 96 * 2);
constexpr size_t OFF_VmC = OFF_KmL + al256((size_t)2 * 983040 * 2);
constexpr size_t OFF_VmL = OFF_VmC + al256((size_t)32 * 4 * 64 * 256 * 2);
constexpr size_t OFF_KdC = OFF_VmL + al256((size_t)2 * 655360 * 2);
constexpr size_t OFF_KdL = OFF_KdC + al256((size_t)32 * 4 * 2 * 256 * 64 * 2);
constexpr size_t OFF_VdC = OFF_KdL + al256((size_t)2 * 1310720 * 2);
constexpr size_t OFF_VdL = OFF_VdC + al256((size_t)32 * 4 * 128 * 256 * 2);
constexpr size_t OFF_mix = OFF_VdL + al256((size_t)2 * 1310720 * 2);
constexpr size_t OFF_xbuf = OFF_mix + al256((size_t)NTOK * 1024 * 2);
constexpr size_t WS_TOTAL = OFF_xbuf + al256((size_t)NTOK * 1024 * 4);

struct Params {
  const float *x_prompt, *x_sample, *c, *cache_ckv, *cache_krope, *cache_dk, *cache_dv, *c_ctx;
  const float *norm_g, *ada_w, *ada_b, *w_in, *q_norm, *w_uq, *kv_norm, *w_ukv, *conv_w, *lam, *subln, *w_out, *final_norm;
  float* out;
  char* ws;
  DI unsigned* bar() const { return (unsigned*)(ws + OFF_bar); }
  DI bf16_t* WinT() const { return (bf16_t*)(ws + OFF_WinT); }
  DI bf16_t* WoutT() const { return (bf16_t*)(ws + OFF_WoutT); }
  DI bf16_t* WuqT() const { return (bf16_t*)(ws + OFF_WuqT); }
  DI bf16_t* WukvTf() const { return (bf16_t*)(ws + OFF_WukvTf); }
  DI bf16_t* WukvT() const { return (bf16_t*)(ws + OFF_WukvT); }
  DI float* mod() const { return (float*)(ws + OFF_mod); }
  DI float* ssq_q() const { return (float*)(ws + OFF_ssq_q); }
  DI float* ssq_kv() const { return (float*)(ws + OFF_ssq_kv); }
  DI float* ssq_x() const { return (float*)(ws + OFF_ssq_x); }
  DI float* bw() const { return (float*)(ws + OFF_bw); }
  DI float* ropeD() const { return (float*)(ws + OFF_ropeD); }
  DI float* ropeM() const { return (float*)(ws + OFF_ropeM); }
  DI int* wq() const { return (int*)(ws + OFF_wq); }
  DI bf16_t* hbuf() const { return (bf16_t*)(ws + OFF_hbuf); }
  DI bf16_t* cq() const { return (bf16_t*)(ws + OFF_cq); }
  DI bf16_t* ckvraw() const { return (bf16_t*)(ws + OFF_ckvraw); }
  DI bf16_t* cckv() const { return (bf16_t*)(ws + OFF_cckv); }
  DI bf16_t* convb() const { return (bf16_t*)(ws + OFF_convb); }
  DI bf16_t* dq() const { return (bf16_t*)(ws + OFF_dq); }
  DI bf16_t* zs() const { return (bf16_t*)(ws + OFF_zs); }
  DI bf16_t* qm() const { return (bf16_t*)(ws + OFF_qm); }
  DI bf16_t* KmC() const { return (bf16_t*)(ws + OFF_KmC); }
  DI bf16_t* KmL() const { return (bf16_t*)(ws + OFF_KmL); }
  DI bf16_t* VmC() const { return (bf16_t*)(ws + OFF_VmC); }
  DI bf16_t* VmL() const { return (bf16_t*)(ws + OFF_VmL); }
  DI bf16_t* KdC() const { return (bf16_t*)(ws + OFF_KdC); }
  DI bf16_t* KdL() const { return (bf16_t*)(ws + OFF_KdL); }
  DI bf16_t* VdC() const { return (bf16_t*)(ws + OFF_VdC); }
  DI bf16_t* VdL() const { return (bf16_t*)(ws + OFF_VdL); }
  DI bf16_t* mix() const { return (bf16_t*)(ws + OFF_mix); }
  DI float* xbuf() const { return (float*)(ws + OFF_xbuf); }
};

DI unsigned pk2(float a, float b) {
  f32x2 v = {a, b};
  bf16x2_t r = __builtin_convertvector(v, bf16x2_t);
  return __builtin_bit_cast(unsigned, r);
}
DI float bflo(unsigned u) { return __uint_as_float(u << 16); }
DI float bfhi(unsigned u) { return __uint_as_float(u & 0xffff0000u); }
DI bf16_t f2bf(float a) { return (bf16_t)(pk2(a, 0.f) & 0xffffu); }
DI float shx(float v, int o, int lane) { return __int_as_float(__builtin_amdgcn_ds_bpermute((lane ^ o) << 2, __float_as_int(v))); }
DI float wave_sum(float v, int lane) {
#pragma unroll
  for (int o = 32; o >= 1; o >>= 1) v += shx(v, o, lane);
  return v;
}
DI int opaque_tid() { int t = threadIdx.x; asm volatile("" : "+v"(t)); return t; }
DI int opaque_bid() { int b = blockIdx.x; asm volatile("" : "+s"(b)); return b; }
DI int rope_perm(int P) { return (P & 7) | ((P & 8) << 1) | ((P & 16) >> 1); }


#define XB_TMO      128
#define XB_XCNT(j)  (256  + 64 * (j))
#define XB_XSUB(j)  (1280 + 64 * (j))
#define XB_XGEN(j)  (2304 + 64 * (j))
#define XB_TOP      3328
#define XB_TOPGEN   3392
#define XB_SPIN_CAP (1u << 18)
DI unsigned xb_ld(unsigned* p)              { return __hip_atomic_load(p, __ATOMIC_RELAXED, __HIP_MEMORY_SCOPE_AGENT); }
DI unsigned xb_add(unsigned* p, unsigned v) { return __hip_atomic_fetch_add(p, v, __ATOMIC_RELAXED, __HIP_MEMORY_SCOPE_AGENT); }
DI unsigned xb_xcc_id() { return (unsigned)__builtin_amdgcn_s_getreg((3 << 11) | 20) & 0xFu; }
#define XB_SPIN(cond, bar) do { unsigned _sp = 0; while (cond) { __builtin_amdgcn_s_sleep(1); \
    if ((++_sp & 255u) == 0u) { if (xb_ld(&(bar)[XB_TMO])) break; if (_sp > XB_SPIN_CAP) { atomicAdd(&(bar)[XB_TMO], 1u); break; } } } } while (0)
#define LAS __attribute__((address_space(3)))
struct XcdBarrier { unsigned* bar; unsigned x; volatile LAS unsigned* st; };
DI XcdBarrier xcd_barrier_post(unsigned* bar, volatile LAS unsigned* st) {
  XcdBarrier b; b.bar = bar; b.x = xb_xcc_id(); b.st = st;
  if (threadIdx.x == 0) (void)xb_add(&bar[XB_XCNT(b.x)], 1u);
  return b;
}
DI void xcd_barrier_complete(unsigned* bar, unsigned x, unsigned& nloc, unsigned& nx) {
  const unsigned G = gridDim.x * gridDim.y * gridDim.z;
  unsigned sum, cnt, mine, sp = 0u;
  for (;;) {
    sum = 0u; cnt = 0u; mine = 0u;
#pragma unroll
    for (unsigned j = 0; j < 16; ++j) { const unsigned c = xb_ld(&bar[XB_XCNT(j)]); sum += c; cnt += (c > 0u) ? 1u : 0u; mine = (j == x) ? c : mine; }
    if (sum == G) break;
    __builtin_amdgcn_s_sleep(1);
    if ((++sp & 255u) == 0u) { if (xb_ld(&bar[XB_TMO])) break; if (sp > XB_SPIN_CAP) { atomicAdd(&bar[XB_TMO], 1u); break; } }
  }
  nloc = mine > 0u ? mine : 1u; nx = cnt > 0u ? cnt : 1u;
}
DI void xcd_barrier(const XcdBarrier& b) {
  asm volatile("s_waitcnt vmcnt(0)" ::: "memory");
  __syncthreads();
  if (threadIdx.x == 0) {
    unsigned* bar = b.bar;
    __builtin_amdgcn_s_waitcnt(0);
    unsigned nloc = b.st[0], nx = b.st[1];
    if (nloc == 0u) { xcd_barrier_complete(bar, b.x, nloc, nx); b.st[0] = nloc; b.st[1] = nx; }
    const unsigned old = xb_add(&bar[XB_XSUB(b.x)], 1u);
    const unsigned gen = old / nloc;
    if (old + 1u == (gen + 1u) * nloc) {
      __builtin_amdgcn_fence(__ATOMIC_RELEASE, "agent");
      asm volatile("s_waitcnt vmcnt(0)" ::: "memory");
      const unsigned og = xb_add(&bar[XB_TOP], 1u);
      const unsigned tg = og / nx;
      if (og + 1u == (tg + 1u) * nx) xb_add(&bar[XB_TOPGEN], 1u);
      else XB_SPIN(xb_ld(&bar[XB_TOPGEN]) == tg, bar);
      __builtin_amdgcn_fence(__ATOMIC_ACQUIRE, "agent");
      xb_add(&bar[XB_XGEN(b.x)], 1u);
      asm volatile("s_waitcnt vmcnt(0)" ::: "memory");
    } else {
      XB_SPIN(xb_ld(&bar[XB_XGEN(b.x)]) == gen, bar);
      __builtin_amdgcn_fence(__ATOMIC_ACQUIRE, "agent");
      asm volatile("s_waitcnt vmcnt(0)" ::: "memory");
    }
  }
  __syncthreads();
}

struct ColMapIn { DI int operator()(int n) const { if (n < 384) return n; if (n < 3712) return n + 32; if (n < 3744) return 384 + rope_perm(n - 3712); return -1; } };
struct ColMapId { DI int operator()(int n) const { return n; } };
struct ColMapUq { DI int operator()(int n) const { int h = n / 96, c = n - h * 96; if (c >= 64) c = 64 + rope_perm(c - 64); return h * 96 + c; } };

template <class CM>
DI void tconv_tile(const float* __restrict__ src, int ldsrc, bf16_t* __restrict__ dst, int K, int n0, int k0, const float* __restrict__ kscale, CM cm, float* sm, int tid) {
  const int tq = tid & 15, ty = tid >> 4;
  const int sc = cm(n0 + tq * 4);
  f32x4 v[4];
#pragma unroll
  for (int i = 0; i < 4; ++i) {
    const int kk = ty + i * 16;
    v[i] = (f32x4){0.f, 0.f, 0.f, 0.f};
    if (sc >= 0) v[i] = *(const f32x4*)(src + (size_t)(k0 + kk) * ldsrc + sc);
  }
#pragma unroll
  for (int i = 0; i < 4; ++i) {
    const int kk = ty + i * 16;
    const float s = kscale ? kscale[k0 + kk] : 1.f;
#pragma unroll
    for (int j = 0; j < 4; ++j) sm[kk * 65 + tq * 4 + j] = v[i][j] * s;
  }
  __syncthreads();
  const int kc = tid & 7, nn = tid >> 3;
#pragma unroll
  for (int ps = 0; ps < 2; ++ps) {
    const int n = nn + ps * 32;
    u32x4 o;
#pragma unroll
    for (int i = 0; i < 4; ++i) o[i] = pk2(sm[(kc * 8 + 2 * i) * 65 + n], sm[(kc * 8 + 2 * i + 1) * 65 + n]);
    *(u32x4*)(dst + (size_t)(n0 + n) * K + k0 + kc * 8) = o;
  }
  __syncthreads();
}

DI float silu_f(float x) { return x * __builtin_amdgcn_rcpf(1.f + __expf(-x)); }

DI void mod_item(const Params& p, int it, float* sm, int tid) {
  const int l = it / 192, r = it % 192, cg = r >> 4, kc = r & 15;
  const int c4 = tid & 63, rg = tid >> 6;
  const int k0 = kc * 64 + rg * 16;
  const float* W = p.ada_w + (size_t)l * 1024 * 3072 + (size_t)k0 * 3072 + cg * 256 + c4 * 4;
  f32x4 w[16];
#pragma unroll
  for (int i = 0; i < 16; ++i) w[i] = __builtin_nontemporal_load((const f32x4*)(W + (size_t)i * 3072));
  float a0[4] = {0, 0, 0, 0}, a1[4] = {0, 0, 0, 0}, a2[4] = {0, 0, 0, 0};
#pragma unroll
  for (int i = 0; i < 16; ++i) {
    const int k = k0 + i;
    const float s0 = silu_f(p.c_ctx[k]), s1 = silu_f(p.c[k]), s2 = silu_f(p.c[1024 + k]);
#pragma unroll
    for (int j = 0; j < 4; ++j) { a0[j] += s0 * w[i][j]; a1[j] += s1 * w[i][j]; a2[j] += s2 * w[i][j]; }
  }
#pragma unroll
  for (int j = 0; j < 4; ++j) {
    sm[(rg * 3 + 0) * 256 + c4 * 4 + j] = a0[j];
    sm[(rg * 3 + 1) * 256 + c4 * 4 + j] = a1[j];
    sm[(rg * 3 + 2) * 256 + c4 * 4 + j] = a2[j];
  }
  __syncthreads();
#pragma unroll
  for (int ci = 0; ci < 3; ++ci) {
    float s = sm[(0 * 3 + ci) * 256 + tid] + sm[(1 * 3 + ci) * 256 + tid] + sm[(2 * 3 + ci) * 256 + tid] + sm[(3 * 3 + ci) * 256 + tid];
    const int col = cg * 256 + tid;
    if (kc == 0) s += p.ada_b[l * 3072 + col];
    atomicAdd(p.mod() + (l * 3 + ci) * 3072 + col, s);
  }
  __syncthreads();
}

DI void sincos_d(float ang, float& c, float& s) {
  const double TWO_PI = 6.283185307179586476925286766559;
  double x = (double)ang;
  x = x - TWO_PI * rint(x / TWO_PI);
  const double x2 = x * x;
  double ts = 1.0, tc = 1.0;
#pragma unroll
  for (int k = 12; k >= 1; --k) {
    ts = 1.0 - ts * x2 / (double)((2 * k) * (2 * k + 1));
    tc = 1.0 - tc * x2 / (double)((2 * k - 1) * (2 * k));
  }
  s = (float)(x * ts);
  c = (float)tc;
}

struct TcDesc { const float* src; bf16_t* dst; const float* kscale; int ld, K, n0, k0, sc; };
DI void tc_decode(const Params& p, int it, int tid, TcDesc& d) {
  const int tq = tid & 15;
  if (it < 1920) {
    const int l = it / 960, r = it % 960;
    d.src = p.w_in + (size_t)l * 1024 * 3744; d.ld = 3744; d.dst = p.WinT() + (size_t)l * NP * 1024; d.K = 1024; d.n0 = (r % 60) * 64; d.k0 = (r / 60) * 64; d.kscale = nullptr;
    d.sc = ColMapIn()(d.n0 + tq * 4);
  } else if (it < 2432) {
    const int j = it - 1920, l = j / 256, r = j % 256;
    d.src = p.w_out + (size_t)l * 1024 * 1024; d.ld = 1024; d.dst = p.WoutT() + (size_t)l * 1024 * 1024; d.K = 1024; d.n0 = (r % 16) * 64; d.k0 = (r / 16) * 64; d.kscale = nullptr;
    d.sc = d.n0 + tq * 4;
  } else if (it < 2480) {
    const int j = it - 2432, l = j / 24, r = j % 24;
    d.src = p.w_uq + (size_t)l * 256 * 384; d.ld = 384; d.dst = p.WuqT() + (size_t)l * 384 * 256; d.K = 256; d.n0 = (r % 6) * 64; d.k0 = (r / 6) * 64; d.kscale = p.q_norm + l * 256;
    d.sc = ColMapUq()(d.n0 + tq * 4);
  } else {
    const int j = (it - 2480) & 31, l = j / 16, r = j % 16;
    const bool folded = it < 2512;
    d.src = p.w_ukv + (size_t)l * 128 * 512; d.ld = 512; d.dst = (folded ? p.WukvTf() : p.WukvT()) + (size_t)l * 512 * 128; d.K = 128; d.n0 = (r % 8) * 64; d.k0 = (r / 8) * 64;
    d.kscale = folded ? p.kv_norm + l * 128 : nullptr;
    d.sc = d.n0 + tq * 4;
  }
}
DI void tc_load(const TcDesc& d, int tid, f32x4 (&v)[4]) {
  const int ty = tid >> 4;
#pragma unroll
  for (int i = 0; i < 4; ++i) {
    v[i] = (f32x4){0.f, 0.f, 0.f, 0.f};
    if (d.sc >= 0) v[i] = __builtin_nontemporal_load((const f32x4*)(d.src + (size_t)(d.k0 + ty + i * 16) * d.ld + d.sc));
  }
  __builtin_amdgcn_sched_barrier(0);
}
DI void tc_finish(const TcDesc& d, int tid, f32x4 (&v)[4], float* sm) {
  const int tq = tid & 15, ty = tid >> 4;
#pragma unroll
  for (int i = 0; i < 4; ++i) {
    const int kk = ty + i * 16;
    const float s = d.kscale ? d.kscale[d.k0 + kk] : 1.f;
#pragma unroll
    for (int j = 0; j < 4; ++j) sm[kk * 65 + tq * 4 + j] = v[i][j] * s;
  }
  __syncthreads();
  const int kc = tid & 7, nn = tid >> 3;
#pragma unroll
  for (int ps = 0; ps < 2; ++ps) {
    const int n = nn + ps * 32;
    u32x4 o;
#pragma unroll
    for (int i = 0; i < 4; ++i) o[i] = pk2(sm[(kc * 8 + 2 * i) * 65 + n], sm[(kc * 8 + 2 * i + 1) * 65 + n]);
    *(u32x4*)(d.dst + (size_t)(d.n0 + n) * d.K + d.k0 + kc * 8) = o;
  }
  __syncthreads();
}

DI void phase0(const Params& p, char* smem) {
  float* sm = (float*)smem;
  const int tid = opaque_tid(), bid = opaque_bid();
  const int G = gridDim.x;
  for (int it = bid; it < 384; it += G) mod_item(p, it, sm, tid);
  {
    TcDesc da, db;
    f32x4 va[4], vb[4];
    int it = bid;
    bool ha = it < 2544;
    if (ha) { tc_decode(p, it, tid, da); tc_load(da, tid, va); }
    while (ha) {
      const int itb = it + G;
      const bool hb = itb < 2544;
      if (hb) { tc_decode(p, itb, tid, db); tc_load(db, tid, vb); }
      tc_finish(da, tid, va, sm);
      if (!hb) break;
      it = itb + G;
      ha = it < 2544;
      if (ha) { tc_decode(p, it, tid, da); tc_load(da, tid, va); }
      tc_finish(db, tid, vb, sm);
    }
  }
  const int gstride = gridDim.x * 256, g0 = bid * 256 + tid;
  for (int i0 = g0; i0 < 524288; i0 += 4 * gstride) {
    float v[4];
#pragma unroll
    for (int u = 0; u < 4; ++u) {
      const int i = i0 + u * gstride;
      if (i < 524288) { const int cc = i & 511, t = (i >> 9) & 255, b = (i >> 17) & 1, l = i >> 18; v[u] = p.cache_dk[(size_t)((b * 2 + l) * 256 + t) * 512 + cc]; }
    }
#pragma unroll
    for (int u = 0; u < 4; ++u) {
      const int i = i0 + u * gstride;
      if (i < 524288) {
        const int cc = i & 511, t = (i >> 9) & 255, b = (i >> 17) & 1, l = i >> 18, h = cc >> 7, a = (cc >> 6) & 1, d = cc & 63;
        p.KdL()[(size_t)l * 1310720 + (size_t)(((b * 4 + h) * 2 + a) * 1280 + t) * 64 + d] = f2bf(v[u]);
      }
    }
  }
  for (int i0 = g0; i0 < 524288; i0 += 4 * gstride) {
    float v[4];
#pragma unroll
    for (int u = 0; u < 4; ++u) {
      const int j = i0 + u * gstride;
      if (j < 524288) { const int t = j & 255, e = (j >> 8) & 127, h = (j >> 15) & 3, b = (j >> 17) & 1, l = j >> 18; v[u] = p.cache_dv[(size_t)((b * 2 + l) * 256 + t) * 512 + h * 128 + e]; }
    }
#pragma unroll
    for (int u = 0; u < 4; ++u) {
      const int j = i0 + u * gstride;
      if (j < 524288) { const int t = j & 255, e = (j >> 8) & 127, h = (j >> 15) & 3, b = (j >> 17) & 1, l = j >> 18; p.VdL()[(size_t)l * 1310720 + (size_t)((b * 4 + h) * 128 + e) * 1280 + t] = f2bf(v[u]); }
    }
  }
  const int E2 = 131072, E3 = E2 + 131072, E4 = E3 + 1536, E5 = E4 + 40960 + 30720;
  for (int i = g0; i < E5; i += gstride) {
    if (i < E2) {
      const int j = i;
      const int r = j & 31, h = (j >> 5) & 3, t = (j >> 7) & 255, b = (j >> 15) & 1, l = j >> 16;
      p.KmL()[(size_t)l * 983040 + (size_t)((b * 4 + h) * 1280 + t) * 96 + 64 + r] = f2bf(p.cache_krope[(size_t)((b * 2 + l) * 256 + t) * 32 + r]);
    } else if (i < E3) {
      const int j = i - E2;
      const int cc = j & 127, t = (j >> 7) & 255, b = (j >> 15) & 1, l = j >> 16;
      p.cckv()[(size_t)l * 65536 + (b * 256 + t) * 128 + cc] = f2bf(p.cache_ckv[(size_t)((b * 2 + l) * 256 + t) * 128 + cc]);
    } else if (i < E4) {
      const int j = i - E3;
      float cs, sn;
      if (j < 1024) {
        const int pos = j >> 4, f = j & 15;
        sincos_d((float)pos * INV16[f], cs, sn);
        p.ropeD()[j] = cs; p.ropeD()[1024 + j] = sn;
      } else {
        const int jj = j - 1024, pos = jj >> 3, f = jj & 7;
        sincos_d((float)pos * INV8[f], cs, sn);
        p.ropeM()[jj] = cs; p.ropeM()[512 + jj] = sn;
      }
    } else {
      const int j = i - E4;
      if (j < 20480) p.ssq_q()[j] = 0.f; else if (j < 40960) p.ssq_kv()[j - 20480] = 0.f; else p.ssq_x()[j - 40960] = 0.f;
      if (j < 64) p.wq()[j] = 0;
    }
  }
}

DI void phase_norm(const Params& p, int l) {
  const int tid = opaque_tid(), bid = opaque_bid();
  const int lane = tid & 63;
  const int gw = bid * 4 + (tid >> 6), nw = gridDim.x * 4;
  if (l == 0) {
    for (int it = gw; it < 2 * NP; it += nw) {
      const int ll = it / NP, n = it % NP;
      const bf16_t* wrow = p.WinT() + ((size_t)ll * NP + n) * 1024 + lane * 16;
      const u32x4 w0 = *(const u32x4*)wrow, w1 = *(const u32x4*)(wrow + 8);
      float wv[16];
#pragma unroll
      for (int q = 0; q < 4; ++q) { wv[2 * q] = bflo(w0[q]); wv[2 * q + 1] = bfhi(w0[q]); wv[8 + 2 * q] = bflo(w1[q]); wv[8 + 2 * q + 1] = bfhi(w1[q]); }
#pragma unroll
      for (int ci = 0; ci < 3; ++ci) {
        const float* sh = p.mod() + (ll * 3 + ci) * 3072 + lane * 16;
        float s = 0.f;
#pragma unroll
        for (int q = 0; q < 4; ++q) { const f32x4 sv = *(const f32x4*)(sh + q * 4); s += sv[0] * wv[q * 4] + sv[1] * wv[q * 4 + 1] + sv[2] * wv[q * 4 + 2] + sv[3] * wv[q * 4 + 3]; }
        s = wave_sum(s, lane);
        if (lane == 0) p.bw()[(ll * 3 + ci) * NP + n] = s;
      }
    }
  }
  for (int row = gw; row < NTOK; row += nw) {
    const float* x = (l == 0) ? (row < NCTX ? p.x_prompt + (size_t)row * 1024 : p.x_sample + (size_t)(row - NCTX) * 1024) : p.xbuf() + (size_t)row * 1024;
    f32x4 v[4];
#pragma unroll
    for (int i = 0; i < 4; ++i) v[i] = *(const f32x4*)(x + i * 256 + lane * 4);
    if (l == 0) {
      float ss = 0.f;
#pragma unroll
      for (int i = 0; i < 4; ++i) ss += v[i][0] * v[i][0] + v[i][1] * v[i][1] + v[i][2] * v[i][2] + v[i][3] * v[i][3];
      ss = wave_sum(ss, lane);
      if (lane == 0) p.ssq_x()[row] = ss;
      const int ci = row < NCTX ? 0 : 1 + ((row - NCTX) >> 10);
      const float* md = p.mod() + ci * 3072;
#pragma unroll
      for (int i = 0; i < 4; ++i) {
        const int k = i * 256 + lane * 4;
        const f32x4 gg = *(const f32x4*)(p.norm_g + k), sc = *(const f32x4*)(md + 1024 + k);
        float o[4];
#pragma unroll
        for (int j = 0; j < 4; ++j) o[j] = v[i][j] * gg[j] * (1.f + sc[j]);
        u32x2 pk = {pk2(o[0], o[1]), pk2(o[2], o[3])};
        *(u32x2*)(p.hbuf() + (size_t)row * 1024 + k) = pk;
      }
    } else {
      const float rstd = rsqrtf(p.ssq_x()[2 * NTOK + row] * (1.f / 1024.f) + EPS);
#pragma unroll
      for (int i = 0; i < 4; ++i) {
        const int k = i * 256 + lane * 4;
        const f32x4 gg = *(const f32x4*)(p.final_norm + k);
        f32x4 o;
#pragma unroll
        for (int j = 0; j < 4; ++j) o[j] = v[i][j] * rstd * gg[j];
        __builtin_nontemporal_store(o, (f32x4*)(p.out + (size_t)row * 1024 + k));
      }
    }
  }
}

template <int MB, int DEPTH, class Epi>
DI void gemm_tile(const bf16_t* __restrict__ A, int lda, const bf16_t* __restrict__ Bt, int ldb, int K, int row0, int col0, const Epi& epi, char* smem, int tid) {
  constexpr int ABYTES = MB * 32 * 128, STAGE = ABYTES + 16384;
  const int lane = tid & 63, w = tid >> 6, wr = w >> 1, wc = w & 1, fr = lane & 15, fq = lane >> 4;
  const int lrow = tid >> 3, lc8 = tid & 7, lch = lc8 >> 2, lrr = lrow & 15;
  const char* Ab = (const char*)(A + (size_t)row0 * lda);
  const char* Bb = (const char*)(Bt + (size_t)col0 * ldb);
  const unsigned voa = (unsigned)(lrow * lda + lc8 * 8) * 2u, vob = (unsigned)(lrow * ldb + lc8 * 8) * 2u;
  const int wbase = ((lrow >> 4) * 2 + lch) * 1024 + ((((lrr ^ lch) * 64) + (lc8 & 3) * 16) ^ ((lrr >> 3) << 5));
  const int rlo = (fr * 64 + fq * 16) ^ ((fr >> 3) << 5);
  u32x4 ra[DEPTH][MB], rb[DEPTH][4];
  f32x4 acc[MB][4];
#pragma unroll
  for (int m = 0; m < MB; ++m)
#pragma unroll
    for (int n = 0; n < 4; ++n) acc[m][n] = (f32x4){0.f, 0.f, 0.f, 0.f};
  const int nk = K >> 6;
#define GLOAD(S, K0)                                                                               \
  {                                                                                                \
    _Pragma("unroll") for (int ps = 0; ps < MB; ++ps) ra[S][ps] = *(const u32x4*)(Ab + ((size_t)ps * 64 * lda + (K0) * 2) + voa); \
    _Pragma("unroll") for (int ps = 0; ps < 4; ++ps) rb[S][ps] = *(const u32x4*)(Bb + ((size_t)ps * 64 * ldb + (K0) * 2) + vob);  \
    __builtin_amdgcn_sched_barrier(0);                                                             \
  }
#define SSTORE(S, BUF)                                                                             \
  {                                                                                                \
    char* sw = smem + (BUF) * STAGE + wbase;                                                       \
    _Pragma("unroll") for (int ps = 0; ps < MB; ++ps) *(u32x4*)(sw + ps * 4096) = ra[S][ps];        \
    _Pragma("unroll") for (int ps = 0; ps < 4; ++ps) *(u32x4*)(sw + ABYTES + ps * 4096) = rb[S][ps]; \
  }
#define COMPUTE(BUF)                                                                               \
  {                                                                                                \
    const char* sa = smem + (BUF) * STAGE;                                                         \
    const char* sb = sa + ABYTES;                                                                  \
    _Pragma("unroll") for (int kk = 0; kk < 2; ++kk) {                                             \
      bf16x8 af[MB], bfr[4];                                                                       \
      const int ro = kk * 1024 + (rlo ^ (kk * 64));                                                \
      _Pragma("unroll") for (int m = 0; m < MB; ++m) af[m] = *(const bf16x8*)(sa + (wr * MB + m) * 2048 + ro); \
      _Pragma("unroll") for (int n = 0; n < 4; ++n) bfr[n] = *(const bf16x8*)(sb + (wc * 4 + n) * 2048 + ro);  \
      __builtin_amdgcn_s_setprio(1);                                                               \
      _Pragma("unroll") for (int m = 0; m < MB; ++m) _Pragma("unroll") for (int n = 0; n < 4; ++n) acc[m][n] = MFMA16(bfr[n], af[m], acc[m][n]); \
      __builtin_amdgcn_s_setprio(0);                                                               \
    }                                                                                              \
  }
  if constexpr (DEPTH == 2) {
    GLOAD(0, 0);
    GLOAD(1, 64);
    SSTORE(0, 0);
    __syncthreads();
    for (int kt = 0; kt < nk; kt += 2) {
      if (kt + 2 < nk) GLOAD(0, (kt + 2) * 64);
      COMPUTE(0);
      SSTORE(1, 1);
      __syncthreads();
      if (kt + 3 < nk) GLOAD(1, (kt + 3) * 64);
      COMPUTE(1);
      if (kt + 2 < nk) SSTORE(0, 0);
      __syncthreads();
    }
  } else {
    GLOAD(0, 0);
    SSTORE(0, 0);
    __syncthreads();
    for (int kt = 0; kt < nk; kt += 2) {
      GLOAD(0, (kt + 1) * 64);
      COMPUTE(0);
      SSTORE(0, 1);
      __syncthreads();
      if (kt + 2 < nk) GLOAD(0, (kt + 2) * 64);
      COMPUTE(1);
      if (kt + 2 < nk) SSTORE(0, 0);
      __syncthreads();
    }
  }
#undef GLOAD
#undef SSTORE
#undef COMPUTE
  epi.template tile<MB>(row0 + wr * MB * 16 + fr, col0 + wc * 64, fq, acc);
}

DI void st_bf4(bf16_t* dst, const f32x4& v) {
  u32x2 o = {pk2(v[0], v[1]), pk2(v[2], v[3])};
  *(u32x2*)dst = o;
}

DI void rot4(f32x4& x0, f32x4& x1, const float* tab, int toff, int idx) {
  const f32x4 cs = *(const f32x4*)(tab + idx), sn = *(const f32x4*)(tab + toff + idx);
#pragma unroll
  for (int j = 0; j < 4; ++j) {
    const float a = x0[j], b = x1[j];
    x0[j] = a * cs[j] - b * sn[j];
    x1[j] = b * cs[j] + a * sn[j];
  }
}

struct EpiIn {
  const Params& p; int l; bool atom; bool skip;
  template <int MB> DI void tile(int rbase, int cb, int fq, f32x4 (&acc)[MB][4]) const {
    const float* bwp = p.bw() + (l * 3 + (rbase < NCTX ? 0 : 1 + ((rbase - NCTX) >> 10))) * NP + cb + fq * 4;
    f32x4 bb[4];
    float rs[MB];
#pragma unroll
    for (int n = 0; n < 4; ++n) bb[n] = *(const f32x4*)(bwp + n * 16);
#pragma unroll
    for (int m = 0; m < MB; ++m) rs[m] = p.ssq_x()[l * NTOK + rbase + m * 16];
#pragma unroll
    for (int m = 0; m < MB; ++m) {
      const float r = rsqrtf(rs[m] * (1.f / 1024.f) + EPS);
#pragma unroll
      for (int n = 0; n < 4; ++n)
#pragma unroll
        for (int j = 0; j < 4; ++j) acc[m][n][j] = acc[m][n][j] * r + bb[n][j];
      (*this)(rbase + m * 16, cb, fq, acc[m]);
    }
  }
  DI void operator()(int row, int cb, int fq, f32x4 (&v)[4]) const {
    if (skip) return;
    const bool ctx = row < NCTX;
    int b, t;
    if (ctx) { b = row >> 8; t = row & 255; } else { b = (row - NCTX) >> 10; t = (row - NCTX) & 1023; }
    const int pr = t >> 6, pc = t & 63;
    const int c4 = fq * 4;
    if (cb < 384) {
      float ss = 0.f;
#pragma unroll
      for (int n = 0; n < 4; ++n) ss += v[n][0] * v[n][0] + v[n][1] * v[n][1] + v[n][2] * v[n][2] + v[n][3] * v[n][3];
      { const int ln = fq * 16 + (row & 15); ss += shx(ss, 16, ln); ss += shx(ss, 32, ln); }
      if (cb < 256) {
        if (fq == 0 && atom) atomicAdd(p.ssq_q() + l * NTOK + row, ss);
#pragma unroll
        for (int n = 0; n < 4; ++n) st_bf4(p.cq() + (size_t)row * 256 + cb + n * 16 + c4, v[n]);
      } else {
        if (fq == 0 && atom) atomicAdd(p.ssq_kv() + l * NTOK + row, ss);
        const int c = cb - 256;
#pragma unroll
        for (int n = 0; n < 4; ++n) {
          st_bf4(p.ckvraw() + (size_t)row * 128 + c + n * 16 + c4, v[n]);
          if (ctx) *(f32x4*)(p.out + OUT_CKV + (size_t)((b * 2 + l) * 256 + t) * 128 + c + n * 16 + c4) = v[n];
        }
      }
    } else if (cb < 1152) {
      const int c = cb - 384;
#pragma unroll
      for (int n = 0; n < 4; ++n) st_bf4(p.convb() + (size_t)row * 768 + c + n * 16 + c4, v[n]);
    } else if (cb < 1664) {
      const int c = cb - 1152;
      if (!ctx) { rot4(v[0], v[1], p.ropeD(), 1024, pr * 16 + c4); rot4(v[2], v[3], p.ropeD(), 1024, pc * 16 + c4); }
#pragma unroll
      for (int n = 0; n < 4; ++n) { v[n] *= QSCALE_D; st_bf4(p.dq() + (size_t)row * 512 + c + n * 16 + c4, v[n]); }
    } else if (cb < 2176) {
      const int c = cb - 1664, h = c >> 7, a = (c >> 6) & 1;
      if (ctx) {
#pragma unroll
        for (int n = 0; n < 4; ++n) {
          __builtin_nontemporal_store(v[n], (f32x4*)(p.out + OUT_DK + (size_t)((b * 2 + l) * 256 + t) * 512 + c + n * 16 + c4));
          st_bf4(p.KdC() + (size_t)(((b * 4 + h) * 2 + a) * 256 + t) * 64 + n * 16 + c4, v[n]);
        }
      } else {
        rot4(v[0], v[1], p.ropeD(), 1024, pr * 16 + c4); rot4(v[2], v[3], p.ropeD(), 1024, pc * 16 + c4);
#pragma unroll
        for (int n = 0; n < 4; ++n) st_bf4(p.KdL() + (size_t)l * 1310720 + (size_t)(((b * 4 + h) * 2 + a) * 1280 + 256 + t) * 64 + n * 16 + c4, v[n]);
      }
    } else if (cb < 2688) {
      const int c = cb - 2176, h = c >> 7, e0 = (c & 127) + c4;
      if (ctx) {
#pragma unroll
        for (int n = 0; n < 4; ++n) {
          __builtin_nontemporal_store(v[n], (f32x4*)(p.out + OUT_DV + (size_t)((b * 2 + l) * 256 + t) * 512 + c + n * 16 + c4));
#pragma unroll
          for (int j = 0; j < 4; ++j) p.VdC()[(size_t)((b * 4 + h) * 128 + e0 + n * 16 + j) * 256 + t] = f2bf(v[n][j]);
        }
      } else {
#pragma unroll
        for (int n = 0; n < 4; ++n)
#pragma unroll
          for (int j = 0; j < 4; ++j) p.VdL()[(size_t)l * 1310720 + (size_t)((b * 4 + h) * 128 + e0 + n * 16 + j) * 1280 + 256 + t] = f2bf(v[n][j]);
      }
    } else if (cb < 3712) {
      const int c = cb - 2688;
#pragma unroll
      for (int n = 0; n < 4; ++n) {
        f32x4 s;
#pragma unroll
        for (int j = 0; j < 4; ++j) s[j] = silu_f(v[n][j]);
        st_bf4(p.zs() + (size_t)row * 1024 + c + n * 16 + c4, s);
      }
    } else if (cb == 3712) {
      const int o0 = (fq < 2) ? c4 : c4 + 8;
      if (ctx) {
        float* so = p.out + OUT_KR + (size_t)((b * 2 + l) * 256 + t) * 32 + o0;
        __builtin_nontemporal_store(v[0], (f32x4*)so);
        __builtin_nontemporal_store(v[1], (f32x4*)(so + 8));
#pragma unroll
        for (int h = 0; h < 4; ++h) {
          bf16_t* d = p.KmC() + (size_t)((b * 4 + h) * 256 + t) * 96 + 64 + o0;
          st_bf4(d, v[0]); st_bf4(d + 8, v[1]);
        }
      } else {
        if (fq < 2) rot4(v[0], v[1], p.ropeM(), 512, pr * 8 + c4); else rot4(v[0], v[1], p.ropeM(), 512, pc * 8 + c4 - 8);
#pragma unroll
        for (int h = 0; h < 4; ++h) {
          bf16_t* d = p.KmL() + (size_t)l * 983040 + (size_t)((b * 4 + h) * 1280 + 256 + t) * 96 + 64 + o0;
          st_bf4(d, v[0]); st_bf4(d + 8, v[1]);
        }
      }
    }
  }
};

struct EpiQ {
  const Params& p; int l;
  template <int MB> DI void tile(int rbase, int cb, int fq, f32x4 (&acc)[MB][4]) const {
#pragma unroll
    for (int m = 0; m < MB; ++m) (*this)(rbase + m * 16, cb, fq, acc[m]);
  }
  DI void operator()(int row, int cb, int fq, f32x4 (&v)[4]) const {
    const bool ctx = row < NCTX;
    const int t = (row - NCTX) & 1023, pr = t >> 6, pc = t & 63, c4 = fq * 4;
    const float f = rsqrtf(p.ssq_q()[l * NTOK + row] * (1.f / 256.f) + EPS) * QSCALE_M;
#pragma unroll
    for (int g = 0; g < 2; ++g) {
      const int cs = cb + 32 * g;
      v[2 * g] *= f; v[2 * g + 1] *= f;
      if (cs % 96 == 64) {
        const int o0 = (fq < 2) ? c4 : c4 + 8;
        if (!ctx) { if (fq < 2) rot4(v[2 * g], v[2 * g + 1], p.ropeM(), 512, pr * 8 + c4); else rot4(v[2 * g], v[2 * g + 1], p.ropeM(), 512, pc * 8 + c4 - 8); }
        bf16_t* d = p.qm() + (size_t)row * 384 + cs + o0;
        st_bf4(d, v[2 * g]); st_bf4(d + 8, v[2 * g + 1]);
      } else {
        bf16_t* d = p.qm() + (size_t)row * 384 + cs + c4;
        st_bf4(d, v[2 * g]); st_bf4(d + 16, v[2 * g + 1]);
      }
    }
  }
};

struct EpiKV {
  const Params& p; int l; int mode;
  template <int MB> DI void tile(int rbase, int cb, int fq, f32x4 (&acc)[MB][4]) const {
#pragma unroll
    for (int m = 0; m < MB; ++m) (*this)(rbase + m * 16, cb, fq, acc[m]);
  }
  DI void operator()(int row, int cb, int fq, f32x4 (&v)[4]) const {
    const int h = cb >> 7, c4 = fq * 4;
    const bool isV = (cb & 64) != 0;
    float f = 1.f;
    bf16_t *kd, *vd; int vstride;
    if (mode == 0) {
      f = rsqrtf(p.ssq_kv()[l * NTOK + row] * (1.f / 128.f) + EPS);
      if (row < NCTX) {
        const int b = row >> 8, t = row & 255;
        kd = p.KmC() + (size_t)((b * 4 + h) * 256 + t) * 96; vd = p.VmC() + (size_t)((b * 4 + h) * 64) * 256 + t; vstride = 256;
      } else {
        const int b = (row - NCTX) >> 10, t = (row - NCTX) & 1023;
        kd = p.KmL() + (size_t)l * 983040 + (size_t)((b * 4 + h) * 1280 + 256 + t) * 96; vd = p.VmL() + (size_t)l * 655360 + (size_t)((b * 4 + h) * 64) * 1280 + 256 + t; vstride = 1280;
      }
    } else {
      const int b = row >> 8, t = row & 255;
      kd = p.KmL() + (size_t)l * 983040 + (size_t)((b * 4 + h) * 1280 + t) * 96; vd = p.VmL() + (size_t)l * 655360 + (size_t)((b * 4 + h) * 64) * 1280 + t; vstride = 1280;
    }
#pragma unroll
    for (int n = 0; n < 4; ++n) {
      v[n] *= f;
      if (!isV) st_bf4(kd + n * 16 + c4, v[n]);
      else {
#pragma unroll
        for (int j = 0; j < 4; ++j) vd[(size_t)(n * 16 + c4 + j) * vstride] = f2bf(v[n][j]);
      }
    }
  }
};

struct EpiOut {
  const Params& p; int l;
  template <int MB> DI void tile(int rbase, int cb, int fq, f32x4 (&acc)[MB][4]) const {
    const float* gate0 = p.mod() + (l * 3) * 3072 + 2048 + cb + fq * 4;
    f32x4 xv[MB][4];
#pragma unroll
    for (int m = 0; m < MB; ++m) {
      const int row = rbase + m * 16;
      const float* xo = (l == 0) ? (row < NCTX ? p.x_prompt + (size_t)row * 1024 : p.x_sample + (size_t)(row - NCTX) * 1024) : p.xbuf() + (size_t)row * 1024;
#pragma unroll
      for (int n = 0; n < 4; ++n) xv[m][n] = *(const f32x4*)(xo + cb + n * 16 + fq * 4);
    }
    __builtin_amdgcn_sched_barrier(0);
    const int ln = fq * 16 + (rbase & 15);
#pragma unroll
    for (int m = 0; m < MB; ++m) {
      const int row = rbase + m * 16;
      const int ci = row < NCTX ? 0 : 1 + ((row - NCTX) >> 10);
      float ss = 0.f;
#pragma unroll
      for (int n = 0; n < 4; ++n) {
        const int col = cb + n * 16 + fq * 4;
        const f32x4 g = *(const f32x4*)(gate0 + ci * 3072 + n * 16);
        f32x4 o;
#pragma unroll
        for (int j = 0; j < 4; ++j) { o[j] = xv[m][n][j] + g[j] * acc[m][n][j]; ss += o[j] * o[j]; }
        *(f32x4*)(p.xbuf() + (size_t)row * 1024 + col) = o;
        if (l == 0) {
          const f32x4 gg = *(const f32x4*)(p.norm_g + 1024 + col), sc = *(const f32x4*)(p.mod() + (3 + ci) * 3072 + 1024 + col);
          u32x2 pk = {pk2(o[0] * gg[0] * (1.f + sc[0]), o[1] * gg[1] * (1.f + sc[1])), pk2(o[2] * gg[2] * (1.f + sc[2]), o[3] * gg[3] * (1.f + sc[3]))};
          *(u32x2*)(p.hbuf() + (size_t)row * 1024 + col) = pk;
        }
      }
      ss += shx(ss, 16, ln); ss += shx(ss, 32, ln);
      if (fq == 0) atomicAdd(p.ssq_x() + (l + 1) * NTOK + row, ss);
    }
  }
};

template <int MINE, int THEIRS>
DI void diff_finalize(f32x16 (&O)[4], float f, float sgn, const float* __restrict__ subln, float osc, char* smem, int w, int lane, int hh,
                      bf16_t* __restrict__ orow, const bf16_t* __restrict__ zrow, bool active) {
  float* ex = (float*)smem;
  float* sx = ex + 4 * 32 * 64;
  if (active) {
#pragma unroll
    for (int d = 0; d < 2; ++d)
#pragma unroll
      for (int i = 0; i < 16; ++i) ex[(w * 32 + d * 16 + i) * 64 + lane] = O[THEIRS + d][i] * f;
  }
  __syncthreads();
  if (!active) { __syncthreads(); return; }
  const float* pe = ex + (w ^ 1) * 32 * 64;
  float ss = 0.f;
#pragma unroll
  for (int d = 0; d < 2; ++d)
#pragma unroll
    for (int i = 0; i < 16; ++i) {
      const float mine = O[MINE + d][i] * f, theirs = pe[(d * 16 + i) * 64 + lane];
      const float o = (sgn == 0.f) ? (mine - theirs) : (theirs - mine);
      O[MINE + d][i] = o; ss += o * o;
    }
  ss += shx(ss, 32, lane);
  sx[w * 64 + lane] = ss;
  __syncthreads();
  ss += sx[(w ^ 1) * 64 + lane];
  const float rs = rsqrtf(ss * (1.f / 128.f) + EPS) * osc;
#pragma unroll
  for (int d = 0; d < 2; ++d) {
#pragma unroll
    for (int g = 0; g < 4; ++g) {
      const int d0 = (MINE + d) * 32 + g * 8 + hh * 4;
      const f32x4 sg = *(const f32x4*)(subln + d0);
      const u32x2 z = *(const u32x2*)(zrow + d0);
      u32x2 o = {pk2(O[MINE + d][4 * g] * rs * sg[0] * bflo(z[0]), O[MINE + d][4 * g + 1] * rs * sg[1] * bfhi(z[0])),
                 pk2(O[MINE + d][4 * g + 2] * rs * sg[2] * bflo(z[1]), O[MINE + d][4 * g + 3] * rs * sg[3] * bfhi(z[1]))};
      *(u32x2*)(orow + d0) = o;
    }
    __builtin_amdgcn_sched_barrier(0);
  }
}

template <int DQK, int DV, bool DIFF, bool SPLIT>
DI void attn_item(const bf16_t* __restrict__ Qp, int ldq, const bf16_t* __restrict__ Kp, const bf16_t* __restrict__ Vtp, int nkeys,
                  bf16_t* __restrict__ outp, const bf16_t* __restrict__ zsp, float lamf, const float* __restrict__ subln, float osc, char* smem, int tid,
                  int warm_n = 0, int warm_share = 0) {
  constexpr int NMAPK = DIFF ? 2 : 1;
  constexpr int KROW = (DQK + 8) * 2;
  constexpr int KMAPB = 64 * KROW;
  constexpr int VROW = 136;
  constexpr int NS = DQK / 16, NDB = DV / 32;
  constexpr int BUFB = NMAPK * KMAPB + DV * VROW;
  constexpr int NT = SPLIT ? 2 : 1;
  char* sK = smem;
  char* sV = smem + NMAPK * KMAPB;
  const int lane = tid & 63, w = tid >> 6, r = lane & 31, hh = lane >> 5;
  const int kh = SPLIT ? (w >> 1) : 0;
  const int qb = SPLIT ? (DIFF ? 0 : (w & 1)) : (DIFF ? (w >> 1) : w);
  const int am = DIFF ? (w & 1) : 0;
  bf16x8 qf[NS];
#pragma unroll
  for (int s = 0; s < NS; ++s) qf[s] = *(const bf16x8*)(Qp + (size_t)(qb * 32 + r) * ldq + am * 64 + s * 16 + hh * 8);
  f32x16 O[NDB];
  float mrun = -1e30f, lrun = 0.f;
#pragma unroll
  for (int db = 0; db < NDB; ++db)
#pragma unroll
    for (int i = 0; i < 16; ++i) O[db][i] = 0.f;
  const char* sKa = sK + am * KMAPB + r * KROW + hh * 16;
  const char* sVa = sV + r * VROW + hh * 8;
  const int nkt = nkeys >> 6, nit = SPLIT ? (nkt >> 1) : nkt;
  constexpr int KCH = 64 * DQK / 8;
  constexpr int NKC = (KCH + 255) / 256, NVC = DV * 8 / 256;
  u32x4 kreg[NT][NMAPK][NKC], vreg[NT][NVC];
#define ATT_GLOAD(J)                                                                               \
  {                                                                                                \
    _Pragma("unroll") for (int t = 0; t < NT; ++t) {                                               \
      const int tile = t * nit + (J);                                                              \
      _Pragma("unroll") for (int a = 0; a < NMAPK; ++a) {                                          \
        const bf16_t* kg = Kp + (size_t)a * nkeys * DQK + (size_t)tile * 64 * DQK;                  \
        _Pragma("unroll") for (int c = 0; c < NKC; ++c) {                                          \
          const int ch = c * 256 + tid;                                                            \
          if (KCH % 256 == 0 || ch < KCH) kreg[t][a][c] = *(const u32x4*)(kg + (size_t)ch * 8);     \
        }                                                                                          \
      }                                                                                            \
      const bf16_t* vg = Vtp + (size_t)tile * 64;                                                   \
      _Pragma("unroll") for (int c = 0; c < NVC; ++c) {                                            \
        const int ch = c * 256 + tid, d = ch >> 3, part = ch & 7;                                  \
        vreg[t][c] = *(const u32x4*)(vg + (size_t)d * nkeys + part * 8);                            \
      }                                                                                            \
    }                                                                                              \
    __builtin_amdgcn_sched_barrier(0);                                                             \
  }
#define ATT_SWRITE(BUF)                                                                            \
  {                                                                                                \
    _Pragma("unroll") for (int t = 0; t < NT; ++t) {                                               \
      char* bK = sK + (SPLIT ? t : (BUF)) * BUFB;                                                  \
      char* bV = sV + (SPLIT ? t : (BUF)) * BUFB;                                                  \
      _Pragma("unroll") for (int a = 0; a < NMAPK; ++a) _Pragma("unroll") for (int c = 0; c < NKC; ++c) { \
        const int ch = c * 256 + tid;                                                              \
        if (KCH % 256 == 0 || ch < KCH) {                                                          \
          const int key = ch / (DQK / 8), part = ch % (DQK / 8);                                   \
          *(u32x4*)(bK + a * KMAPB + key * KROW + part * 16) = kreg[t][a][c];                       \
        }                                                                                          \
      }                                                                                            \
      _Pragma("unroll") for (int c = 0; c < NVC; ++c) {                                            \
        const int ch = c * 256 + tid, d = ch >> 3, part = ch & 7;                                  \
        u32x2 lo = {vreg[t][c][0], vreg[t][c][1]}, hi = {vreg[t][c][2], vreg[t][c][3]};            \
        *(u32x2*)(bV + d * VROW + part * 16) = lo;                                                 \
        *(u32x2*)(bV + d * VROW + part * 16 + 8) = hi;                                             \
      }                                                                                            \
    }                                                                                              \
  }
  auto compute = [&](const char* sKb, const char* sVb) {
    f32x16 st[2];
#pragma unroll
    for (int kb = 0; kb < 2; ++kb) {
#pragma unroll
      for (int i = 0; i < 16; ++i) st[kb][i] = 0.f;
#pragma unroll
      for (int s = 0; s < NS; ++s) {
        const bf16x8 kf = *(const bf16x8*)(sKb + kb * 32 * KROW + s * 32);
        st[kb] = MFMA32(kf, qf[s], st[kb]);
      }
    }
    float mx = st[0][0];
#pragma unroll
    for (int i = 1; i < 16; ++i) mx = fmaxf(mx, st[0][i]);
#pragma unroll
    for (int i = 0; i < 16; ++i) mx = fmaxf(mx, st[1][i]);
    mx = fmaxf(mx, shx(mx, 32, lane));
    const float mnew = fmaxf(mrun, mx);
    const float alpha = __builtin_amdgcn_exp2f(mrun - mnew);
    mrun = mnew;
    float ls = 0.f;
#pragma unroll
    for (int kb = 0; kb < 2; ++kb)
#pragma unroll
      for (int i = 0; i < 16; ++i) { const float e = __builtin_amdgcn_exp2f(st[kb][i] - mnew); st[kb][i] = e; ls += e; }
    lrun = lrun * alpha + ls;
    if (__builtin_amdgcn_ballot_w64(alpha != 1.f) != 0) {
#pragma unroll
      for (int db = 0; db < NDB; ++db)
#pragma unroll
        for (int i = 0; i < 16; ++i) O[db][i] *= alpha;
    }
#pragma unroll
    for (int kb = 0; kb < 2; ++kb)
#pragma unroll
      for (int t2 = 0; t2 < 2; ++t2) {
        u32x4 pp;
#pragma unroll
        for (int j = 0; j < 4; ++j) pp[j] = pk2(st[kb][8 * t2 + 2 * j], st[kb][8 * t2 + 2 * j + 1]);
        const bf16x8 pf = __builtin_bit_cast(bf16x8, pp);
#pragma unroll
        for (int db = 0; db < NDB; ++db) {
          const char* vb = sVb + db * 32 * VROW + (kb * 32 + 16 * t2) * 2;
          const u32x2 lo = *(const u32x2*)vb, hi = *(const u32x2*)(vb + 16);
          const u32x4 vv = {lo[0], lo[1], hi[0], hi[1]};
          O[db] = MFMA32(__builtin_bit_cast(bf16x8, vv), pf, O[db]);
        }
        if constexpr (DIFF && SPLIT) __builtin_amdgcn_sched_barrier(0);
      }
  };
  ATT_GLOAD(0);
  unsigned w0 = 0u, w1 = 0u;
  if (warm_n > 0) {
    const int lk = (NMAPK * nkeys * DQK * 2 / 128) / warm_n, lv = (DV * nkeys * 2 / 128) / warm_n;
    if (tid < lk) w0 = *(const volatile unsigned*)((const char*)Kp + (size_t)(warm_share * lk + tid) * 128);
    if (tid < lv) w1 = *(const volatile unsigned*)((const char*)Vtp + (size_t)(warm_share * lv + tid) * 128);
  }
  if constexpr (!SPLIT) {
    __syncthreads();
    ATT_SWRITE(0);
    if (nit > 1) ATT_GLOAD(1);
    __syncthreads();
    for (int kt = 0; kt < nit; ++kt) {
      if (kt + 1 < nit) {
        ATT_SWRITE((kt + 1) & 1);
        if (kt + 2 < nit) ATT_GLOAD(kt + 2);
      }
      compute(sKa + (kt & 1) * BUFB, sVa + (kt & 1) * BUFB);
      __syncthreads();
    }
  } else {
    for (int j = 0; j < nit; ++j) {
      __syncthreads();
      ATT_SWRITE(0);
      __syncthreads();
      if (j + 1 < nit) ATT_GLOAD(j + 1);
      compute(sKa + kh * BUFB, sVa + kh * BUFB);
    }
    __syncthreads();
    float* mg = (float*)(smem + 36864);
    float* mlb = mg + 2 * NDB * 16 * 64;
    const int wl = w & 1;
    if (kh == 1) {
#pragma unroll
      for (int db = 0; db < NDB; ++db)
#pragma unroll
        for (int i = 0; i < 16; ++i) mg[((wl * NDB + db) * 16 + i) * 64 + lane] = O[db][i];
      mlb[(wl * 2 + 0) * 64 + lane] = mrun;
      mlb[(wl * 2 + 1) * 64 + lane] = lrun;
    }
    __syncthreads();
    if (kh == 0) {
      const float m1 = mlb[(wl * 2 + 0) * 64 + lane], l1 = mlb[(wl * 2 + 1) * 64 + lane];
      const float mn = fmaxf(mrun, m1);
      const float s0 = __builtin_amdgcn_exp2f(mrun - mn), s1 = __builtin_amdgcn_exp2f(m1 - mn);
      lrun = lrun * s0 + l1 * s1;
      mrun = mn;
#pragma unroll
      for (int db = 0; db < NDB; ++db)
#pragma unroll
        for (int i = 0; i < 16; ++i) O[db][i] = O[db][i] * s0 + mg[((wl * NDB + db) * 16 + i) * 64 + lane] * s1;
    }
  }
#undef ATT_GLOAD
#undef ATT_SWRITE
  const float inv = 1.f / (lrun + shx(lrun, 32, lane));
  const size_t ro = (size_t)(qb * 32 + r) * 1024;
  const bool active = (kh == 0);
  if constexpr (DIFF) {
    __syncthreads();
    if (am == 0) diff_finalize<0, 2>(O, inv, 0.f, subln, osc, smem, w, lane, hh, outp + ro, zsp + ro, active);
    else diff_finalize<2, 0>(O, inv * lamf, 1.f, subln, osc, smem, w, lane, hh, outp + ro, zsp + ro, active);
  } else {
    if (active) {
#pragma unroll
      for (int db = 0; db < NDB; ++db) {
#pragma unroll
        for (int g = 0; g < 4; ++g) {
          const int d0 = db * 32 + g * 8 + hh * 4;
          const u32x2 z = *(const u32x2*)(zsp + ro + d0);
          u32x2 o = {pk2(O[db][4 * g] * inv * bflo(z[0]), O[db][4 * g + 1] * inv * bfhi(z[0])), pk2(O[db][4 * g + 2] * inv * bflo(z[1]), O[db][4 * g + 3] * inv * bfhi(z[1]))};
          *(u32x2*)(outp + ro + d0) = o;
        }
        __builtin_amdgcn_sched_barrier(0);
      }
    }
  }
  if ((w0 ^ w1) == 0x7fc54321u && warm_n < 0) ((volatile unsigned*)smem)[0] = w0;
}

DI void conv_item(const Params& p, int l, int it, int tid) {
  const int ch = (tid & 31) * 8, rr = tid >> 5;
  float w0[8], w1[8], w2[8];
#pragma unroll
  for (int j = 0; j < 8; ++j) { w0[j] = p.conv_w[l * 768 + ch + j]; w1[j] = p.conv_w[l * 768 + 256 + ch + j]; w2[j] = p.conv_w[l * 768 + 512 + ch + j]; }
  for (int i = 0; i < 16; ++i) {
    const int row = it * 128 + i * 8 + rr;
    int t, len;
    if (row < NCTX) { t = row & 255; len = 256; } else { t = (row - NCTX) & 1023; len = 1024; }
    const bf16_t* base = p.convb() + (size_t)row * 768;
    const u32x4 zero = {0u, 0u, 0u, 0u};
    const u32x4 cbv = *(const u32x4*)(base + ch);
    const u32x4 c1 = *(const u32x4*)(base + 256 + ch), x1 = *(const u32x4*)(base + 512 + ch);
    const u32x4 c0 = t > 0 ? *(const u32x4*)(base - 768 + 256 + ch) : zero, x0 = t > 0 ? *(const u32x4*)(base - 768 + 512 + ch) : zero;
    const u32x4 c2 = t < len - 1 ? *(const u32x4*)(base + 768 + 256 + ch) : zero, x2 = t < len - 1 ? *(const u32x4*)(base + 768 + 512 + ch) : zero;
    const u32x4 zv = *(const u32x4*)(p.zs() + (size_t)row * 1024 + 256 + ch);
    u32x4 o;
#pragma unroll
    for (int q = 0; q < 4; ++q) {
      const float ylo = bflo(c0[q]) * bflo(x0[q]) * w0[2 * q] + bflo(c1[q]) * bflo(x1[q]) * w1[2 * q] + bflo(c2[q]) * bflo(x2[q]) * w2[2 * q];
      const float yhi = bfhi(c0[q]) * bfhi(x0[q]) * w0[2 * q + 1] + bfhi(c1[q]) * bfhi(x1[q]) * w1[2 * q + 1] + bfhi(c2[q]) * bfhi(x2[q]) * w2[2 * q + 1];
      o[q] = pk2(bflo(cbv[q]) * ylo * bflo(zv[q]), bfhi(cbv[q]) * yhi * bfhi(zv[q]));
    }
    *(u32x4*)(p.mix() + (size_t)row * 1024 + 256 + ch) = o;
  }
}

DI void phase_mix(const Params& p, int l, char* smem, int mask = 7) {
  const int lane = opaque_tid() & 63;
  const float* lm = p.lam + l * 256;
  const float s01 = wave_sum(lm[lane] * lm[64 + lane], lane), s23 = wave_sum(lm[128 + lane] * lm[192 + lane], lane);
  const float lam_init = (l == 0) ? 0.2f : 0.35550906759096934f;
  const float lamf = __int_as_float(__builtin_amdgcn_readfirstlane(__float_as_int(__expf(s01) - __expf(s23) + lam_init)));
  const float osc = 1.f - lam_init;
  const int bid = opaque_bid(), G = gridDim.x;
  for (int slot = 0;; ++slot) {
    int it;
    if (G == 512) {
      if (slot == 0) it = bid;
      else if (slot == 1) it = bid < 128 ? -1 : bid < 192 ? 704 + (bid - 128) : bid < 384 ? 512 + (bid - 192) : 768 + (bid - 384);
      else if (slot == 2) it = bid < 384 ? -1 : bid < 448 ? 896 + (bid - 384) : 960 + (bid - 448);
      else if (slot == 3) it = (bid >= 192 && bid < 208) ? 1024 + (bid - 192) : -1;
      else break;
      if (it < 0) continue;
    } else {
      it = slot * G + bid;
      if (it >= 1040) break;
    }
    int tid = threadIdx.x;
    asm volatile("" : "+v"(tid));
#if REP >= 40
    { const bool isdiff = it < 128 || (it >= 192 && it < 704), ismla = (it >= 128 && it < 192) || (it >= 704 && it < 960), islat = it < 192;
      if (mask == 1 && !isdiff) continue; if (mask == 2 && !ismla) continue; if (mask == 3 && !islat) continue; if (mask == 4 && !(isdiff && islat)) continue; }
#endif
    if (it < 128 || (it >= 192 && it < 704)) {
      int b, h, qt; size_t row0; const bf16_t *kp, *vp; int nk;
      if (it < 128) {
        const int x = it & 7; b = x >> 2; h = x & 3; qt = it >> 3; row0 = NCTX + b * 1024 + qt * 64; nk = 1280;
        kp = p.KdL() + (size_t)l * 1310720 + (size_t)((b * 4 + h) * 2) * 1280 * 64; vp = p.VdL() + (size_t)l * 1310720 + (size_t)((b * 4 + h) * 128) * 1280;
      } else {
        const int j = it - 192, combo = (j & 7) | ((j >> 5) << 3); b = combo >> 2; h = combo & 3; qt = (j >> 3) & 3; row0 = b * 256 + qt * 64; nk = 256;
        kp = p.KdC() + (size_t)((b * 4 + h) * 2) * 256 * 64; vp = p.VdC() + (size_t)((b * 4 + h) * 128) * 256;
      }
      attn_item<64, 128, true, false>(p.dq() + row0 * 512 + h * 128, 512, kp, vp, nk, p.mix() + row0 * 1024 + 512 + h * 128, p.zs() + row0 * 1024 + 512 + h * 128,
                                      lamf, p.subln + l * 128, osc, smem, tid, it < 128 ? 16 : 0, qt);
    } else if (it < 960) {
      int b, h, qt; size_t row0; const bf16_t *kp, *vp; int nk;
      if (it < 192) {
        const int j = it - 128, x = j & 7; b = x >> 2; h = x & 3; qt = j >> 3; row0 = NCTX + b * 1024 + qt * 128; nk = 1280;
        kp = p.KmL() + (size_t)l * 983040 + (size_t)(b * 4 + h) * 1280 * 96; vp = p.VmL() + (size_t)l * 655360 + (size_t)((b * 4 + h) * 64) * 1280;
      } else {
        const int j = it - 704, combo = (j & 7) | ((j >> 4) << 3); b = combo >> 2; h = combo & 3; qt = (j >> 3) & 1; row0 = b * 256 + qt * 128; nk = 256;
        kp = p.KmC() + (size_t)(b * 4 + h) * 256 * 96; vp = p.VmC() + (size_t)((b * 4 + h) * 64) * 256;
      }
      attn_item<96, 64, false, false>(p.qm() + row0 * 384 + h * 96, 384, kp, vp, nk, p.mix() + row0 * 1024 + h * 64, p.zs() + row0 * 1024 + h * 64, 0.f, nullptr, 1.f, smem, tid, it < 192 ? 8 : 0, qt);
    } else {
      conv_item(p, l, it - 960, tid);
    }
  }
}

DI void phase_inproj(const Params& p, int l, char* smem, bool atom = true, bool skip = false) {
  EpiIn epi{p, l, atom, skip};
  const int tid = opaque_tid(), bid = opaque_bid();
  const int xcd = bid & 7, nloc = (gridDim.x + 7 - xcd) >> 3;
  for (int j = bid >> 3; j < 300; j += nloc) {
    const int mt = xcd * 10 + j % 10, nt = j / 10;
    gemm_tile<4, 2>(p.hbuf(), 1024, p.WinT() + (size_t)l * NP * 1024, 1024, 1024, mt * 128, nt * 128, epi, smem, tid);
  }
}

DI void phase_upproj(const Params& p, int l, char* smem, bool fix = true) {
  const int tid = opaque_tid(), bid = opaque_bid();
  if (fix) {
    const float* g = p.kv_norm + l * 128;
    for (int i = bid * 256 + tid; i < NCTX * 32; i += gridDim.x * 256) {
      const int row = i >> 5, c = (i & 31) * 4, b = row >> 8, t = row & 255;
      const float f = rsqrtf(p.ssq_kv()[l * NTOK + row] * (1.f / 128.f) + EPS);
      float* d = p.out + OUT_CKV + (size_t)((b * 2 + l) * 256 + t) * 128 + c;
      f32x4 v = *(f32x4*)d;
      const f32x4 gg = *(const f32x4*)(g + c);
#pragma unroll
      for (int j = 0; j < 4; ++j) v[j] *= f * gg[j];
      *(f32x4*)d = v;
    }
  }
  EpiQ eq{p, l};
  EpiKV ek0{p, l, 0}, ek1{p, l, 1};
  for (int it = bid; it < 464; it += gridDim.x) {
    if (it < 192) {
      const int mt = it / 3, nt = it % 3;
      gemm_tile<5, 1>(p.cq(), 256, p.WuqT() + (size_t)l * 384 * 256, 256, 256, mt * 160, nt * 128, eq, smem, tid);
    } else if (it < 448) {
      const int j = it - 192, mt = j >> 2, nt = j & 3;
      gemm_tile<5, 1>(p.ckvraw(), 128, p.WukvTf() + (size_t)l * 512 * 128, 128, 128, mt * 160, nt * 128, ek0, smem, tid);
    } else {
      const int j = it - 448, mt = j >> 2, nt = j & 3;
      gemm_tile<4, 1>(p.cckv() + (size_t)l * 65536, 128, p.WukvT() + (size_t)l * 512 * 128, 128, 128, mt * 128, nt * 128, ek1, smem, tid);
    }
  }
}

DI void phase_outproj(const Params& p, int l, char* smem) {
  EpiOut epi{p, l};
  const int tid = opaque_tid(), bid = opaque_bid();
  const int xcd = bid & 7, nloc = (gridDim.x + 7 - xcd) >> 3;
  for (int j = bid >> 3; j < 64; j += nloc) {
    const int mt = xcd * 8 + (j & 7), nt = j >> 3;
    gemm_tile<5, 1>(p.mix(), 1024, p.WoutT() + (size_t)l * 1024 * 1024, 1024, 1024, mt * 160, nt * 128, epi, smem, tid);
  }
}

__global__ void __launch_bounds__(256, 2) fwd_megakernel(Params p) {
  __shared__ __attribute__((aligned(16))) char smem[73728];
  __shared__ __attribute__((aligned(16))) unsigned xb_words[4];
  cg::grid_group grid = cg::this_grid();
  if (p.ws == nullptr) grid.sync();
  if (threadIdx.x == 0) { xb_words[0] = 0u; xb_words[1] = 0u; xb_words[2] = 0u; xb_words[3] = 0u; }
  __syncthreads();
  const XcdBarrier xb = xcd_barrier_post(p.bar(), (volatile LAS unsigned*)xb_words);
#define GSYNC() xcd_barrier(xb)
  phase0(p, smem);
#if REP == 0
  GSYNC(); phase0(p, smem);
#endif
#pragma unroll
  for (int l = 0; l < 2; ++l) {
    GSYNC();
    if (l == 0) { phase_norm(p, 0); GSYNC(); }
#if REP == 2
    phase_inproj(p, l, smem, false); GSYNC();
#endif
#if REP == 7
    phase_inproj(p, l, smem, false, p.ws != nullptr); GSYNC();
#endif
    phase_inproj(p, l, smem);
    GSYNC();
#if REP == 3
    phase_upproj(p, l, smem, false); GSYNC();
#endif
    phase_upproj(p, l, smem);
    GSYNC();
#if REP == 4
    phase_mix(p, l, smem); GSYNC();
#endif
#if REP >= 40
    phase_mix(p, l, smem, REP - 40); GSYNC();
#endif
    phase_mix(p, l, smem);
    GSYNC();
#if REP == 5
    if (l == 0) { phase_outproj(p, l, smem); GSYNC(); }
#endif
    phase_outproj(p, l, smem);
  }
  GSYNC();
  phase_norm(p, 2);
#if REP == 6
  for (int i = 0; i < 10; ++i) GSYNC();
#endif
}

extern "C" void kernel_launch(void* const* d_in, const int* in_sizes, int n_in, void* d_out, int out_size, void* d_ws, size_t ws_size, hipStream_t stream) {
  static int grid_blocks = 0;
  if (!grid_blocks) {
    int dev = 0, cus = 0, per_cu = 0;
    hipGetDevice(&dev);
    hipDeviceGetAttribute(&cus, hipDeviceAttributeMultiprocessorCount, dev);
    hipOccupancyMaxActiveBlocksPerMultiprocessor(&per_cu, fwd_megakernel, 256, 0);
    if (per_cu > 2) per_cu = 2;
    if (per_cu < 1) per_cu = 1;
    grid_blocks = cus * per_cu;
  }
  Params p{};
  p.x_prompt = (const float*)d_in[0]; p.x_sample = (const float*)d_in[1]; p.c = (const float*)d_in[2];
  p.cache_ckv = (const float*)d_in[3]; p.cache_krope = (const float*)d_in[4]; p.cache_dk = (const float*)d_in[5]; p.cache_dv = (const float*)d_in[6];
  p.c_ctx = (const float*)d_in[7]; p.norm_g = (const float*)d_in[8]; p.ada_w = (const float*)d_in[9]; p.ada_b = (const float*)d_in[10];
  p.w_in = (const float*)d_in[11]; p.q_norm = (const float*)d_in[12]; p.w_uq = (const float*)d_in[13]; p.kv_norm = (const float*)d_in[14];
  p.w_ukv = (const float*)d_in[15]; p.conv_w = (const float*)d_in[16]; p.lam = (const float*)d_in[17]; p.subln = (const float*)d_in[18];
  p.w_out = (const float*)d_in[19]; p.final_norm = (const float*)d_in[20];
  p.out = (float*)d_out;
  p.ws = (char*)d_ws;
  if (ws_size < WS_TOTAL) fprintf(stderr, "workspace too small\n");
  hipMemsetAsync(d_ws, 0, OFF_WinT, stream);
  void* args[] = {&p};
  hipError_t e = hipLaunchCooperativeKernel((void*)fwd_megakernel, dim3(grid_blocks), dim3(256), args, 0, stream);
  if (e != hipSuccess) fprintf(stderr, "cooperative launch failed: %s (grid %d)\n", hipGetErrorString(e), grid_blocks);
}
```

```cpp
#include <hip/hip_runtime.h>
#include <hip/hip_cooperative_groups.h>
#include <cstdio>
namespace cg = cooperative_groups;

typedef unsigned short bf16_t;
typedef short bf16x8 __attribute__((ext_vector_type(8)));
typedef float f32x2 __attribute__((ext_vector_type(2)));
typedef float f32x4 __attribute__((ext_vector_type(4)));
typedef float f32x16 __attribute__((ext_vector_type(16)));
typedef unsigned u32x2 __attribute__((ext_vector_type(2)));
typedef unsigned u32x4 __attribute__((ext_vector_type(4)));
typedef __bf16 bf16x2_t __attribute__((ext_vector_type(2)));

#ifndef REP
#define REP -1
#endif
#define DI __device__ __forceinline__
#define MFMA16(a, b, c) __builtin_amdgcn_mfma_f32_16x16x32_bf16((a), (b), (c), 0, 0, 0)
#define MFMA32(a, b, c) __builtin_amdgcn_mfma_f32_32x32x16_bf16((a), (b), (c), 0, 0, 0)

#define XCD_BAR_WORDS 3456
constexpr int NCTX = 8192, NTOK = 10240, NP = 3840;
constexpr float EPS = 1e-6f;
constexpr float QSCALE_M = 0.14724444602590306f;
constexpr float QSCALE_D = 0.18033688011112042f;
constexpr size_t OUT_CKV = 10485760, OUT_KR = 12582912, OUT_DK = 13107200, OUT_DV = 21495808;

__constant__ float INV16[16] = {1.000000000e+00f, 5.623413324e-01f, 3.162277639e-01f, 1.778279394e-01f, 1.000000015e-01f, 5.623413250e-02f, 3.162277490e-02f, 1.778279431e-02f,
                                9.999999776e-03f, 5.623413250e-03f, 3.162277630e-03f, 1.778279431e-03f, 1.000000047e-03f, 5.623413017e-04f, 3.162277571e-04f, 1.778279402e-04f};
__constant__ float INV8[8] = {1.000000000e+00f, 3.162277639e-01f, 1.000000015e-01f, 3.162277490e-02f, 9.999999776e-03f, 3.162277630e-03f, 1.000000047e-03f, 3.162277571e-04f};

constexpr size_t al256(size_t x) { return (x + 255) & ~(size_t)255; }
constexpr size_t OFF_bar = 0;
constexpr size_t OFF_mod = OFF_bar + al256(XCD_BAR_WORDS * 4);
constexpr size_t OFF_WinT = OFF_mod + al256((size_t)2 * 3 * 3072 * 4);
constexpr size_t OFF_WoutT = OFF_WinT + al256((size_t)2 * NP * 1024 * 2);
constexpr size_t OFF_WuqT = OFF_WoutT + al256((size_t)2 * 1024 * 1024 * 2);
constexpr size_t OFF_WukvTf = OFF_WuqT + al256((size_t)2 * 384 * 256 * 2);
constexpr size_t OFF_WukvT = OFF_WukvTf + al256((size_t)2 * 512 * 128 * 2);
constexpr size_t OFF_ssq_q = OFF_WukvT + al256((size_t)2 * 512 * 128 * 2);
constexpr size_t OFF_ssq_kv = OFF_ssq_q + al256((size_t)2 * NTOK * 4);
constexpr size_t OFF_ssq_x = OFF_ssq_kv + al256((size_t)2 * NTOK * 4);
constexpr size_t OFF_bw = OFF_ssq_x + al256((size_t)3 * NTOK * 4);
constexpr size_t OFF_ropeD = OFF_bw + al256((size_t)2 * 3 * NP * 4);
constexpr size_t OFF_ropeM = OFF_ropeD + al256(2048 * 4);
constexpr size_t OFF_wq = OFF_ropeM + al256(1024 * 4);
constexpr size_t OFF_hbuf = OFF_wq + al256(256);
constexpr size_t OFF_cq = OFF_hbuf + al256((size_t)NTOK * 1024 * 2);
constexpr size_t OFF_ckvraw = OFF_cq + al256((size_t)NTOK * 256 * 2);
constexpr size_t OFF_cckv = OFF_ckvraw + al256((size_t)NTOK * 128 * 2);
constexpr size_t OFF_convb = OFF_cckv + al256((size_t)2 * 512 * 128 * 2);
constexpr size_t OFF_dq = OFF_convb + al256((size_t)NTOK * 768 * 2);
constexpr size_t OFF_zs = OFF_dq + al256((size_t)NTOK * 512 * 2);
constexpr size_t OFF_qm = OFF_zs + al256((size_t)NTOK * 1024 * 2);
constexpr size_t OFF_KmC = OFF_qm + al256((size_t)NTOK * 384 * 2);
constexpr size_t OFF_KmL = OFF_KmC + al256((size_t)32 * 4 * 256 * 96 * 2);
constexpr size_t OFF_VmC = OFF_KmL + al256((size_t)2 * 983040 * 2);
constexpr size_t OFF_VmL = OFF_VmC + al256((size_t)32 * 4 * 64 * 256 * 2);
constexpr size_t OFF_KdC = OFF_VmL + al256((size_t)2 * 655360 * 2);
constexpr size_t OFF_KdL = OFF_KdC + al256((size_t)32 * 4 * 2 * 256 * 64 * 2);
constexpr size_t OFF_VdC = OFF_KdL + al256((size_t)2 * 1310720 * 2);
constexpr size_t OFF_VdL = OFF_VdC + al256((size_t)32 * 4 * 128 * 256 * 2);
constexpr size_t OFF_mix = OFF_VdL + al256((size_t)2 * 1310720 * 2);
constexpr size_t OFF_xbuf = OFF_mix + al256((size_t)NTOK * 1024 * 2);
constexpr size_t WS_TOTAL = OFF_xbuf + al256((size_t)NTOK * 1024 * 4);

struct Params {
  const float *x_prompt, *x_sample, *c, *cache_ckv, *cache_krope, *cache_dk, *cache_dv, *c_ctx;
  const float *norm_g, *ada_w, *ada_b, *w_in, *q_norm, *w_uq, *kv_norm, *w_ukv, *conv_w, *lam, *subln, *w_out, *final_norm;
  float* out;
  char* ws;
  DI unsigned* bar() const { return (unsigned*)(ws + OFF_bar); }
  DI bf16_t* WinT() const { return (bf16_t*)(ws + OFF_WinT); }
  DI bf16_t* WoutT() const { return (bf16_t*)(ws + OFF_WoutT); }
  DI bf16_t* WuqT() const { return (bf16_t*)(ws + OFF_WuqT); }
  DI bf16_t* WukvTf() const { return (bf16_t*)(ws + OFF_WukvTf); }
  DI bf16_t* WukvT() const { return (bf16_t*)(ws + OFF_WukvT); }
  DI float* mod() const { return (float*)(ws + OFF_mod); }
  DI float* ssq_q() const { return (float*)(ws + OFF_ssq_q); }
  DI float* ssq_kv() const { return (float*)(ws + OFF_ssq_kv); }
  DI float* ssq_x() const { return (float*)(ws + OFF_ssq_x); }
  DI float* bw() const { return (float*)(ws + OFF_bw); }
  DI float* ropeD() const { return (float*)(ws + OFF_ropeD); }
  DI float* ropeM() const { return (float*)(ws + OFF_ropeM); }
  DI int* wq() const { return (int*)(ws + OFF_wq); }
  DI bf16_t* hbuf() const { return (bf16_t*)(ws + OFF_hbuf); }
  DI bf16_t* cq() const { return (bf16_t*)(ws + OFF_cq); }
  DI bf16_t* ckvraw() const { return (bf16_t*)(ws + OFF_ckvraw); }
  DI bf16_t* cckv() const { return (bf16_t*)(ws + OFF_cckv); }
  DI bf16_t* convb() const { return (bf16_t*)(ws + OFF_convb); }
  DI bf16_t* dq() const { return (bf16_t*)(ws + OFF_dq); }
  DI bf16_t* zs() const { return (bf16_t*)(ws + OFF_zs); }
  DI bf16_t* qm() const { return (bf16_t*)(ws + OFF_qm); }
  DI bf16_t* KmC() const { return (bf16_t*)(ws + OFF_KmC); }
  DI bf16_t* KmL() const { return (bf16_t*)(ws + OFF_KmL); }
  DI bf16_t* VmC() const { return (bf16_t*)(ws + OFF_VmC); }
  DI bf16_t* VmL() const { return (bf16_t*)(ws + OFF_VmL); }
  DI bf16_t* KdC() const { return (bf16_t*)(ws + OFF_KdC); }
  DI bf16_t* KdL() const { return (bf16_t*)(ws + OFF_KdL); }
  DI bf16_t* VdC() const { return (bf16_t*)(ws + OFF_VdC); }
  DI bf16_t* VdL() const { return (bf16_t*)(ws + OFF_VdL); }
  DI bf16_t* mix() const { return (bf16_t*)(ws + OFF_mix); }
  DI float* xbuf() const { return (float*)(ws + OFF_xbuf); }
};

DI unsigned pk2(float a, float b) {
  f32x2 v = {a, b};
  bf16x2_t r = __builtin_convertvector(v, bf16x2_t);
  return __builtin_bit_cast(unsigned, r);
}
DI float bflo(unsigned u) { return __uint_as_float(u << 16); }
DI float bfhi(unsigned u) { return __uint_as_float(u & 0xffff0000u); }
DI bf16_t f2bf(float a) { return (bf16_t)(pk2(a, 0.f) & 0xffffu); }
DI float shx(float v, int o, int lane) { return __int_as_float(__builtin_amdgcn_ds_bpermute((lane ^ o) << 2, __float_as_int(v))); }
DI float wave_sum(float v, int lane) {
#pragma unroll
  for (int o = 32; o >= 1; o >>= 1) v += shx(v, o, lane);
  return v;
}
DI int opaque_tid() { int t = threadIdx.x; asm volatile("" : "+v"(t)); return t; }
DI int opaque_bid() { int b = blockIdx.x; asm volatile("" : "+s"(b)); return b; }
DI int rope_perm(int P) { return (P & 7) | ((P & 8) << 1) | ((P & 16) >> 1); }


#define XB_TMO      128
#define XB_XCNT(j)  (256  + 64 * (j))
#define XB_XSUB(j)  (1280 + 64 * (j))
#define XB_XGEN(j)  (2304 + 64 * (j))
#define XB_TOP      3328
#define XB_TOPGEN   3392
#define XB_SPIN_CAP (1u << 18)
DI unsigned xb_ld(unsigned* p)              { return __hip_atomic_load(p, __ATOMIC_RELAXED, __HIP_MEMORY_SCOPE_AGENT); }
DI unsigned xb_add(unsigned* p, unsigned v) { return __hip_atomic_fetch_add(p, v, __ATOMIC_RELAXED, __HIP_MEMORY_SCOPE_AGENT); }
DI unsigned xb_xcc_id() { return (unsigned)__builtin_amdgcn_s_getreg((3 << 11) | 20) & 0xFu; }
#define XB_SPIN(cond, bar) do { unsigned _sp = 0; while (cond) { __builtin_amdgcn_s_sleep(1); \
    if ((++_sp & 255u) == 0u) { if (xb_ld(&(bar)[XB_TMO])) break; if (_sp > XB_SPIN_CAP) { atomicAdd(&(bar)[XB_TMO], 1u); break; } } } } while (0)
#define LAS __attribute__((address_space(3)))
struct XcdBarrier { unsigned* bar; unsigned x; volatile LAS unsigned* st; };
DI XcdBarrier xcd_barrier_post(unsigned* bar, volatile LAS unsigned* st) {
  XcdBarrier b; b.bar = bar; b.x = xb_xcc_id(); b.st = st;
  if (threadIdx.x == 0) (void)xb_add(&bar[XB_XCNT(b.x)], 1u);
  return b;
}
DI void xcd_barrier_complete(unsigned* bar, unsigned x, unsigned& nloc, unsigned& nx) {
  const unsigned G = gridDim.x * gridDim.y * gridDim.z;
  unsigned sum, cnt, mine, sp = 0u;
  for (;;) {
    sum = 0u; cnt = 0u; mine = 0u;
#pragma unroll
    for (unsigned j = 0; j < 16; ++j) { const unsigned c = xb_ld(&bar[XB_XCNT(j)]); sum += c; cnt += (c > 0u) ? 1u : 0u; mine = (j == x) ? c : mine; }
    if (sum == G) break;
    __builtin_amdgcn_s_sleep(1);
    if ((++sp & 255u) == 0u) { if (xb_ld(&bar[XB_TMO])) break; if (sp > XB_SPIN_CAP) { atomicAdd(&bar[XB_TMO], 1u); break; } }
  }
  nloc = mine > 0u ? mine : 1u; nx = cnt > 0u ? cnt : 1u;
}
DI void xcd_barrier(const XcdBarrier& b) {
  asm volatile("s_waitcnt vmcnt(0)" ::: "memory");
  __syncthreads();
  if (threadIdx.x == 0) {
    unsigned* bar = b.bar;
    __builtin_amdgcn_s_waitcnt(0);
    unsigned nloc = b.st[0], nx = b.st[1];
    if (nloc == 0u) { xcd_barrier_complete(bar, b.x, nloc, nx); b.st[0] = nloc; b.st[1] = nx; }
    const unsigned old = xb_add(&bar[XB_XSUB(b.x)], 1u);
    const unsigned gen = old / nloc;
    if (old + 1u == (gen + 1u) * nloc) {
      __builtin_amdgcn_fence(__ATOMIC_RELEASE, "agent");
      asm volatile("s_waitcnt vmcnt(0)" ::: "memory");
      const unsigned og = xb_add(&bar[XB_TOP], 1u);
      const unsigned tg = og / nx;
      if (og + 1u == (tg + 1u) * nx) xb_add(&bar[XB_TOPGEN], 1u);
      else XB_SPIN(xb_ld(&bar[XB_TOPGEN]) == tg, bar);
      __builtin_amdgcn_fence(__ATOMIC_ACQUIRE, "agent");
      xb_add(&bar[XB_XGEN(b.x)], 1u);
      asm volatile("s_waitcnt vmcnt(0)" ::: "memory");
    } else {
      XB_SPIN(xb_ld(&bar[XB_XGEN(b.x)]) == gen, bar);
      __builtin_amdgcn_fence(__ATOMIC_ACQUIRE, "agent");
      asm volatile("s_waitcnt vmcnt(0)" ::: "memory");
    }
  }
  __syncthreads();
}

struct ColMapIn { DI int operator()(int n) const { if (n < 384) return n; if (n < 3712) return n + 32; if (n < 3744) return 384 + rope_perm(n - 3712); return -1; } };
struct ColMapId { DI int operator()(int n) const { return n; } };
struct ColMapUq { DI int operator()(int n) const { int h = n / 96, c = n - h * 96; if (c >= 64) c = 64 + rope_perm(c - 64); return h * 96 + c; } };

template <class CM>
DI void tconv_tile(const float* __restrict__ src, int ldsrc, bf16_t* __restrict__ dst, int K, int n0, int k0, const float* __restrict__ kscale, CM cm, float* sm, int tid) {
  const int tq = tid & 15, ty = tid >> 4;
  const int sc = cm(n0 + tq * 4);
  f32x4 v[4];
#pragma unroll
  for (int i = 0; i < 4; ++i) {
    const int kk = ty + i * 16;
    v[i] = (f32x4){0.f, 0.f, 0.f, 0.f};
    if (sc >= 0) v[i] = *(const f32x4*)(src + (size_t)(k0 + kk) * ldsrc + sc);
  }
#pragma unroll
  for (int i = 0; i < 4; ++i) {
    const int kk = ty + i * 16;
    const float s = kscale ? kscale[k0 + kk] : 1.f;
#pragma unroll
    for (int j = 0; j < 4; ++j) sm[kk * 65 + tq * 4 + j] = v[i][j] * s;
  }
  __syncthreads();
  const int kc = tid & 7, nn = tid >> 3;
#pragma unroll
  for (int ps = 0; ps < 2; ++ps) {
    const int n = nn + ps * 32;
    u32x4 o;
#pragma unroll
    for (int i = 0; i < 4; ++i) o[i] = pk2(sm[(kc * 8 + 2 * i) * 65 + n], sm[(kc * 8 + 2 * i + 1) * 65 + n]);
    *(u32x4*)(dst + (size_t)(n0 + n) * K + k0 + kc * 8) = o;
  }
  __syncthreads();
}

DI float silu_f(float x) { return x * __builtin_amdgcn_rcpf(1.f + __expf(-x)); }

DI void mod_item(const Params& p, int it, float* sm, int tid) {
  const int l = it / 192, r = it % 192, cg = r >> 4, kc = r & 15;
  const int c4 = tid & 63, rg = tid >> 6;
  const int k0 = kc * 64 + rg * 16;
  const float* W = p.ada_w + (size_t)l * 1024 * 3072 + (size_t)k0 * 3072 + cg * 256 + c4 * 4;
  f32x4 w[16];
#pragma unroll
  for (int i = 0; i < 16; ++i) w[i] = __builtin_nontemporal_load((const f32x4*)(W + (size_t)i * 3072));
  float a0[4] = {0, 0, 0, 0}, a1[4] = {0, 0, 0, 0}, a2[4] = {0, 0, 0, 0};
#pragma unroll
  for (int i = 0; i < 16; ++i) {
    const int k = k0 + i;
    const float s0 = silu_f(p.c_ctx[k]), s1 = silu_f(p.c[k]), s2 = silu_f(p.c[1024 + k]);
#pragma unroll
    for (int j = 0; j < 4; ++j) { a0[j] += s0 * w[i][j]; a1[j] += s1 * w[i][j]; a2[j] += s2 * w[i][j]; }
  }
#pragma unroll
  for (int j = 0; j < 4; ++j) {
    sm[(rg * 3 + 0) * 256 + c4 * 4 + j] = a0[j];
    sm[(rg * 3 + 1) * 256 + c4 * 4 + j] = a1[j];
    sm[(rg * 3 + 2) * 256 + c4 * 4 + j] = a2[j];
  }
  __syncthreads();
#pragma unroll
  for (int ci = 0; ci < 3; ++ci) {
    float s = sm[(0 * 3 + ci) * 256 + tid] + sm[(1 * 3 + ci) * 256 + tid] + sm[(2 * 3 + ci) * 256 + tid] + sm[(3 * 3 + ci) * 256 + tid];
    const int col = cg * 256 + tid;
    if (kc == 0) s += p.ada_b[l * 3072 + col];
    atomicAdd(p.mod() + (l * 3 + ci) * 3072 + col, s);
  }
  __syncthreads();
}

DI void sincos_d(float ang, float& c, float& s) {
  const double TWO_PI = 6.283185307179586476925286766559;
  double x = (double)ang;
  x = x - TWO_PI * rint(x / TWO_PI);
  const double x2 = x * x;
  double ts = 1.0, tc = 1.0;
#pragma unroll
  for (int k = 12; k >= 1; --k) {
    ts = 1.0 - ts * x2 / (double)((2 * k) * (2 * k + 1));
    tc = 1.0 - tc * x2 / (double)((2 * k - 1) * (2 * k));
  }
  s = (float)(x * ts);
  c = (float)tc;
}

struct TcDesc { const float* src; bf16_t* dst; const float* kscale; int ld, K, n0, k0, sc; };
DI void tc_decode(const Params& p, int it, int tid, TcDesc& d) {
  const int tq = tid & 15;
  if (it < 1920) {
    const int l = it / 960, r = it % 960;
    d.src = p.w_in + (size_t)l * 1024 * 3744; d.ld = 3744; d.dst = p.WinT() + (size_t)l * NP * 1024; d.K = 1024; d.n0 = (r % 60) * 64; d.k0 = (r / 60) * 64; d.kscale = nullptr;
    d.sc = ColMapIn()(d.n0 + tq * 4);
  } else if (it < 2432) {
    const int j = it - 1920, l = j / 256, r = j % 256;
    d.src = p.w_out + (size_t)l * 1024 * 1024; d.ld = 1024; d.dst = p.WoutT() + (size_t)l * 1024 * 1024; d.K = 1024; d.n0 = (r % 16) * 64; d.k0 = (r / 16) * 64; d.kscale = nullptr;
    d.sc = d.n0 + tq * 4;
  } else if (it < 2480) {
    const int j = it - 2432, l = j / 24, r = j % 24;
    d.src = p.w_uq + (size_t)l * 256 * 384; d.ld = 384; d.dst = p.WuqT() + (size_t)l * 384 * 256; d.K = 256; d.n0 = (r % 6) * 64; d.k0 = (r / 6) * 64; d.kscale = p.q_norm + l * 256;
    d.sc = ColMapUq()(d.n0 + tq * 4);
  } else {
    const int j = (it - 2480) & 31, l = j / 16, r = j % 16;
    const bool folded = it < 2512;
    d.src = p.w_ukv + (size_t)l * 128 * 512; d.ld = 512; d.dst = (folded ? p.WukvTf() : p.WukvT()) + (size_t)l * 512 * 128; d.K = 128; d.n0 = (r % 8) * 64; d.k0 = (r / 8) * 64;
    d.kscale = folded ? p.kv_norm + l * 128 : nullptr;
    d.sc = d.n0 + tq * 4;
  }
}
DI void tc_load(const TcDesc& d, int tid, f32x4 (&v)[4]) {
  const int ty = tid >> 4;
#pragma unroll
  for (int i = 0; i < 4; ++i) {
    v[i] = (f32x4){0.f, 0.f, 0.f, 0.f};
    if (d.sc >= 0) v[i] = __builtin_nontemporal_load((const f32x4*)(d.src + (size_t)(d.k0 + ty + i * 16) * d.ld + d.sc));
  }
  __builtin_amdgcn_sched_barrier(0);
}
DI void tc_finish(const TcDesc& d, int tid, f32x4 (&v)[4], float* sm) {
  const int tq = tid & 15, ty = tid >> 4;
#pragma unroll
  for (int i = 0; i < 4; ++i) {
    const int kk = ty + i * 16;
    const float s = d.kscale ? d.kscale[d.k0 + kk] : 1.f;
#pragma unroll
    for (int j = 0; j < 4; ++j) sm[kk * 65 + tq * 4 + j] = v[i][j] * s;
  }
  __syncthreads();
  const int kc = tid & 7, nn = tid >> 3;
#pragma unroll
  for (int ps = 0; ps < 2; ++ps) {
    const int n = nn + ps * 32;
    u32x4 o;
#pragma unroll
    for (int i = 0; i < 4; ++i) o[i] = pk2(sm[(kc * 8 + 2 * i) * 65 + n], sm[(kc * 8 + 2 * i + 1) * 65 + n]);
    *(u32x4*)(d.dst + (size_t)(d.n0 + n) * d.K + d.k0 + kc * 8) = o;
  }
  __syncthreads();
}

DI void phase0(const Params& p, char* smem) {
  float* sm = (float*)smem;
  const int tid = opaque_tid(), bid = opaque_bid();
  const int G = gridDim.x;
  for (int it = bid; it < 384; it += G) mod_item(p, it, sm, tid);
  {
    TcDesc da, db;
    f32x4 va[4], vb[4];
    int it = bid;
    bool ha = it < 2544;
    if (ha) { tc_decode(p, it, tid, da); tc_load(da, tid, va); }
    while (ha) {
      const int itb = it + G;
      const bool hb = itb < 2544;
      if (hb) { tc_decode(p, itb, tid, db); tc_load(db, tid, vb); }
      tc_finish(da, tid, va, sm);
      if (!hb) break;
      it = itb + G;
      ha = it < 2544;
      if (ha) { tc_decode(p, it, tid, da); tc_load(da, tid, va); }
      tc_finish(db, tid, vb, sm);
    }
  }
  const int gstride = gridDim.x * 256, g0 = bid * 256 + tid;
  for (int i0 = g0; i0 < 524288; i0 += 4 * gstride) {
    float v[4];
#pragma unroll
    for (int u = 0; u < 4; ++u) {
      const int i = i0 + u * gstride;
      if (i < 524288) { const int cc = i & 511, t = (i >> 9) & 255, b = (i >> 17) & 1, l = i >> 18; v[u] = __builtin_nontemporal_load(p.cache_dk + (size_t)((b * 2 + l) * 256 + t) * 512 + cc); }
    }
#pragma unroll
    for (int u = 0; u < 4; ++u) {
      const int i = i0 + u * gstride;
      if (i < 524288) {
        const int cc = i & 511, t = (i >> 9) & 255, b = (i >> 17) & 1, l = i >> 18, h = cc >> 7, a = (cc >> 6) & 1, d = cc & 63;
        p.KdL()[(size_t)l * 1310720 + (size_t)(((b * 4 + h) * 2 + a) * 1280 + t) * 64 + d] = f2bf(v[u]);
      }
    }
  }
  for (int i0 = g0; i0 < 524288; i0 += 4 * gstride) {
    float v[4];
#pragma unroll
    for (int u = 0; u < 4; ++u) {
      const int j = i0 + u * gstride;
      if (j < 524288) { const int t = j & 255, e = (j >> 8) & 127, h = (j >> 15) & 3, b = (j >> 17) & 1, l = j >> 18; v[u] = p.cache_dv[(size_t)((b * 2 + l) * 256 + t) * 512 + h * 128 + e]; }
    }
#pragma unroll
    for (int u = 0; u < 4; ++u) {
      const int j = i0 + u * gstride;
      if (j < 524288) { const int t = j & 255, e = (j >> 8) & 127, h = (j >> 15) & 3, b = (j >> 17) & 1, l = j >> 18; p.VdL()[(size_t)l * 1310720 + (size_t)((b * 4 + h) * 128 + e) * 1280 + t] = f2bf(v[u]); }
    }
  }
  const int E2 = 131072, E3 = E2 + 131072, E4 = E3 + 1536, E5 = E4 + 40960 + 30720;
  for (int i = g0; i < E5; i += gstride) {
    if (i < E2) {
      const int j = i;
      const int r = j & 31, h = (j >> 5) & 3, t = (j >> 7) & 255, b = (j >> 15) & 1, l = j >> 16;
      p.KmL()[(size_t)l * 983040 + (size_t)((b * 4 + h) * 1280 + t) * 96 + 64 + r] = f2bf(p.cache_krope[(size_t)((b * 2 + l) * 256 + t) * 32 + r]);
    } else if (i < E3) {
      const int j = i - E2;
      const int cc = j & 127, t = (j >> 7) & 255, b = (j >> 15) & 1, l = j >> 16;
      p.cckv()[(size_t)l * 65536 + (b * 256 + t) * 128 + cc] = f2bf(p.cache_ckv[(size_t)((b * 2 + l) * 256 + t) * 128 + cc]);
    } else if (i < E4) {
      const int j = i - E3;
      float cs, sn;
      if (j < 1024) {
        const int pos = j >> 4, f = j & 15;
        sincos_d((float)pos * INV16[f], cs, sn);
        p.ropeD()[j] = cs; p.ropeD()[1024 + j] = sn;
      } else {
        const int jj = j - 1024, pos = jj >> 3, f = jj & 7;
        sincos_d((float)pos * INV8[f], cs, sn);
        p.ropeM()[jj] = cs; p.ropeM()[512 + jj] = sn;
      }
    } else {
      const int j = i - E4;
      if (j < 20480) p.ssq_q()[j] = 0.f; else if (j < 40960) p.ssq_kv()[j - 20480] = 0.f; else p.ssq_x()[j - 40960] = 0.f;
      if (j < 64) p.wq()[j] = 0;
    }
  }
}

DI void phase_norm(const Params& p, int l) {
  const int tid = opaque_tid(), bid = opaque_bid();
  const int lane = tid & 63;
  const int gw = bid * 4 + (tid >> 6), nw = gridDim.x * 4;
  if (l == 0) {
    for (int it = gw; it < 2 * NP; it += nw) {
      const int ll = it / NP, n = it % NP;
      const bf16_t* wrow = p.WinT() + ((size_t)ll * NP + n) * 1024 + lane * 16;
      const u32x4 w0 = *(const u32x4*)wrow, w1 = *(const u32x4*)(wrow + 8);
      float wv[16];
#pragma unroll
      for (int q = 0; q < 4; ++q) { wv[2 * q] = bflo(w0[q]); wv[2 * q + 1] = bfhi(w0[q]); wv[8 + 2 * q] = bflo(w1[q]); wv[8 + 2 * q + 1] = bfhi(w1[q]); }
#pragma unroll
      for (int ci = 0; ci < 3; ++ci) {
        const float* sh = p.mod() + (ll * 3 + ci) * 3072 + lane * 16;
        float s = 0.f;
#pragma unroll
        for (int q = 0; q < 4; ++q) { const f32x4 sv = *(const f32x4*)(sh + q * 4); s += sv[0] * wv[q * 4] + sv[1] * wv[q * 4 + 1] + sv[2] * wv[q * 4 + 2] + sv[3] * wv[q * 4 + 3]; }
        s = wave_sum(s, lane);
        if (lane == 0) p.bw()[(ll * 3 + ci) * NP + n] = s;
      }
    }
  }
  for (int row = gw; row < NTOK; row += nw) {
    const float* x = (l == 0) ? (row < NCTX ? p.x_prompt + (size_t)row * 1024 : p.x_sample + (size_t)(row - NCTX) * 1024) : p.xbuf() + (size_t)row * 1024;
    f32x4 v[4];
#pragma unroll
    for (int i = 0; i < 4; ++i) v[i] = *(const f32x4*)(x + i * 256 + lane * 4);
    if (l == 0) {
      float ss = 0.f;
#pragma unroll
      for (int i = 0; i < 4; ++i) ss += v[i][0] * v[i][0] + v[i][1] * v[i][1] + v[i][2] * v[i][2] + v[i][3] * v[i][3];
      ss = wave_sum(ss, lane);
      if (lane == 0) p.ssq_x()[row] = ss;
      const int ci = row < NCTX ? 0 : 1 + ((row - NCTX) >> 10);
      const float* md = p.mod() + ci * 3072;
#pragma unroll
      for (int i = 0; i < 4; ++i) {
        const int k = i * 256 + lane * 4;
        const f32x4 gg = *(const f32x4*)(p.norm_g + k), sc = *(const f32x4*)(md + 1024 + k);
        float o[4];
#pragma unroll
        for (int j = 0; j < 4; ++j) o[j] = v[i][j] * gg[j] * (1.f + sc[j]);
        u32x2 pk = {pk2(o[0], o[1]), pk2(o[2], o[3])};
        *(u32x2*)(p.hbuf() + (size_t)row * 1024 + k) = pk;
      }
    } else {
      const float rstd = rsqrtf(p.ssq_x()[2 * NTOK + row] * (1.f / 1024.f) + EPS);
#pragma unroll
      for (int i = 0; i < 4; ++i) {
        const int k = i * 256 + lane * 4;
        const f32x4 gg = *(const f32x4*)(p.final_norm + k);
        f32x4 o;
#pragma unroll
        for (int j = 0; j < 4; ++j) o[j] = v[i][j] * rstd * gg[j];
        __builtin_nontemporal_store(o, (f32x4*)(p.out + (size_t)row * 1024 + k));
      }
    }
  }
}

template <int MB, int DEPTH, class Epi>
DI void gemm_tile(const bf16_t* __restrict__ A, int lda, const bf16_t* __restrict__ Bt, int ldb, int K, int row0, int col0, const Epi& epi, char* smem, int tid) {
  constexpr int ABYTES = MB * 32 * 128, STAGE = ABYTES + 16384;
  const int lane = tid & 63, w = tid >> 6, wr = w >> 1, wc = w & 1, fr = lane & 15, fq = lane >> 4;
  const int lrow = tid >> 3, lc8 = tid & 7, lch = lc8 >> 2, lrr = lrow & 15;
  const char* Ab = (const char*)(A + (size_t)row0 * lda);
  const char* Bb = (const char*)(Bt + (size_t)col0 * ldb);
  const unsigned voa = (unsigned)(lrow * lda + lc8 * 8) * 2u, vob = (unsigned)(lrow * ldb + lc8 * 8) * 2u;
  const int wbase = ((lrow >> 4) * 2 + lch) * 1024 + ((((lrr ^ lch) * 64) + (lc8 & 3) * 16) ^ ((lrr >> 3) << 5));
  const int rlo = (fr * 64 + fq * 16) ^ ((fr >> 3) << 5);
  u32x4 ra[DEPTH][MB], rb[DEPTH][4];
  f32x4 acc[MB][4];
#pragma unroll
  for (int m = 0; m < MB; ++m)
#pragma unroll
    for (int n = 0; n < 4; ++n) acc[m][n] = (f32x4){0.f, 0.f, 0.f, 0.f};
  const int nk = K >> 6;
#define GLOAD(S, K0)                                                                               \
  {                                                                                                \
    _Pragma("unroll") for (int ps = 0; ps < MB; ++ps) ra[S][ps] = *(const u32x4*)(Ab + ((size_t)ps * 64 * lda + (K0) * 2) + voa); \
    _Pragma("unroll") for (int ps = 0; ps < 4; ++ps) rb[S][ps] = *(const u32x4*)(Bb + ((size_t)ps * 64 * ldb + (K0) * 2) + vob);  \
    __builtin_amdgcn_sched_barrier(0);                                                             \
  }
#define SSTORE(S, BUF)                                                                             \
  {                                                                                                \
    char* sw = smem + (BUF) * STAGE + wbase;                                                       \
    _Pragma("unroll") for (int ps = 0; ps < MB; ++ps) *(u32x4*)(sw + ps * 4096) = ra[S][ps];        \
    _Pragma("unroll") for (int ps = 0; ps < 4; ++ps) *(u32x4*)(sw + ABYTES + ps * 4096) = rb[S][ps]; \
  }
#define COMPUTE(BUF)                                                                               \
  {                                                                                                \
    const char* sa = smem + (BUF) * STAGE;                                                         \
    const char* sb = sa + ABYTES;                                                                  \
    _Pragma("unroll") for (int kk = 0; kk < 2; ++kk) {                                             \
      bf16x8 af[MB], bfr[4];                                                                       \
      const int ro = kk * 1024 + (rlo ^ (kk * 64));                                                \
      _Pragma("unroll") for (int m = 0; m < MB; ++m) af[m] = *(const bf16x8*)(sa + (wr * MB + m) * 2048 + ro); \
      _Pragma("unroll") for (int n = 0; n < 4; ++n) bfr[n] = *(const bf16x8*)(sb + (wc * 4 + n) * 2048 + ro);  \
      __builtin_amdgcn_s_setprio(1);                                                               \
      _Pragma("unroll") for (int m = 0; m < MB; ++m) _Pragma("unroll") for (int n = 0; n < 4; ++n) acc[m][n] = MFMA16(bfr[n], af[m], acc[m][n]); \
      __builtin_amdgcn_s_setprio(0);                                                               \
    }                                                                                              \
  }
  if constexpr (DEPTH == 2) {
    GLOAD(0, 0);
    GLOAD(1, 64);
    SSTORE(0, 0);
    __syncthreads();
    for (int kt = 0; kt < nk; kt += 2) {
      if (kt + 2 < nk) GLOAD(0, (kt + 2) * 64);
      COMPUTE(0);
      SSTORE(1, 1);
      __syncthreads();
      if (kt + 3 < nk) GLOAD(1, (kt + 3) * 64);
      COMPUTE(1);
      if (kt + 2 < nk) SSTORE(0, 0);
      __syncthreads();
    }
  } else {
    GLOAD(0, 0);
    SSTORE(0, 0);
    __syncthreads();
    for (int kt = 0; kt < nk; kt += 2) {
      GLOAD(0, (kt + 1) * 64);
      COMPUTE(0);
      SSTORE(0, 1);
      __syncthreads();
      if (kt + 2 < nk) GLOAD(0, (kt + 2) * 64);
      COMPUTE(1);
      if (kt + 2 < nk) SSTORE(0, 0);
      __syncthreads();
    }
  }
#undef GLOAD
#undef SSTORE
#undef COMPUTE
  epi.template tile<MB>(row0 + wr * MB * 16 + fr, col0 + wc * 64, fq, acc);
}

DI void st_bf4(bf16_t* dst, const f32x4& v) {
  u32x2 o = {pk2(v[0], v[1]), pk2(v[2], v[3])};
  *(u32x2*)dst = o;
}

DI void rot4(f32x4& x0, f32x4& x1, const float* tab, int toff, int idx) {
  const f32x4 cs = *(const f32x4*)(tab + idx), sn = *(const f32x4*)(tab + toff + idx);
#pragma unroll
  for (int j = 0; j < 4; ++j) {
    const float a = x0[j], b = x1[j];
    x0[j] = a * cs[j] - b * sn[j];
    x1[j] = b * cs[j] + a * sn[j];
  }
}

struct EpiIn {
  const Params& p; int l; bool atom; bool skip;
  template <int MB> DI void tile(int rbase, int cb, int fq, f32x4 (&acc)[MB][4]) const {
    const float* bwp = p.bw() + (l * 3 + (rbase < NCTX ? 0 : 1 + ((rbase - NCTX) >> 10))) * NP + cb + fq * 4;
    f32x4 bb[4];
    float rs[MB];
#pragma unroll
    for (int n = 0; n < 4; ++n) bb[n] = *(const f32x4*)(bwp + n * 16);
#pragma unroll
    for (int m = 0; m < MB; ++m) rs[m] = p.ssq_x()[l * NTOK + rbase + m * 16];
#pragma unroll
    for (int m = 0; m < MB; ++m) {
      const float r = rsqrtf(rs[m] * (1.f / 1024.f) + EPS);
#pragma unroll
      for (int n = 0; n < 4; ++n)
#pragma unroll
        for (int j = 0; j < 4; ++j) acc[m][n][j] = acc[m][n][j] * r + bb[n][j];
      (*this)(rbase + m * 16, cb, fq, acc[m]);
    }
  }
  DI void operator()(int row, int cb, int fq, f32x4 (&v)[4]) const {
    if (skip) return;
    const bool ctx = row < NCTX;
    int b, t;
    if (ctx) { b = row >> 8; t = row & 255; } else { b = (row - NCTX) >> 10; t = (row - NCTX) & 1023; }
    const int pr = t >> 6, pc = t & 63;
    const int c4 = fq * 4;
    if (cb < 384) {
      float ss = 0.f;
#pragma unroll
      for (int n = 0; n < 4; ++n) ss += v[n][0] * v[n][0] + v[n][1] * v[n][1] + v[n][2] * v[n][2] + v[n][3] * v[n][3];
      { const int ln = fq * 16 + (row & 15); ss += shx(ss, 16, ln); ss += shx(ss, 32, ln); }
      if (cb < 256) {
        if (fq == 0 && atom) atomicAdd(p.ssq_q() + l * NTOK + row, ss);
#pragma unroll
        for (int n = 0; n < 4; ++n) st_bf4(p.cq() + (size_t)row * 256 + cb + n * 16 + c4, v[n]);
      } else {
        if (fq == 0 && atom) atomicAdd(p.ssq_kv() + l * NTOK + row, ss);
        const int c = cb - 256;
#pragma unroll
        for (int n = 0; n < 4; ++n) {
          st_bf4(p.ckvraw() + (size_t)row * 128 + c + n * 16 + c4, v[n]);
          if (ctx) *(f32x4*)(p.out + OUT_CKV + (size_t)((b * 2 + l) * 256 + t) * 128 + c + n * 16 + c4) = v[n];
        }
      }
    } else if (cb < 1152) {
      const int c = cb - 384;
#pragma unroll
      for (int n = 0; n < 4; ++n) st_bf4(p.convb() + (size_t)row * 768 + c + n * 16 + c4, v[n]);
    } else if (cb < 1664) {
      const int c = cb - 1152;
      if (!ctx) { rot4(v[0], v[1], p.ropeD(), 1024, pr * 16 + c4); rot4(v[2], v[3], p.ropeD(), 1024, pc * 16 + c4); }
#pragma unroll
      for (int n = 0; n < 4; ++n) { v[n] *= QSCALE_D; st_bf4(p.dq() + (size_t)row * 512 + c + n * 16 + c4, v[n]); }
    } else if (cb < 2176) {
      const int c = cb - 1664, h = c >> 7, a = (c >> 6) & 1;
      if (ctx) {
#pragma unroll
        for (int n = 0; n < 4; ++n) {
          __builtin_nontemporal_store(v[n], (f32x4*)(p.out + OUT_DK + (size_t)((b * 2 + l) * 256 + t) * 512 + c + n * 16 + c4));
          st_bf4(p.KdC() + (size_t)(((b * 4 + h) * 2 + a) * 256 + t) * 64 + n * 16 + c4, v[n]);
        }
      } else {
        rot4(v[0], v[1], p.ropeD(), 1024, pr * 16 + c4); rot4(v[2], v[3], p.ropeD(), 1024, pc * 16 + c4);
#pragma unroll
        for (int n = 0; n < 4; ++n) st_bf4(p.KdL() + (size_t)l * 1310720 + (size_t)(((b * 4 + h) * 2 + a) * 1280 + 256 + t) * 64 + n * 16 + c4, v[n]);
      }
    } else if (cb < 2688) {
      const int c = cb - 2176, h = c >> 7, e0 = (c & 127) + c4;
      if (ctx) {
#pragma unroll
        for (int n = 0; n < 4; ++n) {
          __builtin_nontemporal_store(v[n], (f32x4*)(p.out + OUT_DV + (size_t)((b * 2 + l) * 256 + t) * 512 + c + n * 16 + c4));
#pragma unroll
          for (int j = 0; j < 4; ++j) p.VdC()[(size_t)((b * 4 + h) * 128 + e0 + n * 16 + j) * 256 + t] = f2bf(v[n][j]);
        }
      } else {
#pragma unroll
        for (int n = 0; n < 4; ++n)
#pragma unroll
          for (int j = 0; j < 4; ++j) p.VdL()[(size_t)l * 1310720 + (size_t)((b * 4 + h) * 128 + e0 + n * 16 + j) * 1280 + 256 + t] = f2bf(v[n][j]);
      }
    } else if (cb < 3712) {
      const int c = cb - 2688;
#pragma unroll
      for (int n = 0; n < 4; ++n) {
        f32x4 s;
#pragma unroll
        for (int j = 0; j < 4; ++j) s[j] = silu_f(v[n][j]);
        st_bf4(p.zs() + (size_t)row * 1024 + c + n * 16 + c4, s);
      }
    } else if (cb == 3712) {
      const int o0 = (fq < 2) ? c4 : c4 + 8;
      if (ctx) {
        float* so = p.out + OUT_KR + (size_t)((b * 2 + l) * 256 + t) * 32 + o0;
        __builtin_nontemporal_store(v[0], (f32x4*)so);
        __builtin_nontemporal_store(v[1], (f32x4*)(so + 8));
#pragma unroll
        for (int h = 0; h < 4; ++h) {
          bf16_t* d = p.KmC() + (size_t)((b * 4 + h) * 256 + t) * 96 + 64 + o0;
          st_bf4(d, v[0]); st_bf4(d + 8, v[1]);
        }
      } else {
        if (fq < 2) rot4(v[0], v[1], p.ropeM(), 512, pr * 8 + c4); else rot4(v[0], v[1], p.ropeM(), 512, pc * 8 + c4 - 8);
#pragma unroll
        for (int h = 0; h < 4; ++h) {
          bf16_t* d = p.KmL() + (size_t)l * 983040 + (size_t)((b * 4 + h) * 1280 + 256 + t) * 96 + 64 + o0;
          st_bf4(d, v[0]); st_bf4(d + 8, v[1]);
        }
      }
    }
  }
};

struct EpiQ {
  const Params& p; int l;
  template <int MB> DI void tile(int rbase, int cb, int fq, f32x4 (&acc)[MB][4]) const {
#pragma unroll
    for (int m = 0; m < MB; ++m) (*this)(rbase + m * 16, cb, fq, acc[m]);
  }
  DI void operator()(int row, int cb, int fq, f32x4 (&v)[4]) const {
    const bool ctx = row < NCTX;
    const int t = (row - NCTX) & 1023, pr = t >> 6, pc = t & 63, c4 = fq * 4;
    const float f = rsqrtf(p.ssq_q()[l * NTOK + row] * (1.f / 256.f) + EPS) * QSCALE_M;
#pragma unroll
    for (int g = 0; g < 2; ++g) {
      const int cs = cb + 32 * g;
      v[2 * g] *= f; v[2 * g + 1] *= f;
      if (cs % 96 == 64) {
        const int o0 = (fq < 2) ? c4 : c4 + 8;
        if (!ctx) { if (fq < 2) rot4(v[2 * g], v[2 * g + 1], p.ropeM(), 512, pr * 8 + c4); else rot4(v[2 * g], v[2 * g + 1], p.ropeM(), 512, pc * 8 + c4 - 8); }
        bf16_t* d = p.qm() + (size_t)row * 384 + cs + o0;
        st_bf4(d, v[2 * g]); st_bf4(d + 8, v[2 * g + 1]);
      } else {
        bf16_t* d = p.qm() + (size_t)row * 384 + cs + c4;
        st_bf4(d, v[2 * g]); st_bf4(d + 16, v[2 * g + 1]);
      }
    }
  }
};

struct EpiKV {
  const Params& p; int l; int mode;
  template <int MB> DI void tile(int rbase, int cb, int fq, f32x4 (&acc)[MB][4]) const {
#pragma unroll
    for (int m = 0; m < MB; ++m) (*this)(rbase + m * 16, cb, fq, acc[m]);
  }
  DI void operator()(int row, int cb, int fq, f32x4 (&v)[4]) const {
    const int h = cb >> 7, c4 = fq * 4;
    const bool isV = (cb & 64) != 0;
    float f = 1.f;
    bf16_t *kd, *vd; int vstride;
    if (mode == 0) {
      f = rsqrtf(p.ssq_kv()[l * NTOK + row] * (1.f / 128.f) + EPS);
      if (row < NCTX) {
        const int b = row >> 8, t = row & 255;
        kd = p.KmC() + (size_t)((b * 4 + h) * 256 + t) * 96; vd = p.VmC() + (size_t)((b * 4 + h) * 64) * 256 + t; vstride = 256;
      } else {
        const int b = (row - NCTX) >> 10, t = (row - NCTX) & 1023;
        kd = p.KmL() + (size_t)l * 983040 + (size_t)((b * 4 + h) * 1280 + 256 + t) * 96; vd = p.VmL() + (size_t)l * 655360 + (size_t)((b * 4 + h) * 64) * 1280 + 256 + t; vstride = 1280;
      }
    } else {
      const int b = row >> 8, t = row & 255;
      kd = p.KmL() + (size_t)l * 983040 + (size_t)((b * 4 + h) * 1280 + t) * 96; vd = p.VmL() + (size_t)l * 655360 + (size_t)((b * 4 + h) * 64) * 1280 + t; vstride = 1280;
    }
#pragma unroll
    for (int n = 0; n < 4; ++n) {
      v[n] *= f;
      if (!isV) st_bf4(kd + n * 16 + c4, v[n]);
      else {
#pragma unroll
        for (int j = 0; j < 4; ++j) vd[(size_t)(n * 16 + c4 + j) * vstride] = f2bf(v[n][j]);
      }
    }
  }
};

struct EpiOut {
  const Params& p; int l;
  template <int MB> DI void tile(int rbase, int cb, int fq, f32x4 (&acc)[MB][4]) const {
    const float* gate0 = p.mod() + (l * 3) * 3072 + 2048 + cb + fq * 4;
    f32x4 xv[MB][4];
#pragma unroll
    for (int m = 0; m < MB; ++m) {
      const int row = rbase + m * 16;
      const float* xo = (l == 0) ? (row < NCTX ? p.x_prompt + (size_t)row * 1024 : p.x_sample + (size_t)(row - NCTX) * 1024) : p.xbuf() + (size_t)row * 1024;
#pragma unroll
      for (int n = 0; n < 4; ++n) xv[m][n] = __builtin_nontemporal_load((const f32x4*)(xo + cb + n * 16 + fq * 4));
    }
    __builtin_amdgcn_sched_barrier(0);
    const int ln = fq * 16 + (rbase & 15);
#pragma unroll
    for (int m = 0; m < MB; ++m) {
      const int row = rbase + m * 16;
      const int ci = row < NCTX ? 0 : 1 + ((row - NCTX) >> 10);
      float ss = 0.f;
#pragma unroll
      for (int n = 0; n < 4; ++n) {
        const int col = cb + n * 16 + fq * 4;
        const f32x4 g = *(const f32x4*)(gate0 + ci * 3072 + n * 16);
        f32x4 o;
#pragma unroll
        for (int j = 0; j < 4; ++j) { o[j] = xv[m][n][j] + g[j] * acc[m][n][j]; ss += o[j] * o[j]; }
        *(f32x4*)(p.xbuf() + (size_t)row * 1024 + col) = o;
        if (l == 0) {
          const f32x4 gg = *(const f32x4*)(p.norm_g + 1024 + col), sc = *(const f32x4*)(p.mod() + (3 + ci) * 3072 + 1024 + col);
          u32x2 pk = {pk2(o[0] * gg[0] * (1.f + sc[0]), o[1] * gg[1] * (1.f + sc[1])), pk2(o[2] * gg[2] * (1.f + sc[2]), o[3] * gg[3] * (1.f + sc[3]))};
          *(u32x2*)(p.hbuf() + (size_t)row * 1024 + col) = pk;
        }
      }
      ss += shx(ss, 16, ln); ss += shx(ss, 32, ln);
      if (fq == 0) atomicAdd(p.ssq_x() + (l + 1) * NTOK + row, ss);
    }
  }
};

template <int MINE, int THEIRS>
DI void diff_finalize(f32x16 (&O)[4], float f, float sgn, const float* __restrict__ subln, float osc, char* smem, int w, int lane, int hh,
                      bf16_t* __restrict__ orow, const bf16_t* __restrict__ zrow, bool active) {
  float* ex = (float*)smem;
  float* sx = ex + 4 * 32 * 64;
  if (active) {
#pragma unroll
    for (int d = 0; d < 2; ++d)
#pragma unroll
      for (int i = 0; i < 16; ++i) ex[(w * 32 + d * 16 + i) * 64 + lane] = O[THEIRS + d][i] * f;
  }
  __syncthreads();
  if (!active) { __syncthreads(); return; }
  const float* pe = ex + (w ^ 1) * 32 * 64;
  float ss = 0.f;
#pragma unroll
  for (int d = 0; d < 2; ++d)
#pragma unroll
    for (int i = 0; i < 16; ++i) {
      const float mine = O[MINE + d][i] * f, theirs = pe[(d * 16 + i) * 64 + lane];
      const float o = (sgn == 0.f) ? (mine - theirs) : (theirs - mine);
      O[MINE + d][i] = o; ss += o * o;
    }
  ss += shx(ss, 32, lane);
  sx[w * 64 + lane] = ss;
  __syncthreads();
  ss += sx[(w ^ 1) * 64 + lane];
  const float rs = rsqrtf(ss * (1.f / 128.f) + EPS) * osc;
#pragma unroll
  for (int d = 0; d < 2; ++d) {
#pragma unroll
    for (int g = 0; g < 4; ++g) {
      const int d0 = (MINE + d) * 32 + g * 8 + hh * 4;
      const f32x4 sg = *(const f32x4*)(subln + d0);
      const u32x2 z = *(const u32x2*)(zrow + d0);
      u32x2 o = {pk2(O[MINE + d][4 * g] * rs * sg[0] * bflo(z[0]), O[MINE + d][4 * g + 1] * rs * sg[1] * bfhi(z[0])),
                 pk2(O[MINE + d][4 * g + 2] * rs * sg[2] * bflo(z[1]), O[MINE + d][4 * g + 3] * rs * sg[3] * bfhi(z[1]))};
      *(u32x2*)(orow + d0) = o;
    }
    __builtin_amdgcn_sched_barrier(0);
  }
}

template <int DQK, int DV, bool DIFF, bool SPLIT>
DI void attn_item(const bf16_t* __restrict__ Qp, int ldq, const bf16_t* __restrict__ Kp, const bf16_t* __restrict__ Vtp, int nkeys,
                  bf16_t* __restrict__ outp, const bf16_t* __restrict__ zsp, float lamf, const float* __restrict__ subln, float osc, char* smem, int tid,
                  int warm_n = 0, int warm_share = 0) {
  constexpr int NMAPK = DIFF ? 2 : 1;
  constexpr int KROW = (DQK + 8) * 2;
  constexpr int KMAPB = 64 * KROW;
  constexpr int VROW = 136;
  constexpr int NS = DQK / 16, NDB = DV / 32;
  constexpr int BUFB = NMAPK * KMAPB + DV * VROW;
  constexpr int NT = SPLIT ? 2 : 1;
  char* sK = smem;
  char* sV = smem + NMAPK * KMAPB;
  const int lane = tid & 63, w = tid >> 6, r = lane & 31, hh = lane >> 5;
  const int kh = SPLIT ? (w >> 1) : 0;
  const int qb = SPLIT ? (DIFF ? 0 : (w & 1)) : (DIFF ? (w >> 1) : w);
  const int am = DIFF ? (w & 1) : 0;
  bf16x8 qf[NS];
#pragma unroll
  for (int s = 0; s < NS; ++s) qf[s] = *(const bf16x8*)(Qp + (size_t)(qb * 32 + r) * ldq + am * 64 + s * 16 + hh * 8);
  f32x16 O[NDB];
  float mrun = -1e30f, lrun = 0.f;
#pragma unroll
  for (int db = 0; db < NDB; ++db)
#pragma unroll
    for (int i = 0; i < 16; ++i) O[db][i] = 0.f;
  const char* sKa = sK + am * KMAPB + r * KROW + hh * 16;
  const char* sVa = sV + r * VROW + hh * 8;
  const int nkt = nkeys >> 6, nit = SPLIT ? (nkt >> 1) : nkt;
  constexpr int KCH = 64 * DQK / 8;
  constexpr int NKC = (KCH + 255) / 256, NVC = DV * 8 / 256;
  u32x4 kreg[NT][NMAPK][NKC], vreg[NT][NVC];
#define ATT_GLOAD(J)                                                                               \
  {                                                                                                \
    _Pragma("unroll") for (int t = 0; t < NT; ++t) {                                               \
      const int tile = t * nit + (J);                                                              \
      _Pragma("unroll") for (int a = 0; a < NMAPK; ++a) {                                          \
        const bf16_t* kg = Kp + (size_t)a * nkeys * DQK + (size_t)tile * 64 * DQK;                  \
        _Pragma("unroll") for (int c = 0; c < NKC; ++c) {                                          \
          const int ch = c * 256 + tid;                                                            \
          if (KCH % 256 == 0 || ch < KCH) kreg[t][a][c] = *(const u32x4*)(kg + (size_t)ch * 8);     \
        }                                                                                          \
      }                                                                                            \
      const bf16_t* vg = Vtp + (size_t)tile * 64;                                                   \
      _Pragma("unroll") for (int c = 0; c < NVC; ++c) {                                            \
        const int ch = c * 256 + tid, d = ch >> 3, part = ch & 7;                                  \
        vreg[t][c] = *(const u32x4*)(vg + (size_t)d * nkeys + part * 8);                            \
      }                                                                                            \
    }                                                                                              \
    __builtin_amdgcn_sched_barrier(0);                                                             \
  }
#define ATT_SWRITE(BUF)                                                                            \
  {                                                                                                \
    _Pragma("unroll") for (int t = 0; t < NT; ++t) {                                               \
      char* bK = sK + (SPLIT ? t : (BUF)) * BUFB;                                                  \
      char* bV = sV + (SPLIT ? t : (BUF)) * BUFB;                                                  \
      _Pragma("unroll") for (int a = 0; a < NMAPK; ++a) _Pragma("unroll") for (int c = 0; c < NKC; ++c) { \
        const int ch = c * 256 + tid;                                                              \
        if (KCH % 256 == 0 || ch < KCH) {                                                          \
          const int key = ch / (DQK / 8), part = ch % (DQK / 8);                                   \
          *(u32x4*)(bK + a * KMAPB + key * KROW + part * 16) = kreg[t][a][c];                       \
        }                                                                                          \
      }                                                                                            \
      _Pragma("unroll") for (int c = 0; c < NVC; ++c) {                                            \
        const int ch = c * 256 + tid, d = ch >> 3, part = ch & 7;                                  \
        u32x2 lo = {vreg[t][c][0], vreg[t][c][1]}, hi = {vreg[t][c][2], vreg[t][c][3]};            \
        *(u32x2*)(bV + d * VROW + part * 16) = lo;                                                 \
        *(u32x2*)(bV + d * VROW + part * 16 + 8) = hi;                                             \
      }                                                                                            \
    }                                                                                              \
  }
  auto compute = [&](const char* sKb, const char* sVb) {
    f32x16 st[2];
#pragma unroll
    for (int kb = 0; kb < 2; ++kb) {
#pragma unroll
      for (int i = 0; i < 16; ++i) st[kb][i] = 0.f;
#pragma unroll
      for (int s = 0; s < NS; ++s) {
        const bf16x8 kf = *(const bf16x8*)(sKb + kb * 32 * KROW + s * 32);
        st[kb] = MFMA32(kf, qf[s], st[kb]);
      }
    }
    float mx = st[0][0];
#pragma unroll
    for (int i = 1; i < 16; ++i) mx = fmaxf(mx, st[0][i]);
#pragma unroll
    for (int i = 0; i < 16; ++i) mx = fmaxf(mx, st[1][i]);
    mx = fmaxf(mx, shx(mx, 32, lane));
    const float mnew = fmaxf(mrun, mx);
    const float alpha = __builtin_amdgcn_exp2f(mrun - mnew);
    mrun = mnew;
    float ls = 0.f;
#pragma unroll
    for (int kb = 0; kb < 2; ++kb)
#pragma unroll
      for (int i = 0; i < 16; ++i) { const float e = __builtin_amdgcn_exp2f(st[kb][i] - mnew); st[kb][i] = e; ls += e; }
    lrun = lrun * alpha + ls;
    if (__builtin_amdgcn_ballot_w64(alpha != 1.f) != 0) {
#pragma unroll
      for (int db = 0; db < NDB; ++db)
#pragma unroll
        for (int i = 0; i < 16; ++i) O[db][i] *= alpha;
    }
#pragma unroll
    for (int kb = 0; kb < 2; ++kb)
#pragma unroll
      for (int t2 = 0; t2 < 2; ++t2) {
        u32x4 pp;
#pragma unroll
        for (int j = 0; j < 4; ++j) pp[j] = pk2(st[kb][8 * t2 + 2 * j], st[kb][8 * t2 + 2 * j + 1]);
        const bf16x8 pf = __builtin_bit_cast(bf16x8, pp);
#pragma unroll
        for (int db = 0; db < NDB; ++db) {
          const char* vb = sVb + db * 32 * VROW + (kb * 32 + 16 * t2) * 2;
          const u32x2 lo = *(const u32x2*)vb, hi = *(const u32x2*)(vb + 16);
          const u32x4 vv = {lo[0], lo[1], hi[0], hi[1]};
          O[db] = MFMA32(__builtin_bit_cast(bf16x8, vv), pf, O[db]);
        }
        if constexpr (DIFF && SPLIT) __builtin_amdgcn_sched_barrier(0);
      }
  };
  ATT_GLOAD(0);
  unsigned w0 = 0u, w1 = 0u;
  if (warm_n > 0) {
    const int lk = (NMAPK * nkeys * DQK * 2 / 128) / warm_n, lv = (DV * nkeys * 2 / 128) / warm_n;
    if (tid < lk) w0 = *(const volatile unsigned*)((const char*)Kp + (size_t)(warm_share * lk + tid) * 128);
    if (tid < lv) w1 = *(const volatile unsigned*)((const char*)Vtp + (size_t)(warm_share * lv + tid) * 128);
  }
  if constexpr (!SPLIT) {
    __syncthreads();
    ATT_SWRITE(0);
    if (nit > 1) ATT_GLOAD(1);
    __syncthreads();
    for (int kt = 0; kt < nit; ++kt) {
      if (kt + 1 < nit) {
        ATT_SWRITE((kt + 1) & 1);
        if (kt + 2 < nit) ATT_GLOAD(kt + 2);
      }
      compute(sKa + (kt & 1) * BUFB, sVa + (kt & 1) * BUFB);
      __syncthreads();
    }
  } else {
    for (int j = 0; j < nit; ++j) {
      __syncthreads();
      ATT_SWRITE(0);
      __syncthreads();
      if (j + 1 < nit) ATT_GLOAD(j + 1);
      compute(sKa + kh * BUFB, sVa + kh * BUFB);
    }
    __syncthreads();
    float* mg = (float*)(smem + 36864);
    float* mlb = mg + 2 * NDB * 16 * 64;
    const int wl = w & 1;
    if (kh == 1) {
#pragma unroll
      for (int db = 0; db < NDB; ++db)
#pragma unroll
        for (int i = 0; i < 16; ++i) mg[((wl * NDB + db) * 16 + i) * 64 + lane] = O[db][i];
      mlb[(wl * 2 + 0) * 64 + lane] = mrun;
      mlb[(wl * 2 + 1) * 64 + lane] = lrun;
    }
    __syncthreads();
    if (kh == 0) {
      const float m1 = mlb[(wl * 2 + 0) * 64 + lane], l1 = mlb[(wl * 2 + 1) * 64 + lane];
      const float mn = fmaxf(mrun, m1);
      const float s0 = __builtin_amdgcn_exp2f(mrun - mn), s1 = __builtin_amdgcn_exp2f(m1 - mn);
      lrun = lrun * s0 + l1 * s1;
      mrun = mn;
#pragma unroll
      for (int db = 0; db < NDB; ++db)
#pragma unroll
        for (int i = 0; i < 16; ++i) O[db][i] = O[db][i] * s0 + mg[((wl * NDB + db) * 16 + i) * 64 + lane] * s1;
    }
  }
#undef ATT_GLOAD
#undef ATT_SWRITE
  const float inv = 1.f / (lrun + shx(lrun, 32, lane));
  const size_t ro = (size_t)(qb * 32 + r) * 1024;
  const bool active = (kh == 0);
  if constexpr (DIFF) {
    __syncthreads();
    if (am == 0) diff_finalize<0, 2>(O, inv, 0.f, subln, osc, smem, w, lane, hh, outp + ro, zsp + ro, active);
    else diff_finalize<2, 0>(O, inv * lamf, 1.f, subln, osc, smem, w, lane, hh, outp + ro, zsp + ro, active);
  } else {
    if (active) {
#pragma unroll
      for (int db = 0; db < NDB; ++db) {
#pragma unroll
        for (int g = 0; g < 4; ++g) {
          const int d0 = db * 32 + g * 8 + hh * 4;
          const u32x2 z = *(const u32x2*)(zsp + ro + d0);
          u32x2 o = {pk2(O[db][4 * g] * inv * bflo(z[0]), O[db][4 * g + 1] * inv * bfhi(z[0])), pk2(O[db][4 * g + 2] * inv * bflo(z[1]), O[db][4 * g + 3] * inv * bfhi(z[1]))};
          *(u32x2*)(outp + ro + d0) = o;
        }
        __builtin_amdgcn_sched_barrier(0);
      }
    }
  }
  if ((w0 ^ w1) == 0x7fc54321u && warm_n < 0) ((volatile unsigned*)smem)[0] = w0;
}

DI void conv_item(const Params& p, int l, int it, int tid) {
  const int ch = (tid & 31) * 8, rr = tid >> 5;
  float w0[8], w1[8], w2[8];
#pragma unroll
  for (int j = 0; j < 8; ++j) { w0[j] = p.conv_w[l * 768 + ch + j]; w1[j] = p.conv_w[l * 768 + 256 + ch + j]; w2[j] = p.conv_w[l * 768 + 512 + ch + j]; }
  for (int i = 0; i < 16; ++i) {
    const int row = it * 128 + i * 8 + rr;
    int t, len;
    if (row < NCTX) { t = row & 255; len = 256; } else { t = (row - NCTX) & 1023; len = 1024; }
    const bf16_t* base = p.convb() + (size_t)row * 768;
    const u32x4 zero = {0u, 0u, 0u, 0u};
    const u32x4 cbv = *(const u32x4*)(base + ch);
    const u32x4 c1 = *(const u32x4*)(base + 256 + ch), x1 = *(const u32x4*)(base + 512 + ch);
    const u32x4 c0 = t > 0 ? *(const u32x4*)(base - 768 + 256 + ch) : zero, x0 = t > 0 ? *(const u32x4*)(base - 768 + 512 + ch) : zero;
    const u32x4 c2 = t < len - 1 ? *(const u32x4*)(base + 768 + 256 + ch) : zero, x2 = t < len - 1 ? *(const u32x4*)(base + 768 + 512 + ch) : zero;
    const u32x4 zv = *(const u32x4*)(p.zs() + (size_t)row * 1024 + 256 + ch);
    u32x4 o;
#pragma unroll
    for (int q = 0; q < 4; ++q) {
      const float ylo = bflo(c0[q]) * bflo(x0[q]) * w0[2 * q] + bflo(c1[q]) * bflo(x1[q]) * w1[2 * q] + bflo(c2[q]) * bflo(x2[q]) * w2[2 * q];
      const float yhi = bfhi(c0[q]) * bfhi(x0[q]) * w0[2 * q + 1] + bfhi(c1[q]) * bfhi(x1[q]) * w1[2 * q + 1] + bfhi(c2[q]) * bfhi(x2[q]) * w2[2 * q + 1];
      o[q] = pk2(bflo(cbv[q]) * ylo * bflo(zv[q]), bfhi(cbv[q]) * yhi * bfhi(zv[q]));
    }
    *(u32x4*)(p.mix() + (size_t)row * 1024 + 256 + ch) = o;
  }
}

DI void phase_mix(const Params& p, int l, char* smem, int mask = 7) {
  const int lane = opaque_tid() & 63;
  const float* lm = p.lam + l * 256;
  const float s01 = wave_sum(lm[lane] * lm[64 + lane], lane), s23 = wave_sum(lm[128 + lane] * lm[192 + lane], lane);
  const float lam_init = (l == 0) ? 0.2f : 0.35550906759096934f;
  const float lamf = __int_as_float(__builtin_amdgcn_readfirstlane(__float_as_int(__expf(s01) - __expf(s23) + lam_init)));
  const float osc = 1.f - lam_init;
  const int bid = opaque_bid(), G = gridDim.x;
  for (int slot = 0;; ++slot) {
    int it;
    if (G == 512) {
      if (slot == 0) it = bid;
      else if (slot == 1) it = bid < 128 ? -1 : bid < 192 ? 704 + (bid - 128) : bid < 384 ? 512 + (bid - 192) : 768 + (bid - 384);
      else if (slot == 2) it = bid < 384 ? -1 : bid < 448 ? 896 + (bid - 384) : 960 + (bid - 448);
      else if (slot == 3) it = (bid >= 192 && bid < 208) ? 1024 + (bid - 192) : -1;
      else break;
      if (it < 0) continue;
    } else {
      it = slot * G + bid;
      if (it >= 1040) break;
    }
    int tid = threadIdx.x;
    asm volatile("" : "+v"(tid));
#if REP >= 40
    { const bool isdiff = it < 128 || (it >= 192 && it < 704), ismla = (it >= 128 && it < 192) || (it >= 704 && it < 960), islat = it < 192;
      if (mask == 1 && !isdiff) continue; if (mask == 2 && !ismla) continue; if (mask == 3 && !islat) continue; if (mask == 4 && !(isdiff && islat)) continue; }
#endif
    if (it < 128 || (it >= 192 && it < 704)) {
      int b, h, qt; size_t row0; const bf16_t *kp, *vp; int nk;
      if (it < 128) {
        const int x = it & 7; b = x >> 2; h = x & 3; qt = it >> 3; row0 = NCTX + b * 1024 + qt * 64; nk = 1280;
        kp = p.KdL() + (size_t)l * 1310720 + (size_t)((b * 4 + h) * 2) * 1280 * 64; vp = p.VdL() + (size_t)l * 1310720 + (size_t)((b * 4 + h) * 128) * 1280;
      } else {
        const int j = it - 192, combo = (j & 7) | ((j >> 5) << 3); b = combo >> 2; h = combo & 3; qt = (j >> 3) & 3; row0 = b * 256 + qt * 64; nk = 256;
        kp = p.KdC() + (size_t)((b * 4 + h) * 2) * 256 * 64; vp = p.VdC() + (size_t)((b * 4 + h) * 128) * 256;
      }
      attn_item<64, 128, true, false>(p.dq() + row0 * 512 + h * 128, 512, kp, vp, nk, p.mix() + row0 * 1024 + 512 + h * 128, p.zs() + row0 * 1024 + 512 + h * 128,
                                      lamf, p.subln + l * 128, osc, smem, tid, it < 128 ? 16 : 0, qt);
    } else if (it < 960) {
      int b, h, qt; size_t row0; const bf16_t *kp, *vp; int nk;
      if (it < 192) {
        const int j = it - 128, x = j & 7; b = x >> 2; h = x & 3; qt = j >> 3; row0 = NCTX + b * 1024 + qt * 128; nk = 1280;
        kp = p.KmL() + (size_t)l * 983040 + (size_t)(b * 4 + h) * 1280 * 96; vp = p.VmL() + (size_t)l * 655360 + (size_t)((b * 4 + h) * 64) * 1280;
      } else {
        const int j = it - 704, combo = (j & 7) | ((j >> 4) << 3); b = combo >> 2; h = combo & 3; qt = (j >> 3) & 1; row0 = b * 256 + qt * 128; nk = 256;
        kp = p.KmC() + (size_t)(b * 4 + h) * 256 * 96; vp = p.VmC() + (size_t)((b * 4 + h) * 64) * 256;
      }
      attn_item<96, 64, false, false>(p.qm() + row0 * 384 + h * 96, 384, kp, vp, nk, p.mix() + row0 * 1024 + h * 64, p.zs() + row0 * 1024 + h * 64, 0.f, nullptr, 1.f, smem, tid, it < 192 ? 8 : 0, qt);
    } else {
      conv_item(p, l, it - 960, tid);
    }
  }
}

DI void phase_inproj(const Params& p, int l, char* smem, bool atom = true, bool skip = false) {
  EpiIn epi{p, l, atom, skip};
  const int tid = opaque_tid(), bid = opaque_bid();
  const int xcd = bid & 7, nloc = (gridDim.x + 7 - xcd) >> 3;
  for (int j = bid >> 3; j < 300; j += nloc) {
    const int mt = xcd * 10 + j % 10, nt = j / 10;
    gemm_tile<4, 2>(p.hbuf(), 1024, p.WinT() + (size_t)l * NP * 1024, 1024, 1024, mt * 128, nt * 128, epi, smem, tid);
  }
}

DI void phase_upproj(const Params& p, int l, char* smem, bool fix = true) {
  const int tid = opaque_tid(), bid = opaque_bid();
  if (fix) {
    const float* g = p.kv_norm + l * 128;
    for (int i = bid * 256 + tid; i < NCTX * 32; i += gridDim.x * 256) {
      const int row = i >> 5, c = (i & 31) * 4, b = row >> 8, t = row & 255;
      const float f = rsqrtf(p.ssq_kv()[l * NTOK + row] * (1.f / 128.f) + EPS);
      float* d = p.out + OUT_CKV + (size_t)((b * 2 + l) * 256 + t) * 128 + c;
      f32x4 v = *(f32x4*)d;
      const f32x4 gg = *(const f32x4*)(g + c);
#pragma unroll
      for (int j = 0; j < 4; ++j) v[j] *= f * gg[j];
      *(f32x4*)d = v;
    }
  }
  EpiQ eq{p, l};
  EpiKV ek0{p, l, 0}, ek1{p, l, 1};
  for (int it = bid; it < 464; it += gridDim.x) {
    if (it < 192) {
      const int mt = it / 3, nt = it % 3;
      gemm_tile<5, 1>(p.cq(), 256, p.WuqT() + (size_t)l * 384 * 256, 256, 256, mt * 160, nt * 128, eq, smem, tid);
    } else if (it < 448) {
      const int j = it - 192, mt = j >> 2, nt = j & 3;
      gemm_tile<5, 1>(p.ckvraw(), 128, p.WukvTf() + (size_t)l * 512 * 128, 128, 128, mt * 160, nt * 128, ek0, smem, tid);
    } else {
      const int j = it - 448, mt = j >> 2, nt = j & 3;
      gemm_tile<4, 1>(p.cckv() + (size_t)l * 65536, 128, p.WukvT() + (size_t)l * 512 * 128, 128, 128, mt * 128, nt * 128, ek1, smem, tid);
    }
  }
}

DI void phase_outproj(const Params& p, int l, char* smem) {
  EpiOut epi{p, l};
  const int tid = opaque_tid(), bid = opaque_bid();
  const int xcd = bid & 7, nloc = (gridDim.x + 7 - xcd) >> 3;
  for (int j = bid >> 3; j < 64; j += nloc) {
    const int mt = xcd * 8 + (j & 7), nt = j >> 3;
    gemm_tile<5, 1>(p.mix(), 1024, p.WoutT() + (size_t)l * 1024 * 1024, 1024, 1024, mt * 160, nt * 128, epi, smem, tid);
  }
}

__global__ void __launch_bounds__(256, 2) fwd_megakernel(Params p) {
  __shared__ __attribute__((aligned(16))) char smem[73728];
  __shared__ __attribute__((aligned(16))) unsigned xb_words[4];
  cg::grid_group grid = cg::this_grid();
  if (p.ws == nullptr) grid.sync();
  if (threadIdx.x == 0) { xb_words[0] = 0u; xb_words[1] = 0u; xb_words[2] = 0u; xb_words[3] = 0u; }
  __syncthreads();
  const XcdBarrier xb = xcd_barrier_post(p.bar(), (volatile LAS unsigned*)xb_words);
#define GSYNC() xcd_barrier(xb)
  phase0(p, smem);
#if REP == 0
  GSYNC(); phase0(p, smem);
#endif
#pragma unroll
  for (int l = 0; l < 2; ++l) {
    GSYNC();
    if (l == 0) { phase_norm(p, 0); GSYNC(); }
#if REP == 2
    phase_inproj(p, l, smem, false); GSYNC();
#endif
#if REP == 7
    phase_inproj(p, l, smem, false, p.ws != nullptr); GSYNC();
#endif
    phase_inproj(p, l, smem);
    GSYNC();
#if REP == 3
    phase_upproj(p, l, smem, false); GSYNC();
#endif
    phase_upproj(p, l, smem);
    GSYNC();
#if REP == 4
    phase_mix(p, l, smem); GSYNC();
#endif
#if REP >= 40
    phase_mix(p, l, smem, REP - 40); GSYNC();
#endif
    phase_mix(p, l, smem);
    GSYNC();
#if REP == 5
    if (l == 0) { phase_outproj(p, l, smem); GSYNC(); }
#endif
    phase_outproj(p, l, smem);
  }
  GSYNC();
  phase_norm(p, 2);
#if REP == 6
  for (int i = 0; i < 10; ++i) GSYNC();
#endif
}

extern "C" void kernel_launch(void* const* d_in, const int* in_sizes, int n_in, void* d_out, int out_size, void* d_ws, size_t ws_size, hipStream_t stream) {
  static int grid_blocks = 0;
  if (!grid_blocks) {
    int dev = 0, cus = 0, per_cu = 0;
    hipGetDevice(&dev);
    hipDeviceGetAttribute(&cus, hipDeviceAttributeMultiprocessorCount, dev);
    hipOccupancyMaxActiveBlocksPerMultiprocessor(&per_cu, fwd_megakernel, 256, 0);
    if (per_cu > 2) per_cu = 2;
    if (per_cu < 1) per_cu = 1;
    grid_blocks = cus * per_cu;
  }
  Params p{};
  p.x_prompt = (const float*)d_in[0]; p.x_sample = (const float*)d_in[1]; p.c = (const float*)d_in[2];
  p.cache_ckv = (const float*)d_in[3]; p.cache_krope = (const float*)d_in[4]; p.cache_dk = (const float*)d_in[5]; p.cache_dv = (const float*)d_in[6];
  p.c_ctx = (const float*)d_in[7]; p.norm_g = (const float*)d_in[8]; p.ada_w = (const float*)d_in[9]; p.ada_b = (const float*)d_in[10];
  p.w_in = (const float*)d_in[11]; p.q_norm = (const float*)d_in[12]; p.w_uq = (const float*)d_in[13]; p.kv_norm = (const float*)d_in[14];
  p.w_ukv = (const float*)d_in[15]; p.conv_w = (const float*)d_in[16]; p.lam = (const float*)d_in[17]; p.subln = (const float*)d_in[18];
  p.w_out = (const float*)d_in[19]; p.final_norm = (const float*)d_in[20];
  p.out = (float*)d_out;
  p.ws = (char*)d_ws;
  if (ws_size < WS_TOTAL) fprintf(stderr, "workspace too small\n");
  hipMemsetAsync(d_ws, 0, OFF_WinT, stream);
  void* args[] = {&p};
  hipError_t e = hipLaunchCooperativeKernel((void*)fwd_megakernel, dim3(grid_blocks), dim3(256), args, 0, stream);
  if (e != hipSuccess) fprintf(stderr, "cooperative launch failed: %s (grid %d)\n", hipGetErrorString(e), grid_blocks);
}
```
